# Optimizing an MI355X kernel written in HIP

```python
import math
import jax
import jax.numpy as jnp
from jax import lax
import numpy as np

D_MODEL = 2048
BATCH = 1
SEQ = 8192
DEPTH = 4

GRID_W = 64
CTX_LEN = 256
N_MIXERS = 4
MIX_WIDTH = D_MODEL
GROUP_WIDTH = MIX_WIDTH // N_MIXERS

DA_HEAD_DIM = 64
DA_HEADS = GROUP_WIDTH // (2 * DA_HEAD_DIM)
GQA_HEAD_DIM = 128
GQA_HEADS = GROUP_WIDTH // GQA_HEAD_DIM
GQA_KV_HEADS = GQA_HEADS // 2
LRU_WIDTH = GROUP_WIDTH
LRU_BLOCKS = 4
LRU_CONV = 4
RGLRU_C = 8.0
SSM_D_INNER = GROUP_WIDTH
SSM_HEAD_DIM = 64
SSM_HEADS = SSM_D_INNER // SSM_HEAD_DIM
SSM_GROUPS = 2
SSM_D_STATE = 128
SSM_CONV = 4
SSD_CHUNK = 128
D_FF = 5632
FFN_CONV = 3
Q_BLOCK = 128
ROPE_THETA = 10000.0
NORM_EPS = 1e-6

SSM_CONV_DIM = SSM_D_INNER + 2 * SSM_GROUPS * SSM_D_STATE
IN_SIZES = (
    2 * DA_HEADS * DA_HEAD_DIM,
    2 * DA_HEADS * DA_HEAD_DIM,
    2 * DA_HEADS * DA_HEAD_DIM,
    GQA_HEADS * GQA_HEAD_DIM,
    GQA_KV_HEADS * GQA_HEAD_DIM,
    GQA_KV_HEADS * GQA_HEAD_DIM,
    LRU_WIDTH,
    LRU_WIDTH,
    SSM_D_INNER,
    SSM_CONV_DIM,
    2 * SSM_HEADS,
)
IN_COLS = sum(IN_SIZES)

kernel_name = 'hybrid_parallel_group_flow_block'


def rmsnorm(x, w):
    xf = x.astype(jnp.float32)
    y = xf * lax.rsqrt(jnp.mean(xf * xf, axis=-1, keepdims=True) + NORM_EPS)
    return (y * w.astype(jnp.float32)).astype(x.dtype)


def modulate(h, shift, scale):
    return h * (1 + scale) + shift


def modulation(cond, w_mod, b_mod):
    m = jax.nn.silu(cond) @ w_mod + b_mod
    return jnp.split(m, 6, axis=-1)


def split_columns(p):
    offs = np.cumsum(IN_SIZES)[:-1].tolist()
    return jnp.split(p, offs, axis=-1)


def to_heads(t, n_heads):
    b, s, hd = t.shape
    return t.reshape(b, s, n_heads, hd // n_heads).transpose(0, 2, 1, 3)


def merge_heads(t):
    b, h, s, d = t.shape
    return t.transpose(0, 2, 1, 3).reshape(b, s, h * d)


def rev(t, backward):
    return t[:, ::-1] if backward else t


def dwconv_centred(x, w, b):
    width = w.shape[0]
    length = x.shape[1]
    xp = jnp.pad(x, ((0, 0), (width // 2, width - 1 - width // 2), (0, 0)))
    return b + sum(w[k] * xp[:, k:k + length] for k in range(width))


def rope_1d(x, pos):
    half = x.shape[-1] // 2
    freqs = jnp.power(ROPE_THETA, -jnp.arange(half, dtype=jnp.float32) / half)
    ang = pos.astype(jnp.float32)[:, None] * freqs[None, :]
    cos = jnp.cos(ang).astype(x.dtype)
    sin = jnp.sin(ang).astype(x.dtype)
    x1, x2 = x[..., :half], x[..., half:]
    return jnp.concatenate([x1 * cos - x2 * sin, x2 * cos + x1 * sin], axis=-1)


def axial_rope(x, row, col):
    d = x.shape[-1]
    return jnp.concatenate([rope_1d(x[..., :d // 2], row), rope_1d(x[..., d // 2:], col)], axis=-1)


def sweep_query_blocks(fn, *qs):
    b, h, s, _ = qs[0].shape
    nb = s // Q_BLOCK
    blocks = tuple(q.reshape(b, h, nb, Q_BLOCK, q.shape[-1]).transpose(2, 0, 1, 3, 4) for q in qs)
    out = lax.map(lambda qb: fn(*qb), blocks)
    return out.transpose(1, 2, 0, 3, 4).reshape(b, out.shape[2], s, out.shape[-1])


def diff_attention(q1, q2, k1, k2, v, lam):
    scale = q1.shape[-1] ** -0.5

    def block(qb1, qb2):
        s1 = jnp.einsum('bhqd,bhtd->bhqt', qb1, k1).astype(jnp.float32) * scale
        s2 = jnp.einsum('bhqd,bhtd->bhqt', qb2, k2).astype(jnp.float32) * scale
        p = jax.nn.softmax(s1, axis=-1) - lam * jax.nn.softmax(s2, axis=-1)
        return jnp.einsum('bhqt,bhtv->bhqv', p.astype(v.dtype), v)

    return sweep_query_blocks(block, q1, q2)


def gqa_attention(q, k, v):
    b, hq, _, d = q.shape
    hkv = k.shape[1]
    g = hq // hkv
    scale = d ** -0.5

    def block(qb):
        nq = qb.shape[2]
        qg = qb.reshape(b, hkv, g, nq, d)
        s = jnp.einsum('bkgqd,bktd->bkgqt', qg, k).astype(jnp.float32) * scale
        p = jax.nn.softmax(s, axis=-1)
        o = jnp.einsum('bkgqt,bktd->bkgqd', p.astype(v.dtype), v)
        return o.reshape(b, hq, nq, d)

    return sweep_query_blocks(block, q)


def diff_attention_mixer(q_c, k_c, v_c, q_l, k_l, v_l, row, col, lam_vecs, subln_w, lam_init, need_ctx):
    lv = lam_vecs.astype(jnp.float32)
    lam = jnp.exp(jnp.sum(lv[0] * lv[1])) - jnp.exp(jnp.sum(lv[2] * lv[3])) + lam_init
    qc, kc, vc = to_heads(q_c, 2 * DA_HEADS), to_heads(k_c, 2 * DA_HEADS), to_heads(v_c, DA_HEADS)
    ql = axial_rope(to_heads(q_l, 2 * DA_HEADS), row, col)
    kl = axial_rope(to_heads(k_l, 2 * DA_HEADS), row, col)
    vl = to_heads(v_l, DA_HEADS)
    k_all = jnp.concatenate([kc, kl], axis=2)
    v_all = jnp.concatenate([vc, vl], axis=2)

    def finish(o):
        return merge_heads(rmsnorm(o, subln_w) * (1 - lam_init))

    y_l = finish(diff_attention(ql[:, 0::2], ql[:, 1::2], k_all[:, 0::2], k_all[:, 1::2], v_all, lam))
    y_c = finish(diff_attention(qc[:, 0::2], qc[:, 1::2], kc[:, 0::2], kc[:, 1::2], vc, lam)) if need_ctx else None
    return y_c, y_l


def gqa_mixer(q_c, k_c, v_c, q_l, k_l, v_l, row, col, q_norm, k_norm, need_ctx):
    qc = rmsnorm(to_heads(q_c, GQA_HEADS), q_norm)
    kc = rmsnorm(to_heads(k_c, GQA_KV_HEADS), k_norm)
    vc = to_heads(v_c, GQA_KV_HEADS)
    ql = axial_rope(rmsnorm(to_heads(q_l, GQA_HEADS), q_norm), row, col)
    kl = axial_rope(rmsnorm(to_heads(k_l, GQA_KV_HEADS), k_norm), row, col)
    vl = to_heads(v_l, GQA_KV_HEADS)
    y_l = merge_heads(gqa_attention(ql, jnp.concatenate([kc, kl], axis=2), jnp.concatenate([vc, vl], axis=2)))
    y_c = merge_heads(gqa_attention(qc, kc, vc)) if need_ctx else None
    return y_c, y_l


def rglru_scan(x, w_gates, b_gates, lam, h0):
    b, length, width = x.shape
    xb = x.reshape(b, length, LRU_BLOCKS, width // LRU_BLOCKS)
    gates = jnp.einsum('blhi,ghij->gblhj', xb, w_gates).reshape(2, b, length, width) + b_gates[:, None, None, :]
    r = jax.nn.sigmoid(gates[0].astype(jnp.float32))
    i = jax.nn.sigmoid(gates[1].astype(jnp.float32))
    log_a = RGLRU_C * r * jax.nn.log_sigmoid(lam.astype(jnp.float32))
    a = jnp.exp(log_a)
    u = jnp.sqrt(-jnp.expm1(2.0 * log_a)) * (i * x.astype(jnp.float32))
    u = u.at[:, 0].add(a[:, 0] * h0.astype(jnp.float32))
    _, h = lax.associative_scan(lambda e, f: (e[0] * f[0], f[0] * e[1] + f[1]), (a, u), axis=1)
    return h.astype(x.dtype)


def rglru_mixer(x_c, g_c, x_l, g_l, conv_w, conv_b, w_gates, b_gates, lam, need_ctx):
    xc = dwconv_centred(x_c, conv_w, conv_b)
    xl = dwconv_centred(x_l, conv_w, conv_b)
    hs_c, hs_l = [], []
    for d in range(2):
        bwd = d == 1
        h_c = rglru_scan(rev(xc, bwd), w_gates[d], b_gates[d], lam[d], jnp.zeros((xc.shape[0], LRU_WIDTH), xc.dtype))
        h_l = rglru_scan(rev(xl, bwd), w_gates[d], b_gates[d], lam[d], h_c[:, -1])
        hs_c.append(rev(h_c, bwd))
        hs_l.append(rev(h_l, bwd))
    y_l = (hs_l[0] + hs_l[1]) * jax.nn.gelu(g_l)
    y_c = (hs_c[0] + hs_c[1]) * jax.nn.gelu(g_c) if need_ctx else None
    return y_c, y_l


def segsum(x):
    t = x.shape[-1]
    xx = jnp.broadcast_to(x[..., :, None], x.shape + (t,))
    strict = jnp.tril(jnp.ones((t, t), dtype=bool), -1)
    out = jnp.cumsum(jnp.where(strict, xx, 0.0), axis=-2)
    return jnp.where(jnp.tril(jnp.ones((t, t), dtype=bool)), out, -jnp.inf)


def ssd_chunked(x, dt, a, bm, cm, h0):
    b, length, h, p = x.shape
    n = bm.shape[-1]
    nc = length // SSD_CHUNK
    f32 = jnp.float32
    xs = (x.astype(f32) * dt[..., None]).reshape(b, nc, SSD_CHUNK, h, p)
    bc = bm.astype(f32).reshape(b, nc, SSD_CHUNK, h, n)
    cc = cm.astype(f32).reshape(b, nc, SSD_CHUNK, h, n)
    adt = (dt * a).reshape(b, nc, SSD_CHUNK, h).transpose(0, 3, 1, 2)
    a_cum = jnp.cumsum(adt, axis=-1)
    l_in = jnp.exp(segsum(adt))
    y_diag = jnp.einsum('bclhn,bcshn,bhcls,bcshp->bclhp', cc, bc, l_in, xs)
    decay_in = jnp.exp(a_cum[..., -1:] - a_cum)
    states = jnp.einsum('bclhn,bhcl,bclhp->bchpn', bc, decay_in, xs)
    states = jnp.concatenate([h0.astype(f32)[:, None], states], axis=1)
    decay_chunk = jnp.exp(segsum(jnp.pad(a_cum[..., -1], ((0, 0), (0, 0), (1, 0)))))
    states = jnp.einsum('bhzc,bchpn->bzhpn', decay_chunk, states)
    y_off = jnp.einsum('bclhn,bchpn,bhcl->bclhp', cc, states[:, :-1], jnp.exp(a_cum))
    y = (y_diag + y_off).reshape(b, length, h, p)
    return y.astype(x.dtype), states[:, -1]


def ssd_mixer(z_c, xbc_c, dt_c, z_l, xbc_l, dt_l, conv_w, conv_b, dt_bias, a_log, d_skip, norm_w, need_ctx):
    rep = SSM_HEADS // SSM_GROUPS

    def prep(xbc):
        xbc = jax.nn.silu(dwconv_centred(xbc, conv_w, conv_b))
        b, length, _ = xbc.shape
        xs, bm, cm = jnp.split(xbc, [SSM_D_INNER, SSM_D_INNER + SSM_GROUPS * SSM_D_STATE], axis=-1)
        xs = xs.reshape(b, length, SSM_HEADS, SSM_HEAD_DIM)
        bm = jnp.repeat(bm.reshape(b, length, SSM_GROUPS, SSM_D_STATE), rep, axis=2)
        cm = jnp.repeat(cm.reshape(b, length, SSM_GROUPS, SSM_D_STATE), rep, axis=2)
        return xs, bm, cm

    xc, bc, cc = prep(xbc_c)
    xl, bl, cl = prep(xbc_l)
    ys_c, ys_l = [], []
    for d in range(2):
        bwd = d == 1
        a = -jnp.exp(a_log[d].astype(jnp.float32))
        dtc = jax.nn.softplus(dt_c[..., d * SSM_HEADS:(d + 1) * SSM_HEADS].astype(jnp.float32) + dt_bias[d])
        dtl = jax.nn.softplus(dt_l[..., d * SSM_HEADS:(d + 1) * SSM_HEADS].astype(jnp.float32) + dt_bias[d])
        h0 = jnp.zeros((xc.shape[0], SSM_HEADS, SSM_HEAD_DIM, SSM_D_STATE), jnp.float32)
        yc, hc = ssd_chunked(rev(xc, bwd), rev(dtc, bwd), a, rev(bc, bwd), rev(cc, bwd), h0)
        yl, _ = ssd_chunked(rev(xl, bwd), rev(dtl, bwd), a, rev(bl, bwd), rev(cl, bwd), hc)
        ys_c.append(rev(yc, bwd))
        ys_l.append(rev(yl, bwd))

    def finish(y, xs, z):
        y = y + d_skip[:, None] * xs
        y = y.reshape(y.shape[0], y.shape[1], SSM_D_INNER)
        return rmsnorm(y * jax.nn.silu(z), norm_w)

    y_l = finish(ys_l[0] + ys_l[1], xl, z_l)
    y_c = finish(ys_c[0] + ys_c[1], xc, z_c) if need_ctx else None
    return y_c, y_l


def token_mixers(p_c, p_l, row, col, lam_init, need_ctx, da_lambda, da_subln, gqa_q_norm, gqa_k_norm,
                 lru_conv_w, lru_conv_b, lru_w_gates, lru_b_gates, lru_lambda,
                 ssm_conv_w, ssm_conv_b, ssm_dt_bias, ssm_a_log, ssm_d, ssm_norm):
    pc = split_columns(p_c)
    pl = split_columns(p_l)
    ya_c, ya_l = diff_attention_mixer(pc[0], pc[1], pc[2], pl[0], pl[1], pl[2], row, col,
                                      da_lambda, da_subln, lam_init, need_ctx)
    yb_c, yb_l = gqa_mixer(pc[3], pc[4], pc[5], pl[3], pl[4], pl[5], row, col, gqa_q_norm, gqa_k_norm, need_ctx)
    yc_c, yc_l = rglru_mixer(pc[6], pc[7], pl[6], pl[7], lru_conv_w, lru_conv_b, lru_w_gates, lru_b_gates,
                             lru_lambda, need_ctx)
    yd_c, yd_l = ssd_mixer(pc[8], pc[9], pc[10], pl[8], pl[9], pl[10], ssm_conv_w, ssm_conv_b,
                           ssm_dt_bias, ssm_a_log, ssm_d, ssm_norm, need_ctx)
    y_l = jnp.concatenate([ya_l, yb_l, yc_l, yd_l], axis=-1)
    y_c = jnp.concatenate([ya_c, yb_c, yc_c, yd_c], axis=-1) if need_ctx else None
    return y_c, y_l


def conv_ffn(h, w_up, conv_w, conv_b, w_down):
    gate, up = jnp.split(h @ w_up, 2, axis=-1)
    gate = dwconv_centred(gate, conv_w, conv_b)
    return (jax.nn.silu(gate) * up) @ w_down


def setup_inputs(seed: int = 0) -> dict:
    key = jax.random.key(seed)
    ks = jax.random.split(key, 32)
    f32 = jnp.float32

    def nrm(k, shape, scale):
        return scale * jax.random.normal(k, shape, f32)

    def gain(k, shape):
        return 1.0 + 0.1 * jax.random.normal(k, shape, f32)

    bw = LRU_WIDTH // LRU_BLOCKS
    u = jax.random.uniform(ks[17], (DEPTH, 2, LRU_WIDTH), f32, 0.9, 0.999)
    a_base = u ** (1.0 / RGLRU_C)
    dt0 = jnp.exp(jax.random.uniform(ks[22], (DEPTH, 2, SSM_HEADS), f32, math.log(1e-3), math.log(1e-1)))
    return {
        'x': nrm(ks[0], (BATCH, SEQ, D_MODEL), 1.0),
        'c': nrm(ks[1], (BATCH, D_MODEL), 1.0),
        'ctx': nrm(ks[2], (BATCH, CTX_LEN, D_MODEL), 1.0),
        'c_ctx': nrm(ks[3], (D_MODEL,), 1.0),
        'w_mod': nrm(ks[4], (DEPTH, D_MODEL, 6 * D_MODEL), 0.5 * D_MODEL ** -0.5),
        'b_mod': nrm(ks[5], (DEPTH, 6 * D_MODEL), 0.01),
        'mix_norm': gain(ks[6], (DEPTH, D_MODEL)),
        'ffn_norm': gain(ks[7], (DEPTH, D_MODEL)),
        'w_in': nrm(ks[8], (DEPTH, D_MODEL, IN_COLS), D_MODEL ** -0.5),
        'w_out': nrm(ks[9], (DEPTH, MIX_WIDTH, D_MODEL), MIX_WIDTH ** -0.5),
        'da_lambda': nrm(ks[10], (DEPTH, 4, DA_HEAD_DIM), 0.1),
        'da_subln': gain(ks[11], (DEPTH, 2 * DA_HEAD_DIM)),
        'gqa_q_norm': gain(ks[12], (DEPTH, GQA_HEAD_DIM)),
        'gqa_k_norm': gain(ks[13], (DEPTH, GQA_HEAD_DIM)),
        'lru_conv_w': nrm(ks[14], (DEPTH, LRU_CONV, LRU_WIDTH), LRU_CONV ** -0.5),
        'lru_conv_b': nrm(ks[15], (DEPTH, LRU_WIDTH), 0.01),
        'lru_w_gates': nrm(ks[16], (DEPTH, 2, 2, LRU_BLOCKS, bw, bw), bw ** -0.5),
        'lru_b_gates': nrm(ks[18], (DEPTH, 2, 2, LRU_WIDTH), 0.01),
        'lru_lambda': jnp.log(a_base) - jnp.log1p(-a_base),
        'ssm_conv_w': nrm(ks[19], (DEPTH, SSM_CONV, SSM_CONV_DIM), SSM_CONV ** -0.5),
        'ssm_conv_b': nrm(ks[20], (DEPTH, SSM_CONV_DIM), 0.01),
        'ssm_dt_bias': dt0 + jnp.log(-jnp.expm1(-dt0)),
        'ssm_a_log': jnp.log(jax.random.uniform(ks[21], (DEPTH, 2, SSM_HEADS), f32, 1.0, 16.0)),
        'ssm_d': gain(ks[23], (DEPTH, SSM_HEADS)),
        'ssm_norm': gain(ks[24], (DEPTH, SSM_D_INNER)),
        'ffn_w_up': nrm(ks[25], (DEPTH, D_MODEL, 2 * D_FF), D_MODEL ** -0.5),
        'ffn_conv_w': nrm(ks[26], (DEPTH, FFN_CONV, D_FF), FFN_CONV ** -0.5),
        'ffn_conv_b': nrm(ks[27], (DEPTH, D_FF), 0.01),
        'ffn_w_down': nrm(ks[28], (DEPTH, D_FF, D_MODEL), D_FF ** -0.5),
        'final_norm': gain(ks[29], (D_MODEL,)),
    }


def reference(x, c, ctx, c_ctx, w_mod, b_mod, mix_norm, ffn_norm, w_in, w_out, da_lambda, da_subln,
              gqa_q_norm, gqa_k_norm, lru_conv_w, lru_conv_b, lru_w_gates, lru_b_gates, lru_lambda,
              ssm_conv_w, ssm_conv_b, ssm_dt_bias, ssm_a_log, ssm_d, ssm_norm,
              ffn_w_up, ffn_conv_w, ffn_conv_b, ffn_w_down, final_norm):
    n_tok = x.shape[1]
    ROWS = n_tok // GRID_W
    row = jnp.repeat(jnp.arange(ROWS, dtype=jnp.int32), GRID_W)
    col = jnp.tile(jnp.arange(GRID_W, dtype=jnp.int32), ROWS)

    for layer in range(DEPTH):
        need_ctx = layer < DEPTH - 1
        lam_init = 0.8 - 0.6 * math.exp(-0.3 * layer)
        sh_m, sc_m, g_m, sh_f, sc_f, g_f = [t[:, None, :] for t in modulation(c, w_mod[layer], b_mod[layer])]
        csh_m, csc_m, cg_m, csh_f, csc_f, cg_f = modulation(c_ctx, w_mod[layer], b_mod[layer])

        p_l = modulate(rmsnorm(x, mix_norm[layer]), sh_m, sc_m) @ w_in[layer]
        p_c = modulate(rmsnorm(ctx, mix_norm[layer]), csh_m, csc_m) @ w_in[layer]
        y_c, y_l = token_mixers(p_c, p_l, row, col, lam_init, need_ctx,
                                da_lambda[layer], da_subln[layer], gqa_q_norm[layer], gqa_k_norm[layer],
                                lru_conv_w[layer], lru_conv_b[layer], lru_w_gates[layer], lru_b_gates[layer],
                                lru_lambda[layer], ssm_conv_w[layer], ssm_conv_b[layer], ssm_dt_bias[layer],
                                ssm_a_log[layer], ssm_d[layer], ssm_norm[layer])
        x = x + g_m * (y_l @ w_out[layer])
        x = x + g_f * conv_ffn(modulate(rmsnorm(x, ffn_norm[layer]), sh_f, sc_f),
                               ffn_w_up[layer], ffn_conv_w[layer], ffn_conv_b[layer], ffn_w_down[layer])
        if need_ctx:
            ctx = ctx + cg_m * (y_c @ w_out[layer])
            ctx = ctx + cg_f * conv_ffn(modulate(rmsnorm(ctx, ffn_norm[layer]), csh_f, csc_f),
                                        ffn_w_up[layer], ffn_conv_w[layer], ffn_conv_b[layer], ffn_w_down[layer])

    return rmsnorm(x, final_norm)
```

```cpp
#include <hip/hip_runtime.h>
#include <hip/hip_bf16.h>
#include <cstdio>
#include <cstdint>

__device__ __forceinline__ int tid_opaque() { int t = threadIdx.x; asm volatile("" : "+v"(t)); return t; }

namespace pg8 {
#define PG8_LAS __attribute__((address_space(3)))
typedef unsigned short bf16_t;
typedef short bf16x8 __attribute__((ext_vector_type(8)));
typedef float f32x4 __attribute__((ext_vector_type(4)));
typedef unsigned u32x4 __attribute__((ext_vector_type(4)));
constexpr int BM = 256, BK = 64, HALF = 128, HTB = HALF * BK * 2  , STAGE_BYTES = 8 * HTB, NXCD = 8, WGM = 8;

__host__ __device__ __forceinline__ int lds_byte(int r, int c) { const int st = (r >> 4) * 2 + (c >> 5), rr = r & 15, cc = c & 31, ob = rr * 64 + cc * 2; return st * 1024 + (ob ^ (((ob >> 9) & 1) << 5)); }
__host__ __device__ __forceinline__ void stage_rc(int b, int& R, int& C) { const int st = b / 1024, sb = b % 1024, swz = sb ^ (((sb >> 9) & 1) << 5); R = (st >> 1) * 16 + swz / 64; C = (st & 1) * 32 + (swz % 64) / 2; }
__host__ __device__ __forceinline__ int perm32(int rho) { const int n = rho >> 4, i = rho & 15; return 8 * (i >> 2) + 4 * n + (i & 3); }

struct Unit { int pm, pn; };
struct Gemm { const bf16_t* A; const bf16_t* Bt; int M, N, K; };

struct StaticOrder {
    int nM, nN, nwg, G, c;
    __host__ __device__ void init(int M, int N, int G_, int c_) { nM = M / BM; nN = N / BM; nwg = nM * nN; G = G_; c = c_; }
    __host__ __device__ bool next(int i, Unit& u) const {
        const long L = (long)i * G + c; if (L >= nwg) return false;
        int wgid = (int)L; { const int q = nwg / NXCD, r = nwg % NXCD, xcd = wgid % NXCD, off = wgid / NXCD; wgid = (xcd < r ? xcd * (q + 1) : r * (q + 1) + (xcd - r) * q) + off; }
        const int nig = WGM * nN, gid = wgid / nig, fm = gid * WGM, gsz = (nM - fm) < WGM ? (nM - fm) : WGM;
        u.pm = fm + ((wgid % nig) % gsz); u.pn = (wgid % nig) / gsz; return true;
    }
    __device__ __forceinline__ void a_ready(const Unit&) const {}
    __device__ __forceinline__ void done(const Unit&) const {}
};

__device__ __forceinline__ unsigned cvt_pk_bf16(float lo, float hi) { unsigned r; asm volatile("v_cvt_pk_bf16_f32 %0, %1, %2" : "=v"(r) : "v"(lo), "v"(hi)); return r; }

struct EpiBf16 {
    static constexpr bool PERM = true, AFTER_DRAIN = false;
    bf16_t* O; int ldc;
    __device__ __forceinline__ void operator()(const f32x4 (&acc)[2][2][4][2], const Unit& u, int wr, int wc, int fr, int fq) const {
        const int row0 = u.pm * BM + wr * 64 + fr; const int col0 = u.pn * BM + wc * 32 + 8 * fq;
#pragma unroll
        for (int ai = 0; ai < 2; ++ai)
#pragma unroll
            for (int m = 0; m < 4; ++m) { bf16_t* rowp = O + (size_t)(row0 + ai * HALF + m * 16) * ldc + col0;
#pragma unroll
                for (int bj = 0; bj < 2; ++bj) { const f32x4 v0 = acc[ai][bj][m][0], v1 = acc[ai][bj][m][1];
                    u32x4 w; w.x = cvt_pk_bf16(v0[0], v0[1]); w.y = cvt_pk_bf16(v0[2], v0[3]); w.z = cvt_pk_bf16(v1[0], v1[1]); w.w = cvt_pk_bf16(v1[2], v1[3]);
                    *(u32x4*)(rowp + bj * HALF) = w; } }
    }
};
struct EpiResid {
    static constexpr bool PERM = false, AFTER_DRAIN = false;
    float* X; int ldc; const float* gate_ctx; const float* gate_lat; int ctx_panels;
    __device__ __forceinline__ void operator()(const f32x4 (&acc)[2][2][4][2], const Unit& u, int wr, int wc, int fr, int fq) const {
        const int row0 = u.pm * BM + wr * 64 + fr, col0 = u.pn * BM + wc * 32 + 4 * fq;
        const float* gate = (u.pm < ctx_panels) ? gate_ctx : gate_lat;
        f32x4 gv[2][2];
#pragma unroll
        for (int bj = 0; bj < 2; ++bj)
#pragma unroll
            for (int n = 0; n < 2; ++n) gv[bj][n] = *(const f32x4*)(gate + col0 + bj * HALF + n * 16);
#pragma unroll
        for (int ai = 0; ai < 2; ++ai)
#pragma unroll
            for (int m = 0; m < 4; ++m) { float* rowp = X + (size_t)(row0 + ai * HALF + m * 16) * ldc + col0;
#pragma unroll
                for (int bj = 0; bj < 2; ++bj)
#pragma unroll
                    for (int n = 0; n < 2; ++n) { float* p = rowp + bj * HALF + n * 16; const f32x4 xv = *(const f32x4*)p; *(f32x4*)p = xv + gv[bj][n] * acc[ai][bj][m][n]; }
                asm volatile("" ::: "memory"); }
    }
};

template <class Epi, class Sched, bool ALIGN_EPI = false, bool SP2 = false>
__device__ __forceinline__ void gemm_phase(PG8_LAS unsigned char* lds, const Gemm g, const Sched& S, const Epi& E) {
    const int tid = tid_opaque(), wid = __builtin_amdgcn_readfirstlane(tid >> 6), lane = tid & 63, wr = wid >> 2, wc = wid & 3, fr = lane & 15, fq = lane >> 4;
    const int K = g.K, nt = K / BK;
    unsigned voffA[2], voffB[2];
#pragma unroll
    for (int i = 0; i < 2; ++i) { int R, C; stage_rc(tid * 16 + i * 8192, R, C); const int Rb = Epi::PERM ? ((R & ~31) + perm32(R & 31)) : R;
        voffA[i] = (unsigned)(R * K + C) * 2u; voffB[i] = (unsigned)(Rb * K + C) * 2u; }
    const size_t kstep = (size_t)(BK * 2);
    const size_t hstep = (size_t)HALF * K * 2;
    const size_t tstep = 2 * hstep;
    const unsigned ldsw = (unsigned)wid * 1024u;
    const int aoff = lds_byte(wr * 64 + fr, fq * 8), boff = lds_byte(wc * 32 + fr, fq * 8);
#define PG8_SA(b, h) (((b) * 2 + (h)) * HTB)
#define PG8_SB(b, h) ((4 + (b) * 2 + (h)) * HTB)
#define PG8_STAGE(bufoff, gbase, voff) do { _Pragma("unroll") for (int _i = 0; _i < 2; ++_i) \
        __builtin_amdgcn_global_load_lds((const unsigned*)((const char*)(gbase) + (voff)[_i]), (PG8_LAS unsigned*)(lds + (bufoff) + ldsw + _i * 8192), 16, 0, 0); } while (0)
#define PG8_LDA(dst, b, h) do { _Pragma("unroll") for (int m = 0; m < 4; ++m) _Pragma("unroll") for (int k = 0; k < 2; ++k) dst[m][k] = *(const PG8_LAS bf16x8*)(lds + PG8_SA(b, h) + aoff + m * 2048 + k * 1024); } while (0)
#define PG8_LDB(dst, b, h) do { _Pragma("unroll") for (int n = 0; n < 2; ++n) _Pragma("unroll") for (int k = 0; k < 2; ++k) dst[n][k] = *(const PG8_LAS bf16x8*)(lds + PG8_SB(b, h) + boff + n * 2048 + k * 1024); } while (0)
#define PG8_MMA(ai, bj, At, Bt) do { __builtin_amdgcn_s_setprio(1); _Pragma("unroll") for (int m = 0; m < 4; ++m) _Pragma("unroll") for (int n = 0; n < 2; ++n) _Pragma("unroll") for (int k = 0; k < 2; ++k) \
        acc[ai][bj][m][n] = __builtin_amdgcn_mfma_f32_16x16x32_bf16(Bt[n][k], At[m][k], acc[ai][bj][m][n], 0, 0, 0); __builtin_amdgcn_s_setprio(0); } while (0)
#define PG8_WAIT_V(n) asm volatile("s_waitcnt vmcnt(" #n ")" ::: "memory")
#define PG8_WAIT_L(n) asm volatile("s_waitcnt lgkmcnt(" #n ")" ::: "memory")
#define PG8_BAR __builtin_amdgcn_s_barrier()
#define PG8_SCHED __builtin_amdgcn_sched_barrier(0)
    Unit cur, nxt; int ui = 0;
    if (!S.next(0, cur)) return;
    f32x4 acc[2][2][4][2];
#pragma unroll
    for (int a = 0; a < 2; ++a)
#pragma unroll
        for (int b = 0; b < 2; ++b)
#pragma unroll
            for (int m = 0; m < 4; ++m)
#pragma unroll
                for (int n = 0; n < 2; ++n) acc[a][b][m][n] = (f32x4){0.f, 0.f, 0.f, 0.f};
    bf16x8 At[4][2], B0[2][2], B1[2][2];
    const char* cA = (const char*)g.A + (size_t)cur.pm * tstep; const char* cB = (const char*)g.Bt + (size_t)cur.pn * tstep;
    S.a_ready(cur);
    if constexpr (SP2) {
        PG8_STAGE(PG8_SB(0, 0), cB, voffB); PG8_STAGE(PG8_SB(0, 1), cB + hstep, voffB); PG8_STAGE(PG8_SA(0, 0), cA, voffA); PG8_STAGE(PG8_SA(0, 1), cA + hstep, voffA);
        if (wr == 1) PG8_BAR;
        PG8_WAIT_V(2); PG8_BAR;
        PG8_STAGE(PG8_SB(1, 0), cB + kstep, voffB); PG8_STAGE(PG8_SA(1, 0), cA + kstep, voffA); PG8_STAGE(PG8_SB(1, 1), cB + hstep + kstep, voffB);
        PG8_WAIT_V(6); PG8_BAR;
    } else {
        PG8_STAGE(PG8_SB(0, 0), cB, voffB); PG8_STAGE(PG8_SA(0, 0), cA, voffA); PG8_STAGE(PG8_SB(0, 1), cB + hstep, voffB); PG8_STAGE(PG8_SA(0, 1), cA + hstep, voffA);
        if (wr == 1) PG8_BAR;
        PG8_WAIT_V(4); PG8_BAR;
        PG8_STAGE(PG8_SB(1, 0), cB + kstep, voffB); PG8_STAGE(PG8_SA(1, 0), cA + kstep, voffA); PG8_STAGE(PG8_SB(1, 1), cB + hstep + kstep, voffB);
        PG8_WAIT_V(6); PG8_BAR;
    }
    for (;;) {
        const bool has_next = S.next(ui + 1, nxt);
        const char* nA = has_next ? (const char*)g.A + (size_t)nxt.pm * tstep : cA; const char* nB = has_next ? (const char*)g.Bt + (size_t)nxt.pn * tstep : cB;
        for (int t = 0; t < nt; t += 2) {
            const bool last = (t == nt - 2);
            const char* a1 = cA + (size_t)(t + 1) * kstep;
            const char* a2 = last ? nA : cA + (size_t)(t + 2) * kstep; const char* b2 = last ? nB : cB + (size_t)(t + 2) * kstep;
            const char* a3 = a2 + kstep; const char* b3 = b2 + kstep;
            if (last && has_next) S.a_ready(nxt);
            if constexpr (SP2) {
            PG8_LDB(B0, 0, 0); PG8_LDB(B1, 0, 1); PG8_SCHED; PG8_LDA(At, 0, 0); PG8_STAGE(PG8_SA(1, 1), a1 + hstep, voffA);
            PG8_WAIT_V(8); PG8_WAIT_L(0); PG8_BAR; PG8_MMA(0, 0, At, B0); PG8_MMA(0, 1, At, B1); PG8_BAR; PG8_SCHED;
            PG8_LDA(At, 0, 1); PG8_STAGE(PG8_SB(0, 0), b2, voffB); PG8_STAGE(PG8_SB(0, 1), b2 + hstep, voffB); PG8_STAGE(PG8_SA(0, 0), a2, voffA);
            PG8_WAIT_V(8); PG8_WAIT_L(0); PG8_BAR; PG8_MMA(1, 0, At, B0); PG8_MMA(1, 1, At, B1); PG8_BAR; PG8_SCHED;
            PG8_LDB(B0, 1, 0); PG8_LDB(B1, 1, 1); PG8_SCHED; PG8_LDA(At, 1, 0); PG8_STAGE(PG8_SA(0, 1), a2 + hstep, voffA);
            PG8_WAIT_V(8); PG8_WAIT_L(0); PG8_BAR; PG8_MMA(0, 0, At, B0); PG8_MMA(0, 1, At, B1); PG8_BAR; PG8_SCHED;
            PG8_LDA(At, 1, 1); PG8_STAGE(PG8_SB(1, 0), b3, voffB); PG8_STAGE(PG8_SB(1, 1), b3 + hstep, voffB); PG8_STAGE(PG8_SA(1, 0), a3, voffA);
            PG8_WAIT_V(8); PG8_WAIT_L(0); PG8_BAR; PG8_MMA(1, 0, At, B0); PG8_MMA(1, 1, At, B1); PG8_BAR; PG8_SCHED;
            } else {
            PG8_LDB(B0, 0, 0); PG8_SCHED; PG8_LDA(At, 0, 0); PG8_STAGE(PG8_SA(1, 1), a1 + hstep, voffA);
            PG8_WAIT_L(8); PG8_BAR; PG8_WAIT_L(0); PG8_MMA(0, 0, At, B0); PG8_BAR; PG8_SCHED;
            PG8_LDB(B1, 0, 1); PG8_STAGE(PG8_SB(0, 0), b2, voffB);
            PG8_BAR; PG8_WAIT_L(0); PG8_MMA(0, 1, At, B1); PG8_BAR;
            PG8_LDA(At, 0, 1); PG8_STAGE(PG8_SA(0, 0), a2, voffA);
            PG8_BAR; PG8_WAIT_L(0); PG8_MMA(1, 0, At, B0); PG8_BAR; PG8_SCHED;
            PG8_STAGE(PG8_SB(0, 1), b2 + hstep, voffB);
            PG8_WAIT_V(6); PG8_BAR; PG8_MMA(1, 1, At, B1); PG8_BAR;
            PG8_LDB(B0, 1, 0); PG8_SCHED; PG8_LDA(At, 1, 0); PG8_STAGE(PG8_SA(0, 1), a2 + hstep, voffA);
            PG8_WAIT_L(8); PG8_BAR; PG8_WAIT_L(0); PG8_MMA(0, 0, At, B0); PG8_BAR; PG8_SCHED;
            PG8_LDB(B1, 1, 1); PG8_STAGE(PG8_SB(1, 0), b3, voffB);
            PG8_BAR; PG8_WAIT_L(0); PG8_MMA(0, 1, At, B1); PG8_BAR;
            PG8_LDA(At, 1, 1); PG8_STAGE(PG8_SA(1, 0), a3, voffA);
            PG8_BAR; PG8_WAIT_L(0); PG8_MMA(1, 0, At, B0); PG8_BAR; PG8_SCHED;
            PG8_STAGE(PG8_SB(1, 1), b3 + hstep, voffB);
            PG8_WAIT_V(6); PG8_BAR; PG8_MMA(1, 1, At, B1); PG8_BAR;
            }
        }
        if constexpr (ALIGN_EPI) { if (wr == 0) PG8_BAR; }
        if constexpr (!Epi::AFTER_DRAIN) { E(acc, cur, wr, wc, fr, fq); S.done(cur); }
        if (!has_next) break;
#pragma unroll
        for (int a = 0; a < 2; ++a)
#pragma unroll
            for (int b = 0; b < 2; ++b)
#pragma unroll
                for (int m = 0; m < 4; ++m)
#pragma unroll
                    for (int n = 0; n < 2; ++n) acc[a][b][m][n] = (f32x4){0.f, 0.f, 0.f, 0.f};
        cur = nxt; cA = nA; cB = nB; ++ui;
        if constexpr (ALIGN_EPI) { if (wr == 1) PG8_BAR; }
    }
    PG8_WAIT_V(0);
    if constexpr (!ALIGN_EPI) { if (wr == 0) PG8_BAR; }
    PG8_BAR;
    if constexpr (Epi::AFTER_DRAIN) { E.fused(acc, cur, wr, wc, fr, fq, lds, wid, lane); S.done(cur); }
#undef PG8_SA
#undef PG8_SB
#undef PG8_STAGE
#undef PG8_LDA
#undef PG8_LDB
#undef PG8_MMA
#undef PG8_WAIT_V
#undef PG8_WAIT_L
#undef PG8_BAR
#undef PG8_SCHED
}
}

namespace att {
using bf16 = __hip_bfloat16;
constexpr int   D = 128, NW = 8, QBLK = 32, KVBLK = 64;
constexpr float SCALE = 0.088388347648318440f;
constexpr float THR = 8.f;
constexpr int SDEPTH = 2;
constexpr int LDQ = 1536, LDK = 768, LDV = 5120, LDO = 1536;
constexpr size_t SHM_V = KVBLK * D * 2, SHM_K = KVBLK * D * 2, SHM_ATTN = 2 * SHM_V + 2 * SHM_K + NW * 64 * 4;
using bf16x8 = __attribute__((ext_vector_type(8))) short;
using s16x4  = __attribute__((ext_vector_type(4))) short;
using f32x16 = __attribute__((ext_vector_type(16))) float;
using f32x8  = __attribute__((ext_vector_type(8))) float;
using u32x4  = __attribute__((ext_vector_type(4))) unsigned;
#define KSWZ(row, colB) ((row) * 256 + ((colB) ^ (((row) & 7) << 4)))
#define SBAR() __builtin_amdgcn_sched_barrier(0)
__device__ __forceinline__ int crow(int r, int hi) { return (r & 3) + 8 * (r >> 2) + 4 * hi; }
__device__ __forceinline__ unsigned cvtpk(float lo, float hi) {
  unsigned r; asm volatile("v_cvt_pk_bf16_f32 %0, %1, %2" : "=v"(r) : "v"(lo), "v"(hi)); return r;
}
template <typename TIn> struct Stage;
template <> struct Stage<bf16>  { using T = bf16x8;
  __device__ static __forceinline__ T ld8(const bf16* p) { return *reinterpret_cast<const bf16x8*>(p); }
  __device__ static __forceinline__ bf16x8 tobf(T x) { return x; } };
template <> struct Stage<float> { using T = f32x8;
  __device__ static __forceinline__ T ld8(const float* p) { return *reinterpret_cast<const f32x8*>(p); }
  __device__ static __forceinline__ bf16x8 tobf(T x) {
    u32x4 w = {cvtpk(x[0], x[1]), cvtpk(x[2], x[3]), cvtpk(x[4], x[5]), cvtpk(x[6], x[7])}; return *reinterpret_cast<bf16x8*>(&w); } };

__device__ __forceinline__ void partialSM(f32x16& p0, f32x16& p1, float& m_reg, float& mn, float& alpha) {
  constexpr float C = SCALE * 1.4426950408889634f;
  float pmax = p0[0]; for (int r = 1; r < 16; ++r) pmax = fmaxf(pmax, p0[r]); for (int r = 0; r < 16; ++r) pmax = fmaxf(pmax, p1[r]);
  { auto rr = __builtin_amdgcn_permlane32_swap(__float_as_uint(pmax), __float_as_uint(pmax), false, false);
    pmax = fmaxf(__uint_as_float(rr[0]), __uint_as_float(rr[1])); }
  if (__builtin_expect(__all(pmax - m_reg <= THR / SCALE), 1)) { mn = m_reg; alpha = 1.f; }
  else { mn = fmaxf(m_reg, pmax); alpha = __builtin_amdgcn_exp2f((m_reg - mn) * C); m_reg = mn; }
  float mnC = -mn * C;
  for (int r = 0; r < 16; ++r) p0[r] = fmaf(p0[r], C, mnC); for (int r = 0; r < 16; ++r) p1[r] = fmaf(p1[r], C, mnC);
  for (int r = 0; r < 16; ++r) p0[r] = __builtin_amdgcn_exp2f(p0[r]);
}
__device__ __forceinline__ void finishSM(f32x16& p0, f32x16& p1, float alpha, float& l_reg, bf16x8& pa0, bf16x8& pa1, bf16x8& pa2, bf16x8& pa3) {
  for (int r = 0; r < 16; ++r) p1[r] = __builtin_amdgcn_exp2f(p1[r]);
  float ps = 0; for (int r = 0; r < 16; ++r) ps += p0[r]; for (int r = 0; r < 16; ++r) ps += p1[r];
  { auto rr = __builtin_amdgcn_permlane32_swap(__float_as_uint(ps), __float_as_uint(ps), false, false);
    ps = __uint_as_float(rr[0]) + __uint_as_float(rr[1]); }
  l_reg = l_reg * alpha + ps;
#define PK4(P, BASE, OUT) do { unsigned a0 = cvtpk(P[BASE + 0], P[BASE + 1]), a1 = cvtpk(P[BASE + 2], P[BASE + 3]);   \
    unsigned b0 = cvtpk(P[BASE + 4], P[BASE + 5]), b1 = cvtpk(P[BASE + 6], P[BASE + 7]);                              \
    auto r0 = __builtin_amdgcn_permlane32_swap(a0, b0, false, false); auto r1 = __builtin_amdgcn_permlane32_swap(a1, b1, false, false); \
    u32x4 w = {r0[0], r1[0], r0[1], r1[1]}; OUT = *reinterpret_cast<bf16x8*>(&w); } while (0)
  PK4(p0, 0, pa0); PK4(p0, 8, pa1); PK4(p1, 0, pa2); PK4(p1, 8, pa3);
#undef PK4
}
__device__ __forceinline__ void qkt(f32x16& p0, f32x16& p1, const bf16* Ks, const bf16x8* qr, int r32, int hi) {
  p0 = f32x16{}; p1 = f32x16{};
  for (int d0 = 0; d0 < 8; ++d0) { int cb = (d0 * 16 + hi * 8) * 2;
    bf16x8 b0 = *reinterpret_cast<const bf16x8*>((const char*)Ks + KSWZ(r32, cb));
    bf16x8 b1 = *reinterpret_cast<const bf16x8*>((const char*)Ks + KSWZ(32 + r32, cb));
    p0 = __builtin_amdgcn_mfma_f32_32x32x16_bf16(b0, qr[d0], p0, 0, 0, 0);
    p1 = __builtin_amdgcn_mfma_f32_32x32x16_bf16(b1, qr[d0], p1, 0, 0, 0); }
}
__device__ __forceinline__ int v_st(int k, int c) { const int kk = (k & ~0xC) | ((k & 4) << 1) | ((k & 8) >> 1); return ((kk >> 3) * 4 + (c >> 5)) * 512 + ((kk & 7) * 32 + (c & 31)) * 2; }
__device__ __forceinline__ int v_rd_base(int lane) { return ((lane & 3) << 3) | (((lane >> 2) & 3) << 6) | (((lane >> 4) & 1) << 5) | (((lane >> 5) & 1) << 8); }
constexpr int v_rd_off(int d0, int ks, int half) { return d0 * 512 + ks * 4096 + half * 2048; }
template <int OFF> __device__ __forceinline__ s16x4 tr_read(int vb) {
  s16x4 r; asm volatile("ds_read_b64_tr_b16 %0, %1 offset:%2" : "=&v"(r) : "v"(vb), "i"(OFF) : "memory"); return r;
}
template <int D0> __device__ __forceinline__ void pv_one(f32x16& od, int vb, bf16x8 pa0, bf16x8 pa1, bf16x8 pa2, bf16x8 pa3) {
  const s16x4 l0 = tr_read<v_rd_off(D0, 0, 0)>(vb), h0 = tr_read<v_rd_off(D0, 0, 1)>(vb), l1 = tr_read<v_rd_off(D0, 1, 0)>(vb), h1 = tr_read<v_rd_off(D0, 1, 1)>(vb);
  const s16x4 l2 = tr_read<v_rd_off(D0, 2, 0)>(vb), h2 = tr_read<v_rd_off(D0, 2, 1)>(vb), l3 = tr_read<v_rd_off(D0, 3, 0)>(vb), h3 = tr_read<v_rd_off(D0, 3, 1)>(vb);
  asm volatile("s_waitcnt lgkmcnt(0)" ::: "memory"); SBAR();
#define PK(L, H) (bf16x8){L[0], L[1], L[2], L[3], H[0], H[1], H[2], H[3]}
  od = __builtin_amdgcn_mfma_f32_32x32x16_bf16(pa0, PK(l0, h0), od, 0, 0, 0);
  od = __builtin_amdgcn_mfma_f32_32x32x16_bf16(pa1, PK(l1, h1), od, 0, 0, 0);
  od = __builtin_amdgcn_mfma_f32_32x32x16_bf16(pa2, PK(l2, h2), od, 0, 0, 0);
  od = __builtin_amdgcn_mfma_f32_32x32x16_bf16(pa3, PK(l3, h3), od, 0, 0, 0);
#undef PK
}
__device__ __forceinline__ void pv_d0(f32x16* o, int vb, bf16x8 pa0, bf16x8 pa1, bf16x8 pa2, bf16x8 pa3) {
  pv_one<0>(o[0], vb, pa0, pa1, pa2, pa3); pv_one<1>(o[1], vb, pa0, pa1, pa2, pa3); pv_one<2>(o[2], vb, pa0, pa1, pa2, pa3); pv_one<3>(o[3], vb, pa0, pa1, pa2, pa3);
}

template <typename TQ>
__device__ __forceinline__ void attn_dense_body(const TQ* __restrict__ Qb, const bf16* __restrict__ Kh, const bf16* __restrict__ Vh,
                                                float* __restrict__ Ob, int seq, char* lds) {
  using St = Stage<bf16>; using SQ = Stage<TQ>;
  const int tid = tid_opaque(), wid = tid >> 6, lane = tid & 63, r32 = lane & 31, hi = lane >> 5;
  bf16* V_lds = (bf16*)lds; bf16* K_lds = (bf16*)(lds + 2 * SHM_V);
  float* ws = (float*)(lds + 2 * SHM_V + 2 * SHM_K) + wid * 64; float* li_l = ws; float* al_l = ws + 32;
  float m_reg = -1e30f, l_reg = 0; f32x16 o[4] = {}; bf16x8 qr[8];
  const TQ* Qw = Qb + (long)(wid * QBLK + r32) * LDQ + hi * 8;
#pragma unroll
  for (int d0 = 0; d0 < 8; ++d0) qr[d0] = SQ::tobf(SQ::ld8(Qw + d0 * 16));
  const int sr = tid >> 4, sc = (tid & 15) * 8, vst0 = v_st(sr, sc), vst1 = v_st(32 + sr, sc);
  const int vb0 = (int)(uintptr_t)V_lds + v_rd_base(lane);
  struct { typename St::T vs0, vs1, ks0, ks1; } sr_[SDEPTH];
#define SLOAD(i, k0) do { sr_[i].vs0 = St::ld8(&Vh[(long)((k0) + sr) * LDV + sc]); sr_[i].vs1 = St::ld8(&Vh[(long)((k0) + 32 + sr) * LDV + sc]); \
    sr_[i].ks0 = St::ld8(&Kh[(long)((k0) + sr) * LDK + sc]); sr_[i].ks1 = St::ld8(&Kh[(long)((k0) + 32 + sr) * LDK + sc]); } while (0)
#define SWRITE(b, i) do { *(bf16x8*)((char*)V_lds + (b) * SHM_V + vst0) = St::tobf(sr_[i].vs0);          \
    *(bf16x8*)((char*)V_lds + (b) * SHM_V + vst1) = St::tobf(sr_[i].vs1); int kc = sc * 2;               \
    *(bf16x8*)((char*)K_lds + (b) * SHM_K + KSWZ(sr, kc)) = St::tobf(sr_[i].ks0);                       \
    *(bf16x8*)((char*)K_lds + (b) * SHM_K + KSWZ(32 + sr, kc)) = St::tobf(sr_[i].ks1); } while (0)
#define SWAIT() do { if constexpr (SDEPTH == 2) asm volatile("s_waitcnt vmcnt(4)" ::: "memory"); else asm volatile("s_waitcnt vmcnt(0)" ::: "memory"); } while (0)
#define RESC(a) do { if (__any((a) < 1.f)) { if (hi == 0) al_l[r32] = (a); asm volatile("s_waitcnt lgkmcnt(0)" ::: "memory"); \
    for (int d = 0; d < 4; ++d) for (int r = 0; r < 16; ++r) o[d][r] *= al_l[crow(r, hi)]; } } while (0)
  f32x16 pA0, pA1, pB0, pB1; float mnA, mnB, alA, alB; bf16x8 pa0, pa1, pa2, pa3; const int NT = seq / KVBLK;
  constexpr int SE = 0, SO = SDEPTH - 1;
  SLOAD(SE, 0); asm volatile("s_waitcnt vmcnt(0)" ::: "memory"); SWRITE(0, SE); __syncthreads();
  qkt(pA0, pA1, K_lds, qr, r32, hi); partialSM(pA0, pA1, m_reg, mnA, alA);
  SLOAD(SO, KVBLK); if constexpr (SDEPTH == 2) { if (2 < NT) SLOAD(SE, 2 * KVBLK); }
  SWAIT(); SWRITE(1, SO); __syncthreads();
  for (int j = 1; j + 1 < NT; j += 2) {
    SBAR(); qkt(pB0, pB1, (bf16*)((char*)K_lds + SHM_K), qr, r32, hi);
    finishSM(pA0, pA1, alA, l_reg, pa0, pa1, pa2, pa3); SBAR();
    SLOAD(SO, (j + SDEPTH) * KVBLK); SBAR();
    pv_d0(o, vb0, pa0, pa1, pa2, pa3); partialSM(pB0, pB1, m_reg, mnB, alB);
    __syncthreads(); SWAIT(); SWRITE(0, SE);
    RESC(alB); __syncthreads();
    SBAR(); qkt(pA0, pA1, K_lds, qr, r32, hi);
    finishSM(pB0, pB1, alB, l_reg, pa0, pa1, pa2, pa3); SBAR();
    if (SDEPTH == 1 || j + 3 < NT) SLOAD(SE, (j + 1 + SDEPTH) * KVBLK); SBAR();
    pv_d0(o, vb0 + (int)SHM_V, pa0, pa1, pa2, pa3); partialSM(pA0, pA1, m_reg, mnA, alA);
    __syncthreads(); SWAIT(); SWRITE(1, SO);
    RESC(alA); __syncthreads();
  }
  SBAR(); qkt(pB0, pB1, (bf16*)((char*)K_lds + SHM_K), qr, r32, hi);
  finishSM(pA0, pA1, alA, l_reg, pa0, pa1, pa2, pa3); SBAR();
  pv_d0(o, vb0, pa0, pa1, pa2, pa3); partialSM(pB0, pB1, m_reg, mnB, alB);
  __syncthreads(); RESC(alB);
  finishSM(pB0, pB1, alB, l_reg, pa0, pa1, pa2, pa3); SBAR();
  pv_d0(o, vb0 + (int)SHM_V, pa0, pa1, pa2, pa3);
  if (hi == 0) li_l[r32] = l_reg; asm volatile("s_waitcnt lgkmcnt(0)" ::: "memory");
  float rli[16];
#pragma unroll
  for (int r = 0; r < 16; ++r) rli[r] = __builtin_amdgcn_rcpf(li_l[crow(r, hi)]);
  float* Ow = Ob + (long)(wid * QBLK) * LDO;
#pragma unroll
  for (int r = 0; r < 16; ++r) { int orow = crow(r, hi);
    for (int d0 = 0; d0 < 4; ++d0) Ow[(long)orow * LDO + d0 * 32 + r32] = o[d0][r] * rli[r]; }
#undef SLOAD
#undef SWRITE
#undef SWAIT
#undef RESC
}
}

#define GAS __attribute__((address_space(1)))
typedef unsigned short bf16_t;
typedef unsigned v4u __attribute__((ext_vector_type(4)));
typedef unsigned v2u __attribute__((ext_vector_type(2)));
typedef float f32x4 __attribute__((ext_vector_type(4)));
typedef float f32x2 __attribute__((ext_vector_type(2)));
typedef short bf16x8 __attribute__((ext_vector_type(8)));

constexpr int DM = 2048, TL = 8192, TC = 256, TA = TL + TC, DEPTH = 4, DFF = 5632;
constexpr int NP = 5120, NIN = 5136;
constexpr int C_DAQ = 0, C_DAK = 512, C_DAV = 1024, C_GQ = 1536, C_GK = 2048, C_GV = 2304, C_LX = 2560, C_LG = 3072, C_SZ = 3584, C_SX = 4096, C_SB = 4608, C_SC = 4864, C_DT = 5120;
constexpr int QLD = 1536, KLD = 768;
constexpr float NEPS = 1e-6f;
constexpr int NWAVES = 8;
#ifndef SUBM
#define SUBM 7
#endif

constexpr size_t MiB = 1u << 20;
constexpr size_t WS_CTL = 0, CTL_ZERO_BYTES = 1 * MiB;
constexpr size_t WS_WIN = 2 * MiB, WS_WOUT = 82 * MiB, WS_WUP = 114 * MiB, WS_WDN = 290 * MiB, WS_WG = 378 * MiB;
constexpr size_t WS_MODP = 380 * MiB, WS_MODF = 383 * MiB, WS_ROPE = 384 * MiB;
constexpr size_t WS_X = 385 * MiB, WS_XN = 451 * MiB, WS_P = 484 * MiB, WS_QB = 567 * MiB, WS_KB = 592 * MiB, WS_O = 605 * MiB;
constexpr size_t WS_DT = 655 * MiB, WS_ACUM = 656 * MiB, WS_HF = 657 * MiB, WS_PF = 674 * MiB, WS_HB = 691 * MiB, WS_PB = 708 * MiB, WS_LSUM = 725 * MiB;
constexpr size_t WS_YD = 727 * MiB, WS_XC = 744 * MiB, WS_ST = 749 * MiB, WS_SIN = 782 * MiB, WS_CHA = 799 * MiB;
constexpr size_t WS_YCAT = 800 * MiB, WS_GU = 833 * MiB, WS_H = 1015 * MiB, WS_YD2 = 1106 * MiB, WS_END = 1123 * MiB;
static_assert(WS_WIN + 4ull * NP * DM * 2 <= WS_WOUT && WS_WOUT + 4ull * DM * DM * 2 <= WS_WUP && WS_WUP + 4ull * 2 * DFF * DM * 2 <= WS_WDN && WS_WDN + 4ull * DM * DFF * 2 <= WS_WG, "weights map");
static_assert(WS_X + (size_t)TA * DM * 4 <= WS_XN && WS_XN + (size_t)TA * DM * 2 <= WS_P && WS_P + (size_t)TA * NP * 2 <= WS_QB && WS_QB + (size_t)TA * QLD * 2 <= WS_KB && WS_KB + (size_t)TA * KLD * 2 <= WS_O && WS_O + (size_t)TA * QLD * 4 <= WS_DT, "act map 1");
static_assert(WS_HF + (size_t)TA * 512 * 4 <= WS_PF && WS_LSUM + 132ull * 2 * 2 * 512 * 4 <= WS_YD && WS_YD + (size_t)TA * 512 * 4 <= WS_XC && WS_XC + (size_t)TA * 256 * 2 <= WS_ST && WS_ST + 66ull * 2 * 65536 * 4 <= WS_SIN && WS_SIN + 66ull * 2 * 65536 * 2 <= WS_CHA, "act map 2");
static_assert(WS_YCAT + (size_t)TA * DM * 2 <= WS_GU && WS_GU + (size_t)TA * 2 * DFF * 2 <= WS_H && WS_H + (size_t)TA * DFF * 2 <= WS_END, "act map 3");
constexpr int CW_BAR = 4096;

constexpr int PH_LDS = 147456;
constexpr int MISC_OFF = PH_LDS;
constexpr int LDS_BYTES = PH_LDS + 1024;

#define LAS __attribute__((address_space(3)))
#define LDS_WAIT() asm volatile("s_waitcnt lgkmcnt(0)" ::: "memory")
#define VM_WAIT() asm volatile("s_waitcnt vmcnt(0)" ::: "memory")
#define RLX_AGENT __ATOMIC_RELAXED, __HIP_MEMORY_SCOPE_AGENT

__device__ __forceinline__ unsigned f2bf(float f) { unsigned u = __builtin_bit_cast(unsigned, f); return (u + 0x7fffu + ((u >> 16) & 1u)) >> 16; }
__device__ __forceinline__ unsigned pk2(float lo, float hi) { unsigned r; asm volatile("v_cvt_pk_bf16_f32 %0, %1, %2" : "=v"(r) : "v"(lo), "v"(hi)); return r; }
__device__ __forceinline__ float bflo(unsigned w) { return __uint_as_float(w << 16); }
__device__ __forceinline__ float bfhi(unsigned w) { return __uint_as_float(w & 0xffff0000u); }
__device__ __forceinline__ float bf1(bf16_t b) { return __uint_as_float(((unsigned)b) << 16); }
__device__ __forceinline__ void unpack8(const v4u w, float (&x)[8]) { x[0] = bflo(w.x); x[1] = bfhi(w.x); x[2] = bflo(w.y); x[3] = bfhi(w.y); x[4] = bflo(w.z); x[5] = bfhi(w.z); x[6] = bflo(w.w); x[7] = bfhi(w.w); }
__device__ __forceinline__ v4u pack8(const float (&x)[8]) { v4u w; w.x = pk2(x[0], x[1]); w.y = pk2(x[2], x[3]); w.z = pk2(x[4], x[5]); w.w = pk2(x[6], x[7]); return w; }
__device__ __forceinline__ float wave_sum(float v) {
#pragma unroll
    for (int o = 1; o < 64; o <<= 1) v += __shfl_xor(v, o);
    return v;
}
__device__ __forceinline__ float siluf(float x) { return x / (1.f + __expf(-x)); }
__device__ __forceinline__ float sigmf(float x) { return 1.f / (1.f + __expf(-x)); }
__device__ __forceinline__ float softplusf(float x) { return fmaxf(x, 0.f) + log1pf(__expf(-fabsf(x))); }
__device__ __forceinline__ float gelu_tanh(float x) { const float u = 0.7978845608028654f * (x + 0.044715f * x * x * x); return 0.5f * x * (1.f + tanhf(u)); }
#define MFMA16(a, b, c) __builtin_amdgcn_mfma_f32_16x16x32_bf16((a), (b), (c), 0, 0, 0)

struct Fr { LAS unsigned char* lds; char* ldsg; int tid, lane, wave, G, bid, vcu; };

struct Args { const float* in[30]; float* out; unsigned char* ws; int s_lo, s_hi; };
constexpr int TBL_OFF = PH_LDS + 256;
struct PArgs { LAS unsigned long long* tbl;
    __device__ __forceinline__ unsigned long long get(int k) const { const unsigned long long v = tbl[k];
        const unsigned lo = __builtin_amdgcn_readfirstlane((unsigned)v), hi = __builtin_amdgcn_readfirstlane((unsigned)(v >> 32)); return ((unsigned long long)hi << 32) | lo; }
    __device__ __forceinline__ const float* inp(int k) const { return (const float*)(const GAS float*)get(k); }
    __device__ __forceinline__ float* outp() const { return (float*)(GAS float*)get(30); }
    __device__ __forceinline__ unsigned char* wsp() const { return (unsigned char*)(GAS unsigned char*)get(31); }
};


#define XB_TMO      128
#define XB_XCNT(j)  (256  + 64 * (j))
#define XB_XSUB(j)  (1280 + 64 * (j))
#define XB_XGEN(j)  (2304 + 64 * (j))
#define XB_TOP      3328
#define XB_TOPGEN   3392
#define XCD_BAR_WORDS 3456
#define XB_SPIN_CAP (1u << 18)

__device__ __forceinline__ unsigned xb_ld(unsigned* p)              { return __hip_atomic_load(p, __ATOMIC_RELAXED, __HIP_MEMORY_SCOPE_AGENT); }
__device__ __forceinline__ unsigned xb_add(unsigned* p, unsigned v) { return __hip_atomic_fetch_add(p, v, __ATOMIC_RELAXED, __HIP_MEMORY_SCOPE_AGENT); }
__device__ __forceinline__ unsigned xb_xcc_id() { return (unsigned)__builtin_amdgcn_s_getreg((3 << 11) | 20) & 0xFu; }
#define XB_SPIN(cond, bar) do { unsigned _sp = 0; while (cond) { __builtin_amdgcn_s_sleep(1); \
    if ((++_sp & 255u) == 0u) { if (xb_ld(&(bar)[XB_TMO])) break; if (_sp > XB_SPIN_CAP) { atomicAdd(&(bar)[XB_TMO], 1u); break; } } } } while (0)

struct XcdBarrier {
    unsigned* bar; unsigned x;
    volatile LAS unsigned* st;
};

__device__ __forceinline__ XcdBarrier xcd_barrier_post(unsigned* bar, volatile LAS unsigned* st) {
    XcdBarrier b; b.bar = bar; b.x = xb_xcc_id(); b.st = st;
    if (threadIdx.x == 0) (void)xb_add(&bar[XB_XCNT(b.x)], 1u);
    return b;
}
__device__ __forceinline__ void xcd_barrier_complete(unsigned* bar, unsigned x, unsigned& nloc, unsigned& nx) {
    const unsigned G = gridDim.x * gridDim.y * gridDim.z;
    unsigned sum, cnt, mine, sp = 0u;
    for (;;) {
        sum = 0u; cnt = 0u; mine = 0u;
#pragma unroll
        for (unsigned j = 0; j < 16; ++j) { const unsigned c = xb_ld(&bar[XB_XCNT(j)]); sum += c; cnt += (c > 0u) ? 1u : 0u; mine = (j == x) ? c : mine; }
        if (sum == G) break;
        __builtin_amdgcn_s_sleep(1);
        if ((++sp & 255u) == 0u) { if (xb_ld(&bar[XB_TMO])) break; if (sp > XB_SPIN_CAP) { atomicAdd(&bar[XB_TMO], 1u); break; } }
    }
    nloc = mine > 0u ? mine : 1u; nx = cnt > 0u ? cnt : 1u;
}

__device__ __forceinline__ void xcd_barrier(const XcdBarrier& b) {
    asm volatile("s_waitcnt vmcnt(0)" ::: "memory");
    __syncthreads();
    if (threadIdx.x == 0) {
        unsigned* bar = b.bar;
        __builtin_amdgcn_s_waitcnt(0);
        unsigned nloc = b.st[0], nx = b.st[1];
        if (nloc == 0u) { xcd_barrier_complete(bar, b.x, nloc, nx); b.st[0] = nloc; b.st[1] = nx; }
        const unsigned old = xb_add(&bar[XB_XSUB(b.x)], 1u);
        const unsigned gen = old / nloc;
        if (old + 1u == (gen + 1u) * nloc) {
            __builtin_amdgcn_fence(__ATOMIC_RELEASE, "agent");
            asm volatile("s_waitcnt vmcnt(0)" ::: "memory");
            const unsigned og = xb_add(&bar[XB_TOP], 1u);
            const unsigned tg = og / nx;
            if (og + 1u == (tg + 1u) * nx) xb_add(&bar[XB_TOPGEN], 1u);
            else XB_SPIN(xb_ld(&bar[XB_TOPGEN]) == tg, bar);
            __builtin_amdgcn_fence(__ATOMIC_ACQUIRE, "agent");
            xb_add(&bar[XB_XGEN(b.x)], 1u);
            asm volatile("s_waitcnt vmcnt(0)" ::: "memory");
        } else {
            XB_SPIN(xb_ld(&bar[XB_XGEN(b.x)]) == gen, bar);
            __builtin_amdgcn_fence(__ATOMIC_ACQUIRE, "agent");
            asm volatile("s_waitcnt vmcnt(0)" ::: "memory");
        }
    }
    __syncthreads();
}

__device__ __forceinline__ void tr_item(const float* W, int ldW, int Nuse, bf16_t* WT, int K, LAS float* scr, int item, int lane) {
    const int nblk = Nuse / 32, kb = item / nblk, nb = item % nblk, k0 = 64 * kb, n0 = 32 * nb;
#pragma unroll 8
    for (int i = 0; i < 32; ++i) { const int kk = 2 * i + (lane >> 5); scr[kk * 33 + (lane & 31)] = W[(size_t)(k0 + kk) * ldW + n0 + (lane & 31)]; }
    LDS_WAIT(); asm volatile("" ::: "memory");
    const int c = lane & 7;
#pragma unroll
    for (int j = 0; j < 4; ++j) { const int n = (lane >> 3) + 8 * j; const LAS float* s = scr + (8 * c) * 33 + n;
        v4u o; o.x = pk2(s[0 * 33], s[1 * 33]); o.y = pk2(s[2 * 33], s[3 * 33]); o.z = pk2(s[4 * 33], s[5 * 33]); o.w = pk2(s[6 * 33], s[7 * 33]);
        *(v4u*)(WT + (size_t)(n0 + n) * K + k0 + 8 * c) = o; }
    LDS_WAIT(); asm volatile("" ::: "memory");
}
__device__ __forceinline__ void sincos_small(float x, float& s, float& c) {
    const float q = rintf(x * 0.6366197723675814f); const int n = (int)q;
    float r = fmaf(q, -1.5703125f, x); r = fmaf(q, -4.837512969970703125e-4f, r); r = fmaf(q, -7.54978995489188216e-8f, r);
    const float z = r * r;
    const float sp = r + r * z * (-1.6666654611e-1f + z * (8.3321608736e-3f + z * (-1.9515295891e-4f)));
    const float cp = 1.f - 0.5f * z + z * z * (4.166664568298827e-2f + z * (-1.388731625493765e-3f + z * 2.443315711809948e-5f));
    switch (n & 3) { case 0: s = sp; c = cp; break; case 1: s = cp; c = -sp; break; case 2: s = -sp; c = -cp; break; default: s = -cp; c = sp; break; }
}
__device__ __forceinline__ void ph_prologue(const Fr& F, const PArgs& A) {
    unsigned char* ws = A.wsp();
    const int gw = F.bid * NWAVES + F.wave, NGW = F.G * NWAVES;
    LAS float* scr = (LAS float*)(F.lds + F.wave * 8704);
    constexpr int I_IN = 32 * 160, I_OUT = 32 * 64, I_UP = 32 * 352, I_DN = 88 * 64, I_WG = 16 * 8, I_L = I_IN + I_OUT + I_UP + I_DN + I_WG;
    for (int it = gw; it < DEPTH * I_L; it += NGW) {
        const int L = it / I_L; int r = it % I_L;
        if (r < I_IN) { tr_item(A.inp(8) + (size_t)L * DM * NIN, NIN, NP, (bf16_t*)(ws + WS_WIN) + (size_t)L * NP * DM, DM, scr, r, F.lane); continue; } r -= I_IN;
        if (r < I_OUT) { tr_item(A.inp(9) + (size_t)L * DM * DM, DM, DM, (bf16_t*)(ws + WS_WOUT) + (size_t)L * DM * DM, DM, scr, r, F.lane); continue; } r -= I_OUT;
        if (r < I_UP) { tr_item(A.inp(25) + (size_t)L * DM * 2 * DFF, 2 * DFF, 2 * DFF, (bf16_t*)(ws + WS_WUP) + (size_t)L * 2 * DFF * DM, DM, scr, r, F.lane); continue; } r -= I_UP;
        if (r < I_DN) { tr_item(A.inp(28) + (size_t)L * DFF * DM, DM, DM, (bf16_t*)(ws + WS_WDN) + (size_t)L * DM * DFF, DFF, scr, r, F.lane); continue; } r -= I_DN;
        { const int mi = r / 8; tr_item(A.inp(16) + (size_t)(L * 16 + mi) * 16384, 128, 128, (bf16_t*)(ws + WS_WG) + (size_t)(L * 16 + mi) * 16384, 128, scr, r % 8, F.lane); }
    }
    float* modp = (float*)(ws + WS_MODP);
    for (int it = gw; it < DEPTH * 48 * 8; it += NGW) {
        const int L = it / 384, r = it % 384, nb = r / 8, ks = r % 8, k0 = ks * 256;
        f32x4 c0 = *(const f32x4*)(A.inp(1) + k0 + 4 * F.lane), c1 = *(const f32x4*)(A.inp(3) + k0 + 4 * F.lane);
#pragma unroll
        for (int i = 0; i < 4; ++i) { c0[i] = siluf(c0[i]); c1[i] = siluf(c1[i]); }
        f32x4 a0 = {0.f, 0.f, 0.f, 0.f}, a1 = {0.f, 0.f, 0.f, 0.f};
        const float* wp = A.inp(4) + ((size_t)(L * DM + k0)) * (6 * DM) + nb * 256 + 4 * F.lane;
#pragma unroll 2
        for (int q = 0; q < 64; ++q) {
#pragma unroll
            for (int i = 0; i < 4; ++i) {
                const float s0 = __uint_as_float(__builtin_amdgcn_readlane(__float_as_uint(c0[i]), q)), s1 = __uint_as_float(__builtin_amdgcn_readlane(__float_as_uint(c1[i]), q));
                const f32x4 w = *(const f32x4*)(wp + (size_t)(4 * q + i) * (6 * DM));
                a0 += s0 * w; a1 += s1 * w; }
        }
        *(f32x4*)(modp + ((size_t)((L * 8 + ks) * 2 + 0)) * (6 * DM) + nb * 256 + 4 * F.lane) = a0;
        *(f32x4*)(modp + ((size_t)((L * 8 + ks) * 2 + 1)) * (6 * DM) + nb * 256 + 4 * F.lane) = a1;
    }
    { const int gt = F.bid * 512 + F.tid, NT = F.G * 512; f32x4* X4 = (f32x4*)(ws + WS_X);
      const f32x4* c4 = (const f32x4*)A.inp(2); const f32x4* x4 = (const f32x4*)A.inp(0);
      constexpr int NC4 = TC * DM / 4, NA4 = TA * DM / 4;
      for (int i = gt; i < NA4; i += NT) X4[i] = (i < NC4) ? c4[i] : x4[i - NC4]; }
    { const int gt = F.bid * 512 + F.tid; if (gt < 128 * 48) { const int pos = gt / 48, f = gt % 48;
        const float fr = (f < 16) ? powf(10000.f, -(float)f / 16.f) : powf(10000.f, -(float)(f - 16) / 32.f);
        float s, c; sincos_small((float)pos * fr, s, c); ((f32x2*)(ws + WS_ROPE))[gt] = (f32x2){c, s}; } }
}
__device__ __forceinline__ void ph_modf(const Fr& F, const PArgs& A) {
    const float* modp = (const float*)(A.wsp() + WS_MODP); float* modf = (float*)(A.wsp() + WS_MODF);
    for (int i = F.bid * 512 + F.tid; i < DEPTH * 2 * 6 * DM; i += F.G * 512) {
        const int L = i / (2 * 6 * DM), r = i % (2 * 6 * DM), cd = r / (6 * DM), n = r % (6 * DM);
        float s = A.inp(5)[L * 6 * DM + n];
#pragma unroll
        for (int ks = 0; ks < 8; ++ks) s += modp[((size_t)((L * 8 + ks) * 2 + cd)) * (6 * DM) + n];
        modf[i] = s; }
}

template <bool DTP>
__device__ __forceinline__ void ph_norm(const Fr& F, const float* X, bf16_t* XN, const float* nw, const float* mod_lat, const float* mod_ctx, int sh_off, int sc_off,
                                        const float* win_layer, const float* dt_bias, float* DT) {
    LAS float* AL = (LAS float*)F.lds; LAS float* BL = AL + DM; LAS float* WDT = BL + DM;
    for (int k = F.tid; k < DM; k += 512) { AL[k] = nw[k] * (1.f + mod_lat[sc_off + k]); BL[k] = mod_lat[sh_off + k]; }
    if (DTP) for (int idx = F.tid; idx < DM * 16; idx += 512) { const int k = idx >> 4, j = idx & 15; WDT[j * DM + k] = win_layer[(size_t)k * NIN + C_DT + j]; }
    __syncthreads();
    const int gw = F.bid * NWAVES + F.wave, NGW = F.G * NWAVES, lane = F.lane;
    for (int row = gw; row < TA; row += NGW) {
        const f32x4* xr = (const f32x4*)(X + (size_t)row * DM) + lane;
        f32x4 v[8]; float ss = 0.f;
#pragma unroll
        for (int j = 0; j < 8; ++j) { v[j] = xr[64 * j]; ss += (v[j].x * v[j].x + v[j].y * v[j].y) + (v[j].z * v[j].z + v[j].w * v[j].w); }
        const float rs = 1.0f / sqrtf(wave_sum(ss) * (1.f / DM) + NEPS);
        const bool isctx = row < TC;
        v2u* o8 = (v2u*)(XN + (size_t)row * DM) + lane;
#pragma unroll
        for (int j = 0; j < 8; ++j) { const int k = 4 * lane + 256 * j; f32x4 a4, b4;
            if (isctx) { const f32x4 w4 = *(const f32x4*)(nw + k), s4 = *(const f32x4*)(mod_ctx + sc_off + k); a4 = w4 * (1.f + s4); b4 = *(const f32x4*)(mod_ctx + sh_off + k); }
            else { a4 = *(const LAS f32x4*)(AL + k); b4 = *(const LAS f32x4*)(BL + k); }
            v[j] = v[j] * rs * a4 + b4;
            v2u o; o.x = pk2(v[j].x, v[j].y); o.y = pk2(v[j].z, v[j].w); o8[64 * j] = o; }
        if (DTP) {
            float acc[16];
#pragma unroll
            for (int jj = 0; jj < 16; ++jj) acc[jj] = 0.f;
#pragma unroll
            for (int j = 0; j < 8; ++j)
#pragma unroll
                for (int jj = 0; jj < 16; ++jj) { const f32x4 w4 = *(const LAS f32x4*)(WDT + jj * DM + 4 * lane + 256 * j);
                    acc[jj] += (v[j].x * w4.x + v[j].y * w4.y) + (v[j].z * w4.z + v[j].w * w4.w); }
            float r8[8], r4[4], r2[2], r1;
#pragma unroll
            for (int i = 0; i < 8; ++i) { const bool up = (lane & 32) != 0; const float keep = up ? acc[i + 8] : acc[i], send = up ? acc[i] : acc[i + 8]; r8[i] = keep + __shfl_xor(send, 32); }
#pragma unroll
            for (int i = 0; i < 4; ++i) { const bool up = (lane & 16) != 0; const float keep = up ? r8[i + 4] : r8[i], send = up ? r8[i] : r8[i + 4]; r4[i] = keep + __shfl_xor(send, 16); }
#pragma unroll
            for (int i = 0; i < 2; ++i) { const bool up = (lane & 8) != 0; const float keep = up ? r4[i + 2] : r4[i], send = up ? r4[i] : r4[i + 2]; r2[i] = keep + __shfl_xor(send, 8); }
            { const bool up = (lane & 4) != 0; const float keep = up ? r2[1] : r2[0], send = up ? r2[0] : r2[1]; r1 = keep + __shfl_xor(send, 4); }
            r1 += __shfl_xor(r1, 2); r1 += __shfl_xor(r1, 1);
            const int col = ((lane >> 5) & 1) * 8 + ((lane >> 4) & 1) * 4 + ((lane >> 3) & 1) * 2 + ((lane >> 2) & 1);
            if ((lane & 3) == 0) DT[(size_t)row * 16 + col] = softplusf(r1 + dt_bias[col]);
        }
    }
    __syncthreads();
}

__device__ __forceinline__ void prep_rope_unit(const Fr& F, const PArgs& A, int L, int unit) {
    unsigned char* ws = A.wsp(); const int lane = F.lane;
    const bf16_t* P = (const bf16_t*)(ws + WS_P); bf16_t* QB = (bf16_t*)(ws + WS_QB); bf16_t* KB = (bf16_t*)(ws + WS_KB);
    const f32x2* RT = (const f32x2*)(ws + WS_ROPE);
    const float* qn = A.inp(12) + L * 128; const float* kn = A.inp(13) + L * 128;
    for (int i = 0; i < 8; ++i) {
        const int r = unit * 64 + F.wave * 8 + i; const bool lat = r >= TC; const int t = r - TC, prow = lat ? (t >> 6) : 0, pcol = lat ? (t & 63) : 0;
        const bf16_t* pr = P + (size_t)r * NP;
        {   const int hd = lane >> 3, o = (lane & 7) * 8, axis = o >> 5, p = o & 31, fi = p & 15; const bool first = p < 16; const int pos = axis ? pcol : prow;
            float xq[8], xk[8], yq[8], yk[8];
            unpack8(*(const v4u*)(pr + C_DAQ + 8 * lane), xq); unpack8(*(const v4u*)(pr + C_DAK + 8 * lane), xk);
#pragma unroll
            for (int e = 0; e < 8; ++e) { const float pq = __shfl_xor(xq[e], 2), pk = __shfl_xor(xk[e], 2);
                f32x2 cs = lat ? RT[pos * 48 + fi + e] : (f32x2){1.f, 0.f};
                const float sg = first ? -cs.y : cs.y;
                yq[e] = (xq[e] * cs.x + pq * sg) * 1.41421356237f; yk[e] = xk[e] * cs.x + pk * sg; }
            bf16_t* qd = QB + (size_t)r * QLD + hd * 128; const int m = hd & 1;
            *(v4u*)(qd + m * 64 + o) = pack8(yq); { unsigned zz = 0u; asm volatile("" : "+v"(zz)); *(v4u*)(qd + (1 - m) * 64 + o) = (v4u){zz, zz, zz, zz}; }
            *(v4u*)(KB + (size_t)r * KLD + 8 * lane) = pack8(yk);
        }
        {   const int o = (lane & 15) * 8, axis = o >> 6, p = o & 63, fi = p & 31; const bool first = p < 32; const int pos = axis ? pcol : prow;
            const int lk = lane & 31;
            float xq[8], xk[8], yq[8], yk[8];
            unpack8(*(const v4u*)(pr + C_GQ + 8 * lane), xq); unpack8(*(const v4u*)(pr + C_GK + 8 * lk), xk);
            float sq = 0.f, sk = 0.f;
#pragma unroll
            for (int e = 0; e < 8; ++e) { sq += xq[e] * xq[e]; sk += xk[e] * xk[e]; }
#pragma unroll
            for (int s = 1; s < 16; s <<= 1) { sq += __shfl_xor(sq, s); sk += __shfl_xor(sk, s); }
            const float rq = 1.0f / sqrtf(sq * (1.f / 128.f) + NEPS), rk = 1.0f / sqrtf(sk * (1.f / 128.f) + NEPS);
#pragma unroll
            for (int e = 0; e < 8; ++e) { xq[e] = xq[e] * rq * qn[o + e]; xk[e] = xk[e] * rk * kn[o + e]; }
#pragma unroll
            for (int e = 0; e < 8; ++e) { const float pq = __shfl_xor(xq[e], 4), pk = __shfl_xor(xk[e], 4);
                f32x2 cs = lat ? RT[pos * 48 + 16 + fi + e] : (f32x2){1.f, 0.f};
                const float sg = first ? -cs.y : cs.y;
                yq[e] = xq[e] * cs.x + pq * sg; yk[e] = xk[e] * cs.x + pk * sg; }
            *(v4u*)(QB + (size_t)r * QLD + 1024 + 8 * lane) = pack8(yq);
            if (lane < 32) *(v4u*)(KB + (size_t)r * KLD + 512 + 8 * lane) = pack8(yk);
        }
    }
}

__device__ __forceinline__ void prep_lru_unit(const Fr& F, const PArgs& A, int L, int unit) {
    unsigned char* ws = A.wsp(); const int lane = F.lane, tid = F.tid, c64 = unit >> 2, blk = unit & 3, r0 = c64 * 64;
    const int seg_lo = (r0 < TC) ? 0 : TC, seg_hi = (r0 < TC) ? TC : TA;
    const bf16_t* P = (const bf16_t*)(ws + WS_P);
    LAS float* XCv = (LAS float*)F.lds;
    LAS f32x2* AU = (LAS f32x2*)(F.lds + 64 * 132 * 4);
    const float* cw = A.inp(14) + (size_t)L * 4 * 512 + blk * 128; const float* cb = A.inp(15) + L * 512 + blk * 128;
    {
        const int tk = tid >> 3, c0 = (tid & 7) * 16, r = r0 + tk;
        float acc[16];
#pragma unroll
        for (int e = 0; e < 16; ++e) acc[e] = cb[c0 + e];
#pragma unroll
        for (int k = 0; k < 4; ++k) { const int rr = r + k - 2; if (rr >= seg_lo && rr < seg_hi) {
            const bf16_t* src = P + (size_t)rr * NP + C_LX + blk * 128 + c0; float x0[8], x1[8]; unpack8(*(const v4u*)src, x0); unpack8(*(const v4u*)(src + 8), x1);
#pragma unroll
            for (int e = 0; e < 8; ++e) { acc[e] += cw[k * 512 + c0 + e] * x0[e]; acc[8 + e] += cw[k * 512 + c0 + 8 + e] * x1[e]; } } }
#pragma unroll
        for (int e = 0; e < 16; e += 4) *(LAS f32x4*)(XCv + tk * 132 + c0 + e) = (f32x4){acc[e], acc[e + 1], acc[e + 2], acc[e + 3]};
    }
    __syncthreads();
    const int w = F.wave, fr = lane & 15, fq = lane >> 4;
    bf16x8 af[4][4];
#pragma unroll
    for (int m = 0; m < 4; ++m)
#pragma unroll
        for (int ks = 0; ks < 4; ++ks) { const LAS float* s = XCv + (16 * m + fr) * 132 + 32 * ks + 8 * fq; const f32x4 a = *(const LAS f32x4*)s, b = *(const LAS f32x4*)(s + 4);
            v4u wv; wv.x = pk2(a.x, a.y); wv.y = pk2(a.z, a.w); wv.z = pk2(b.x, b.y); wv.w = pk2(b.z, b.w); af[m][ks] = __builtin_bit_cast(bf16x8, wv); }
    const bf16_t* WG = (const bf16_t*)(ws + WS_WG) + (size_t)L * 16 * 16384;
    const int ch = 16 * w + fr, chg = blk * 128 + ch;
    for (int dir = 0; dir < 2; ++dir) {
        const bf16_t* Wr = WG + (size_t)((dir * 2 + 0) * 4 + blk) * 16384 + (size_t)ch * 128 + 8 * fq;
        const bf16_t* Wi = WG + (size_t)((dir * 2 + 1) * 4 + blk) * 16384 + (size_t)ch * 128 + 8 * fq;
        f32x4 ar[4], ai[4];
#pragma unroll
        for (int m = 0; m < 4; ++m) { ar[m] = (f32x4){0.f, 0.f, 0.f, 0.f}; ai[m] = (f32x4){0.f, 0.f, 0.f, 0.f}; }
#pragma unroll
        for (int ks = 0; ks < 4; ++ks) { const bf16x8 br = *(const bf16x8*)(Wr + 32 * ks), bi = *(const bf16x8*)(Wi + 32 * ks);
#pragma unroll
            for (int m = 0; m < 4; ++m) { ar[m] = MFMA16(af[m][ks], br, ar[m]); ai[m] = MFMA16(af[m][ks], bi, ai[m]); } }
        const float bgr = A.inp(17)[((size_t)(L * 2 + dir) * 2 + 0) * 512 + chg], bgi = A.inp(17)[((size_t)(L * 2 + dir) * 2 + 1) * 512 + chg];
        const float lam = A.inp(18)[(size_t)(L * 2 + dir) * 512 + chg];
        const float lsg = fminf(lam, 0.f) - log1pf(__expf(-fabsf(lam)));
#pragma unroll
        for (int m = 0; m < 4; ++m)
#pragma unroll
            for (int rg = 0; rg < 4; ++rg) { const int tok = 16 * m + 4 * fq + rg;
                const float rr = sigmf(ar[m][rg] + bgr), ii = sigmf(ai[m][rg] + bgi);
                const float log_a = 8.0f * rr * lsg, a = __expf(log_a), beta = sqrtf(fmaxf(-expm1f(2.f * log_a), 0.f));
                AU[tok * 128 + ch] = (f32x2){a, beta * (ii * XCv[tok * 132 + ch])}; }
        __syncthreads();
        if (tid < 128) {
            float* Hb = (float*)(ws + (dir ? WS_HB : WS_HF)); float* Pb = (float*)(ws + (dir ? WS_PB : WS_PF));
            float h = 0.f, pr = 1.f;
            for (int s = 0; s < 64; ++s) { const int tok = dir ? 63 - s : s; const f32x2 au = AU[tok * 128 + tid];
                h = au.x * h + au.y; pr *= au.x;
                const size_t o = (size_t)(r0 + tok) * 512 + blk * 128 + tid; Hb[o] = h; Pb[o] = pr; }
            float* LS = (float*)(ws + WS_LSUM) + ((size_t)(dir * 132 + c64) * 2) * 512 + blk * 128 + tid;
            LS[0] = pr; LS[512] = h;
        }
        __syncthreads();
    }
}

constexpr int SLD = 136, XLD = 72;
typedef short v4i16_t __attribute__((ext_vector_type(4)));
__device__ __forceinline__ bf16x8 lds_tr_frag(const LAS bf16_t* img, int ld, int r0, int c0, int fr, int fq) {
    const LAS bf16_t* p = img + (r0 + 8 * fq + (fr >> 2)) * ld + c0 + 4 * (fr & 3);
    const v4i16_t lo = __builtin_amdgcn_ds_read_tr16_b64_v4i16((LAS v4i16_t*)p), hi = __builtin_amdgcn_ds_read_tr16_b64_v4i16((LAS v4i16_t*)(p + 4 * ld));
    return (bf16x8){lo[0], lo[1], lo[2], lo[3], hi[0], hi[1], hi[2], hi[3]};
}
__device__ __forceinline__ void prep_ssd_unit(const Fr& F, const PArgs& A, int L, int unit) {
    unsigned char* ws = A.wsp(); const int lane = F.lane, tid = F.tid, c = unit >> 3, h = unit & 7, g = h >> 2, r0 = c * 128;
    const int seg_lo = (r0 < TC) ? 0 : TC, seg_hi = (r0 < TC) ? TC : TA;
    const bf16_t* P = (const bf16_t*)(ws + WS_P);
    LAS bf16_t* CG = (LAS bf16_t*)F.lds;
    LAS bf16_t* BG = CG + 128 * SLD;
    LAS bf16_t* XS = BG + 128 * SLD;
    LAS float* VEC = (LAS float*)(XS + 128 * XLD);
    LAS float* AFv = VEC, *ABv = VEC + 128, *DTF = VEC + 256, *DTB = VEC + 384, *WFv = VEC + 512, *WBv = VEC + 640;
    if (F.wave == 0) {
        const float* DT = (const float*)(ws + WS_DT);
        const float a_f = -__expf(A.inp(22)[(L * 2 + 0) * 8 + h]), a_b = -__expf(A.inp(22)[(L * 2 + 1) * 8 + h]);
        const int t0 = 2 * lane;
        const float df0 = DT[(size_t)(r0 + t0) * 16 + h], df1 = DT[(size_t)(r0 + t0 + 1) * 16 + h], db0 = DT[(size_t)(r0 + t0) * 16 + 8 + h], db1 = DT[(size_t)(r0 + t0 + 1) * 16 + 8 + h];
        const float xf0 = df0 * a_f, xf1 = df1 * a_f, xb0 = db0 * a_b, xb1 = db1 * a_b;
        float sf = xf0 + xf1, sb = xb0 + xb1;
#pragma unroll
        for (int o = 1; o < 64; o <<= 1) { const float uf = __shfl_up(sf, o), ub = __shfl_down(sb, o); if (lane >= o) sf += uf; if (lane + o < 64) sb += ub; }
        const float af1 = sf, af0 = sf - xf1;
        const float ab0 = sb, ab1 = sb - xb0;
        const float aft = __shfl(sf, 63), abt = __shfl(sb, 0);
        AFv[t0] = af0; AFv[t0 + 1] = af1; ABv[t0] = ab0; ABv[t0 + 1] = ab1; DTF[t0] = df0; DTF[t0 + 1] = df1; DTB[t0] = db0; DTB[t0 + 1] = db1;
        WFv[t0] = __expf(aft - af0) * df0; WFv[t0 + 1] = __expf(aft - af1) * df1; WBv[t0] = __expf(abt - ab0) * db0; WBv[t0 + 1] = __expf(abt - ab1) * db1;
        float* AC = (float*)(ws + WS_ACUM);
        AC[(size_t)(r0 + t0) * 16 + h] = af0; AC[(size_t)(r0 + t0 + 1) * 16 + h] = af1; AC[(size_t)(r0 + t0) * 16 + 8 + h] = ab0; AC[(size_t)(r0 + t0 + 1) * 16 + 8 + h] = ab1;
        if (lane == 0) { float* CH = (float*)(ws + WS_CHA); CH[(c * 2 + 0) * 8 + h] = aft; CH[(c * 2 + 1) * 8 + h] = abt; }
    }
    const float* cw = A.inp(19) + (size_t)L * 4 * 1024; const float* cb = A.inp(20) + (size_t)L * 1024;
    bf16_t* XCg = (bf16_t*)(ws + WS_XC);
    for (int id = tid; id < 640; id += 512) {
        const int cgp = id % 40, t0 = (id / 40) * 8;
        int ccol, off, ld; LAS bf16_t* img;
        if (cgp < 8) { off = cgp * 8; ccol = 64 * h + off; img = XS; ld = XLD; } else if (cgp < 24) { off = (cgp - 8) * 8; ccol = 512 + 128 * g + off; img = BG; ld = SLD; } else { off = (cgp - 24) * 8; ccol = 768 + 128 * g + off; img = CG; ld = SLD; }
        const bool cglob = (cgp >= 24) && ((h & 3) == 0);
        float wk[4][8], bb[8];
#pragma unroll
        for (int e = 0; e < 8; ++e) { bb[e] = cb[ccol + e];
#pragma unroll
            for (int k = 0; k < 4; ++k) wk[k][e] = cw[k * 1024 + ccol + e]; }
        const bf16_t* src = P + (size_t)(r0 + t0) * NP + C_SX + ccol;
        float wn[4][8];
#pragma unroll
        for (int j = 0; j < 3; ++j) { const int rr = r0 + t0 + j - 2;
            if (rr >= seg_lo && rr < seg_hi) unpack8(*(const v4u*)(src + (ptrdiff_t)(j - 2) * NP), wn[j]);
            else {
#pragma unroll
                for (int e = 0; e < 8; ++e) wn[j][e] = 0.f; } }
#pragma unroll
        for (int t = 0; t < 8; ++t) { const int rr = r0 + t0 + t + 1;
            if (rr < seg_hi) unpack8(*(const v4u*)(src + (ptrdiff_t)(t + 1) * NP), wn[3]);
            else {
#pragma unroll
                for (int e = 0; e < 8; ++e) wn[3][e] = 0.f; }
            float o8[8];
#pragma unroll
            for (int e = 0; e < 8; ++e) { const float sv = bb[e] + wk[0][e] * wn[0][e] + wk[1][e] * wn[1][e] + wk[2][e] * wn[2][e] + wk[3][e] * wn[3][e];
                o8[e] = siluf(sv); wn[0][e] = wn[1][e]; wn[1][e] = wn[2][e]; wn[2][e] = wn[3][e]; }
            const v4u pv = pack8(o8);
            *(LAS v4u*)(img + (t0 + t) * ld + off) = pv;
            if (cglob) *(v4u*)(XCg + (size_t)(r0 + t0 + t) * 256 + 128 * g + off) = pv; }
    }
    __syncthreads();
    const int w = F.wave, fr = lane & 15, fq = lane >> 4;
    {
        bf16x8 ca[4];
#pragma unroll
        for (int ks = 0; ks < 4; ++ks) ca[ks] = *(const LAS bf16x8*)(CG + (16 * w + fr) * SLD + 32 * ks + 8 * fq);
        float afl[4], abl[4];
#pragma unroll
        for (int rg = 0; rg < 4; ++rg) { afl[rg] = AFv[16 * w + 4 * fq + rg]; abl[rg] = ABv[16 * w + 4 * fq + rg]; }
#pragma unroll 2
        for (int st = 0; st < 8; ++st) { f32x4 gacc = {0.f, 0.f, 0.f, 0.f};
#pragma unroll
            for (int ks = 0; ks < 4; ++ks) { const bf16x8 bfr = *(const LAS bf16x8*)(BG + (16 * st + fr) * SLD + 32 * ks + 8 * fq); gacc = MFMA16(ca[ks], bfr, gacc); }
            const int s = 16 * st + fr; const float afs = AFv[s], abs_ = ABv[s], dfs = DTF[s], dbs = DTB[s];
#pragma unroll
            for (int rg = 0; rg < 4; ++rg) { const int l = 16 * w + 4 * fq + rg; float f;
                if (s < l) f = __expf(afl[rg] - afs) * dfs; else if (s > l) f = __expf(abl[rg] - abs_) * dbs; else f = dfs + dbs;
                CG[l * SLD + s] = (bf16_t)f2bf(gacc[rg] * f); } }
    }
    __syncthreads();
    {
        bf16x8 ma[4];
#pragma unroll
        for (int ks = 0; ks < 4; ++ks) ma[ks] = *(const LAS bf16x8*)(CG + (16 * w + fr) * SLD + 32 * ks + 8 * fq);
        const float Dh = A.inp(23)[L * 8 + h]; float* YD = (float*)(ws + WS_YD);
#pragma unroll
        for (int pt = 0; pt < 4; ++pt) { f32x4 acc = {0.f, 0.f, 0.f, 0.f};
#pragma unroll
            for (int ks = 0; ks < 4; ++ks) { const bf16x8 xb = lds_tr_frag(XS, XLD, 32 * ks, 16 * pt, fr, fq); acc = MFMA16(ma[ks], xb, acc); }
#pragma unroll
            for (int rg = 0; rg < 4; ++rg) { const int l = 16 * w + 4 * fq + rg, p = 16 * pt + fr;
                YD[(size_t)(r0 + l) * 512 + 64 * h + p] = acc[rg] + Dh * bf1(XS[l * XLD + p]); } }
    }
    {
        const int d = w >> 2, ptile = w & 3; const LAS float* Wv = d ? WBv : WFv;
        bf16x8 xa[4];
#pragma unroll
        for (int ks = 0; ks < 4; ++ks) { float x8[8]; unpack8(__builtin_bit_cast(v4u, lds_tr_frag(XS, XLD, 32 * ks, 16 * ptile, fr, fq)), x8);
            const f32x4 w0 = *(const LAS f32x4*)(Wv + 32 * ks + 8 * fq), w1 = *(const LAS f32x4*)(Wv + 32 * ks + 8 * fq + 4);
            x8[0] *= w0.x; x8[1] *= w0.y; x8[2] *= w0.z; x8[3] *= w0.w; x8[4] *= w1.x; x8[5] *= w1.y; x8[6] *= w1.z; x8[7] *= w1.w;
            xa[ks] = __builtin_bit_cast(bf16x8, pack8(x8)); }
        float* ST = (float*)(ws + WS_ST) + ((size_t)((c * 2 + d) * 8 + h)) * 8192;
#pragma unroll 2
        for (int nt = 0; nt < 8; ++nt) { f32x4 acc = {0.f, 0.f, 0.f, 0.f};
#pragma unroll
            for (int ks = 0; ks < 4; ++ks) { const bf16x8 bb2 = lds_tr_frag(BG, SLD, 32 * ks, 16 * nt, fr, fq); acc = MFMA16(xa[ks], bb2, acc); }
#pragma unroll
            for (int rg = 0; rg < 4; ++rg) ST[(16 * ptile + 4 * fq + rg) * 128 + 16 * nt + fr] = acc[rg]; }
    }
    __syncthreads();
}

__device__ __forceinline__ void ph_prep(const Fr& F, const PArgs& A, int L) {
    constexpr int N_SSD = 66 * 8, N_LRU = 132 * 4, N_ROPE = TA / 64;
    for (int u = F.vcu; u < N_SSD + N_LRU + N_ROPE; u += F.G) {
        if (u < N_SSD) { if (SUBM & 1) prep_ssd_unit(F, A, L, u); }
        else if (u < N_SSD + N_LRU) { if (SUBM & 2) prep_lru_unit(F, A, L, u - N_SSD); }
        else { if (SUBM & 4) prep_rope_unit(F, A, L, u - N_SSD - N_LRU); }
    }
}

__device__ __forceinline__ void ph_state_scan(const Fr& F, const PArgs& A) {
    unsigned char* ws = A.wsp(); const float* ST = (const float*)(ws + WS_ST); bf16_t* SIN = (bf16_t*)(ws + WS_SIN); unsigned* CH = (unsigned*)(ws + WS_CHA);
    for (int e = F.bid * 512 + F.tid; e < 2 * 65536; e += F.G * 512) {
        const int d = e >> 16, rest = e & 65535, h = rest >> 13;
        float run = 0.f;
#pragma unroll 6
        for (int i = 0; i < 66; ++i) { const int c = d ? (i == 0 ? 1 : (i == 1 ? 0 : 67 - i)) : i; const size_t o = ((size_t)(c * 2 + d) << 16) + rest;
            SIN[o] = (bf16_t)f2bf(run);
            const float dec = __expf(__uint_as_float(__hip_atomic_load(CH + (c * 2 + d) * 8 + h, RLX_AGENT)));
            run = dec * run + ST[o]; }
    }
}
__device__ __forceinline__ void ph_attn(const Fr& F, const PArgs& A, int L) {
    unsigned char* ws = A.wsp();
    const att::bf16* QB = (const att::bf16*)(ws + WS_QB); const att::bf16* KB = (const att::bf16*)(ws + WS_KB); const att::bf16* P = (const att::bf16*)(ws + WS_P); float* O = (float*)(ws + WS_O);
    const int nunits = 384 + (L < DEPTH - 1 ? 12 : 0);
    for (int u = F.vcu; u < nunits; u += F.G) {
        int vh, row0, seq;
        if (u < 384) { vh = u >> 5; row0 = TC + 256 * (u & 31); seq = TA; } else { vh = u - 384; row0 = 0; seq = TC; }
        const int kvh = vh >> 1;
        const att::bf16* Vh = P + (kvh < 4 ? C_DAV + 128 * kvh : C_GV + 128 * (kvh - 4));
        att::attn_dense_body<att::bf16>(QB + (size_t)row0 * QLD + vh * 128, KB + kvh * 128, Vh, O + (size_t)row0 * QLD + vh * 128, seq, F.ldsg);
        __syncthreads();
    }
}

__device__ __forceinline__ void fin_attn_unit(const Fr& F, const PArgs& A, int L, int unit, float lam, float lam_init) {
    unsigned char* ws = A.wsp(); const int lane = F.lane; const float* O = (const float*)(ws + WS_O); bf16_t* Y = (bf16_t*)(ws + WS_YCAT);
    const float* sub = A.inp(11) + L * 128;
    for (int i = 0; i < 8; ++i) {
        const int r = unit * 64 + F.wave * 8 + i; const float* orow = O + (size_t)r * QLD;
        {   const int hh = lane >> 4, d0 = (lane & 15) * 8;
            const f32x4 a0 = *(const f32x4*)(orow + 256 * hh + d0), a1 = *(const f32x4*)(orow + 256 * hh + d0 + 4), b0 = *(const f32x4*)(orow + 256 * hh + 128 + d0), b1 = *(const f32x4*)(orow + 256 * hh + 128 + d0 + 4);
            float o8[8] = {a0.x - lam * b0.x, a0.y - lam * b0.y, a0.z - lam * b0.z, a0.w - lam * b0.w, a1.x - lam * b1.x, a1.y - lam * b1.y, a1.z - lam * b1.z, a1.w - lam * b1.w};
            float ss = 0.f;
#pragma unroll
            for (int e = 0; e < 8; ++e) ss += o8[e] * o8[e];
#pragma unroll
            for (int s = 1; s < 16; s <<= 1) ss += __shfl_xor(ss, s);
            const float rs = (1.0f / sqrtf(ss * (1.f / 128.f) + NEPS)) * (1.f - lam_init);
#pragma unroll
            for (int e = 0; e < 8; ++e) o8[e] = o8[e] * rs * sub[d0 + e];
            *(v4u*)(Y + (size_t)r * DM + 128 * hh + d0) = pack8(o8); }
        {   const f32x4 a0 = *(const f32x4*)(orow + 1024 + 8 * lane), a1 = *(const f32x4*)(orow + 1024 + 8 * lane + 4);
            float o8[8] = {a0.x, a0.y, a0.z, a0.w, a1.x, a1.y, a1.z, a1.w};
            *(v4u*)(Y + (size_t)r * DM + 512 + 8 * lane) = pack8(o8); }
    }
}
__device__ __forceinline__ void fin_lru_unit(const Fr& F, const PArgs& A, int c64) {
    unsigned char* ws = A.wsp(); const int ch = F.tid;
    const float* LS = (const float*)(ws + WS_LSUM);
    float cf = 0.f, cbk = 0.f;
    for (int j0 = 0; j0 < c64; j0 += 8) { float a[8], hh[8];
#pragma unroll
        for (int k = 0; k < 8; ++k) { const int j = min(j0 + k, c64 - 1); a[k] = LS[((size_t)(0 * 132 + j) * 2) * 512 + ch]; hh[k] = LS[((size_t)(0 * 132 + j) * 2 + 1) * 512 + ch]; }
#pragma unroll
        for (int k = 0; k < 8; ++k) { const bool ok = j0 + k < c64; cf = ok ? a[k] * cf + hh[k] : cf; } }
    const int pos = (c64 < 4) ? 3 - c64 : 135 - c64;
    for (int i0 = 0; i0 < pos; i0 += 8) { float a[8], hh[8];
#pragma unroll
        for (int k = 0; k < 8; ++k) { const int i = min(i0 + k, pos - 1), j = (i < 4) ? 3 - i : 135 - i; a[k] = LS[((size_t)(1 * 132 + j) * 2) * 512 + ch]; hh[k] = LS[((size_t)(1 * 132 + j) * 2 + 1) * 512 + ch]; }
#pragma unroll
        for (int k = 0; k < 8; ++k) { const bool ok = i0 + k < pos; cbk = ok ? a[k] * cbk + hh[k] : cbk; } }
    const float* HF = (const float*)(ws + WS_HF); const float* PF = (const float*)(ws + WS_PF); const float* HB = (const float*)(ws + WS_HB); const float* PB = (const float*)(ws + WS_PB);
    const bf16_t* P = (const bf16_t*)(ws + WS_P); bf16_t* Y = (bf16_t*)(ws + WS_YCAT);
#pragma unroll 8
    for (int t = 0; t < 64; ++t) { const size_t r = (size_t)c64 * 64 + t, o = r * 512 + ch;
        const float hf = HF[o] + PF[o] * cf, hb = HB[o] + PB[o] * cbk, gg = bf1(P[r * NP + C_LG + ch]);
        Y[r * DM + 1024 + ch] = (bf16_t)f2bf((hf + hb) * gelu_tanh(gg)); }
}
constexpr int CLD = 264;
__device__ __forceinline__ void fin_ssd_unit(const Fr& F, const PArgs& A, int L, int c) {
    unsigned char* ws = A.wsp(); const int lane = F.lane, tid = F.tid, w = F.wave, fr = lane & 15, fq = lane >> 4, r0 = c * 128;
    LAS bf16_t* CI = (LAS bf16_t*)F.lds;
    LAS float* EF = (LAS float*)(CI + 128 * CLD);
    const bf16_t* XCg = (const bf16_t*)(ws + WS_XC); const float* AC = (const float*)(ws + WS_ACUM);
    for (int id = tid; id < 128 * 32; id += 512) { const int t = id >> 5, q = id & 31; *(LAS v4u*)(CI + t * CLD + 8 * q) = *(const v4u*)(XCg + (size_t)(r0 + t) * 256 + 8 * q); }
    for (int id = tid; id < 128 * 16; id += 512) { const int t = id >> 4, j = id & 15; EF[j * 128 + t] = __expf(AC[(size_t)(r0 + t) * 16 + j]); }
    __syncthreads();
    const bf16_t* SIN = (const bf16_t*)(ws + WS_SIN); const float* YD = (const float*)(ws + WS_YD); float* YD2 = (float*)(ws + WS_YD2); const bf16_t* P = (const bf16_t*)(ws + WS_P);
    float ss[4] = {0.f, 0.f, 0.f, 0.f};
    for (int h = 0; h < 8; ++h) { const int g = h >> 2;
        bf16x8 ca[4];
#pragma unroll
        for (int ks = 0; ks < 4; ++ks) ca[ks] = *(const LAS bf16x8*)(CI + (16 * w + fr) * CLD + 128 * g + 32 * ks + 8 * fq);
        const bf16_t* S0 = SIN + ((size_t)((c * 2 + 0) * 8 + h)) * 8192; const bf16_t* S1 = SIN + ((size_t)((c * 2 + 1) * 8 + h)) * 8192;
        float ef[4], eb[4];
#pragma unroll
        for (int rg = 0; rg < 4; ++rg) { ef[rg] = EF[h * 128 + 16 * w + 4 * fq + rg]; eb[rg] = EF[(8 + h) * 128 + 16 * w + 4 * fq + rg]; }
#pragma unroll 2
        for (int pt = 0; pt < 4; ++pt) { f32x4 a0 = {0.f, 0.f, 0.f, 0.f}, a1 = {0.f, 0.f, 0.f, 0.f};
#pragma unroll
            for (int ks = 0; ks < 4; ++ks) { const bf16x8 b0 = *(const bf16x8*)(S0 + (16 * pt + fr) * 128 + 32 * ks + 8 * fq), b1 = *(const bf16x8*)(S1 + (16 * pt + fr) * 128 + 32 * ks + 8 * fq);
                a0 = MFMA16(ca[ks], b0, a0); a1 = MFMA16(ca[ks], b1, a1); }
#pragma unroll
            for (int rg = 0; rg < 4; ++rg) { const int l = 16 * w + 4 * fq + rg, col = 64 * h + 16 * pt + fr; const size_t r = (size_t)(r0 + l);
                float y = YD[r * 512 + col] + ef[rg] * a0[rg] + eb[rg] * a1[rg];
                y *= siluf(bf1(P[r * NP + C_SZ + col])); YD2[r * 512 + col] = y; ss[rg] += y * y; } }
    }
    const float* nw = A.inp(24) + L * 512; bf16_t* Y = (bf16_t*)(ws + WS_YCAT);
#pragma unroll
    for (int rg = 0; rg < 4; ++rg) {
#pragma unroll
        for (int s = 1; s < 16; s <<= 1) ss[rg] += __shfl_xor(ss[rg], s);
        ss[rg] = 1.0f / sqrtf(ss[rg] * (1.f / 512.f) + NEPS); }
#pragma unroll 4
    for (int ct = 0; ct < 32; ++ct) { const int col = 16 * ct + fr; const float wv = nw[col];
#pragma unroll
        for (int rg = 0; rg < 4; ++rg) { const size_t r = (size_t)(r0 + 16 * w + 4 * fq + rg); Y[r * DM + 1536 + col] = (bf16_t)f2bf(YD2[r * 512 + col] * ss[rg] * wv); } }
    __syncthreads();
}
__device__ __forceinline__ void ph_finish(const Fr& F, const PArgs& A, int L) {
    const float lam_init = 0.8f - 0.6f * expf(-0.3f * (float)L);
    const float* lv = A.inp(10) + L * 256;
    const float s1 = wave_sum(lv[F.lane] * lv[64 + F.lane]), s2 = wave_sum(lv[128 + F.lane] * lv[192 + F.lane]);
    const float lam = expf(s1) - expf(s2) + lam_init;
    const bool need_ctx = L < DEPTH - 1;
    constexpr int N_SSD = 66, N_LRU = 132, N_ATT = TA / 64;
    for (int u = F.vcu; u < N_SSD + N_LRU + N_ATT; u += F.G) {
        if (u < N_SSD) { if ((SUBM & 1) && (need_ctx || u >= 2)) fin_ssd_unit(F, A, L, u); }
        else if (u < N_SSD + N_LRU) { const int c64 = u - N_SSD; if ((SUBM & 2) && (need_ctx || c64 >= 4)) fin_lru_unit(F, A, c64); }
        else { const int un = u - N_SSD - N_LRU; if ((SUBM & 4) && (need_ctx || un >= 4)) fin_attn_unit(F, A, L, un, lam, lam_init); }
    }
}

__device__ __forceinline__ void ph_act(const Fr& F, const PArgs& A, int L, int row_lo) {
    unsigned char* ws = A.wsp(); const bf16_t* GU = (const bf16_t*)(ws + WS_GU); bf16_t* H = (bf16_t*)(ws + WS_H);
    const float* cw = A.inp(26) + (size_t)L * 3 * DFF; const float* cb = A.inp(27) + (size_t)L * DFF;
    constexpr int NCG = DFF / 8;
    const int ntb = (TA - row_lo) / 8;
    for (int it = F.bid * 512 + F.tid; it < ntb * NCG; it += F.G * 512) {
        const int tb = it / NCG, cg = it % NCG, r0 = row_lo + tb * 8, c0 = cg * 8;
        const int seg_lo = (r0 < TC) ? 0 : TC, seg_hi = (r0 < TC) ? TC : TA;
        float w0[8], w1[8], w2[8], bb[8];
#pragma unroll
        for (int e = 0; e < 8; ++e) { w0[e] = cw[c0 + e]; w1[e] = cw[DFF + c0 + e]; w2[e] = cw[2 * DFF + c0 + e]; bb[e] = cb[c0 + e]; }
        float prev[8], cur[8], nxt[8];
        if (r0 - 1 >= seg_lo) unpack8(*(const v4u*)(GU + (size_t)(r0 - 1) * (2 * DFF) + c0), prev); else {
#pragma unroll
            for (int e = 0; e < 8; ++e) prev[e] = 0.f; }
        unpack8(*(const v4u*)(GU + (size_t)r0 * (2 * DFF) + c0), cur);
#pragma unroll
        for (int t = 0; t < 8; ++t) { const int r = r0 + t;
            if (r + 1 < seg_hi) unpack8(*(const v4u*)(GU + (size_t)(r + 1) * (2 * DFF) + c0), nxt); else {
#pragma unroll
                for (int e = 0; e < 8; ++e) nxt[e] = 0.f; }
            float up[8], o8[8]; unpack8(*(const v4u*)(GU + (size_t)r * (2 * DFF) + DFF + c0), up);
#pragma unroll
            for (int e = 0; e < 8; ++e) { const float gt = bb[e] + w0[e] * prev[e] + w1[e] * cur[e] + w2[e] * nxt[e]; o8[e] = siluf(gt) * up[e]; }
            *(v4u*)(H + (size_t)r * DFF + c0) = pack8(o8);
#pragma unroll
            for (int e = 0; e < 8; ++e) { prev[e] = cur[e]; cur[e] = nxt[e]; } }
    }
}

__device__ __forceinline__ void ph_final(const Fr& F, const PArgs& A) {
    const float* X = (const float*)(A.wsp() + WS_X) + (size_t)TC * DM; const float* nw = A.inp(29);
    const int gw = F.bid * NWAVES + F.wave, NGW = F.G * NWAVES, lane = F.lane;
    for (int row = gw; row < TL; row += NGW) {
        const f32x4* xr = (const f32x4*)(X + (size_t)row * DM) + lane; f32x4* orow = (f32x4*)(A.outp() + (size_t)row * DM) + lane;
        f32x4 v[8]; float ss = 0.f;
#pragma unroll
        for (int j = 0; j < 8; ++j) { v[j] = xr[64 * j]; ss += (v[j].x * v[j].x + v[j].y * v[j].y) + (v[j].z * v[j].z + v[j].w * v[j].w); }
        const float rs = 1.0f / sqrtf(wave_sum(ss) * (1.f / DM) + NEPS);
#pragma unroll
        for (int j = 0; j < 8; ++j) { const f32x4 w4 = *(const f32x4*)(nw + 4 * lane + 256 * j); orow[64 * j] = v[j] * rs * w4; }
    }
}

constexpr int N_STEPS = 2 + 10 * DEPTH + 1;
#ifndef PH_MASK
#define PH_MASK 0xFFFF
#endif
#define PHE(b) ((PH_MASK >> (b)) & 1)
#ifndef DBL_MASK
#define DBL_MASK 0
#endif
#define NREP(b) (((DBL_MASK >> (b)) & 1) ? 2 : 1)
#ifndef MK_ONE_LAUNCH
#define MK_ONE_LAUNCH 1
#endif
__global__ void __launch_bounds__(NWAVES * 64, 2) mk_fwd(Args args) {
    extern __shared__ __attribute__((aligned(16))) unsigned char lds[];
    Fr F;
    F.lds = (LAS unsigned char*)lds; F.ldsg = (char*)lds;
    F.tid = threadIdx.x; F.lane = F.tid & 63; F.wave = __builtin_amdgcn_readfirstlane(F.tid >> 6);
    F.G = gridDim.x; F.bid = blockIdx.x; F.vcu = (F.G % 8 == 0) ? (F.bid % 8) * (F.G / 8) + F.bid / 8 : F.bid;
    volatile LAS unsigned* MISC = (volatile LAS unsigned*)(F.lds + MISC_OFF);
    for (int u = F.tid; u < (LDS_BYTES - MISC_OFF) / 4; u += NWAVES * 64) ((LAS unsigned*)(F.lds + MISC_OFF))[u] = 0u;
    __syncthreads();
    if (F.tid == 0) { LAS unsigned long long* tb = (LAS unsigned long long*)(F.lds + TBL_OFF);
#pragma unroll
        for (int i = 0; i < 30; ++i) tb[i] = (unsigned long long)args.in[i];
        tb[30] = (unsigned long long)args.out; tb[31] = (unsigned long long)args.ws; }
    __syncthreads();
    PArgs PA; PA.tbl = (LAS unsigned long long*)(F.lds + TBL_OFF);
    unsigned char* ws = args.ws;
    const int lo = args.s_lo, hi = args.s_hi;
    if (hi - lo > 1) (void)xcd_barrier_post((unsigned*)(ws + WS_CTL) + CW_BAR, MISC + 8);
#define IN(k) (lo <= (k) && (k) < hi)
#define SEAM(k) do { if (IN(k) && IN((k) + 1)) { XcdBarrier b2; b2.bar = (unsigned*)(PA.wsp() + WS_CTL) + CW_BAR; b2.x = xb_xcc_id(); b2.st = MISC + 8; xcd_barrier(b2); } } while (0)

    if (PHE(0) && IN(0)) for (int rep = 0; rep < NREP(0); ++rep) { ph_prologue(F, PA); } SEAM(0);
    if (PHE(1) && IN(1)) { ph_modf(F, PA); } SEAM(1);

    for (int L = 0; L < DEPTH; ++L) {
        const int s0 = 2 + 10 * L;
        { int z = 0; asm volatile("" : "+s"(z)); F.lds = (LAS unsigned char*)lds + z; F.ldsg = (char*)lds + z; PA.tbl = (LAS unsigned long long*)(F.lds + TBL_OFF); MISC = (volatile LAS unsigned*)(F.lds + MISC_OFF); }
        F.tid = tid_opaque(); F.lane = F.tid & 63; ws = PA.wsp();
        const float* modf = (const float*)(ws + WS_MODF); float* X = (float*)(ws + WS_X); bf16_t* XN = (bf16_t*)(ws + WS_XN);
        const float* mod_lat = modf + (size_t)(L * 2 + 0) * 6 * DM; const float* mod_ctx = modf + (size_t)(L * 2 + 1) * 6 * DM;
        const bool need_ctx = L < DEPTH - 1;
        const int rlo = need_ctx ? 0 : TC;
        if (PHE(2) && IN(s0 + 0)) for (int rep = 0; rep < NREP(2); ++rep) { ph_norm<true>(F, X, XN, PA.inp(6) + L * DM, mod_lat, mod_ctx, 0, DM, PA.inp(8) + (size_t)L * DM * NIN, PA.inp(21) + L * 16, (float*)(ws + WS_DT)); }
        SEAM(s0 + 0);
        if (PHE(3) && IN(s0 + 1)) for (int rep = 0; rep < NREP(3); ++rep) {
            pg8::Gemm g{XN, (const bf16_t*)(ws + WS_WIN) + (size_t)L * NP * DM, TA, NP, DM}; pg8::StaticOrder S; S.init(TA, NP, F.G, F.bid);
            pg8::EpiBf16 E{(bf16_t*)(ws + WS_P), NP};
            pg8::gemm_phase<pg8::EpiBf16, pg8::StaticOrder, true, true>(F.lds, g, S, E); }
        SEAM(s0 + 1);
        if (PHE(4) && IN(s0 + 2)) for (int rep = 0; rep < NREP(4); ++rep) { ph_prep(F, PA, L); }
        SEAM(s0 + 2);
        if (PHE(5) && IN(s0 + 3)) for (int rep = 0; rep < NREP(5); ++rep) { ph_state_scan(F, PA); ph_attn(F, PA, L); }
        SEAM(s0 + 3);
        if (PHE(6) && IN(s0 + 4)) for (int rep = 0; rep < NREP(6); ++rep) { ph_finish(F, PA, L); }
        SEAM(s0 + 4);
        if (PHE(7) && IN(s0 + 5)) {
            pg8::Gemm g{(const bf16_t*)(ws + WS_YCAT) + (size_t)rlo * DM, (const bf16_t*)(ws + WS_WOUT) + (size_t)L * DM * DM, TA - rlo, DM, DM}; pg8::StaticOrder S; S.init(TA - rlo, DM, F.G, F.bid);
            pg8::EpiResid E{X + (size_t)rlo * DM, DM, mod_ctx + 2 * DM, mod_lat + 2 * DM, need_ctx ? 1 : 0};
            pg8::gemm_phase<pg8::EpiResid, pg8::StaticOrder, true, true>(F.lds, g, S, E); }
        SEAM(s0 + 5);
        if (PHE(8) && IN(s0 + 6)) for (int rep = 0; rep < NREP(8); ++rep) { ph_norm<false>(F, X, XN, PA.inp(7) + L * DM, mod_lat, mod_ctx, 3 * DM, 4 * DM, nullptr, nullptr, nullptr); }
        SEAM(s0 + 6);
        if (PHE(9) && IN(s0 + 7)) for (int rep = 0; rep < NREP(9); ++rep) {
            pg8::Gemm g{XN + (size_t)rlo * DM, (const bf16_t*)(ws + WS_WUP) + (size_t)L * 2 * DFF * DM, TA - rlo, 2 * DFF, DM}; pg8::StaticOrder S; S.init(TA - rlo, 2 * DFF, F.G, F.bid);
            pg8::EpiBf16 E{(bf16_t*)(ws + WS_GU) + (size_t)rlo * 2 * DFF, 2 * DFF};
            pg8::gemm_phase<pg8::EpiBf16, pg8::StaticOrder, true, true>(F.lds, g, S, E); }
        SEAM(s0 + 7);
        if (PHE(10) && IN(s0 + 8)) for (int rep = 0; rep < NREP(10); ++rep) { ph_act(F, PA, L, rlo); }
        SEAM(s0 + 8);
        if (PHE(11) && IN(s0 + 9)) {
            pg8::Gemm g{(const bf16_t*)(ws + WS_H) + (size_t)rlo * DFF, (const bf16_t*)(ws + WS_WDN) + (size_t)L * DM * DFF, TA - rlo, DM, DFF}; pg8::StaticOrder S; S.init(TA - rlo, DM, F.G, F.bid);
            pg8::EpiResid E{X + (size_t)rlo * DM, DM, mod_ctx + 5 * DM, mod_lat + 5 * DM, need_ctx ? 1 : 0};
            pg8::gemm_phase<pg8::EpiResid, pg8::StaticOrder, true, true>(F.lds, g, S, E); }
        SEAM(s0 + 9);
    }
    if (PHE(12) && IN(N_STEPS - 1)) { ph_final(F, PA); }
#undef IN
#undef SEAM
}

extern "C" void kernel_launch(void* const* d_in, const int* in_sizes, int n_in, void* d_out, int out_size, void* d_ws, size_t ws_size, hipStream_t stream) {
    static int grid = 0;
    if (grid == 0) {
        if (n_in != 30 || out_size != TL * DM || ws_size < WS_END) { fprintf(stderr, "kernel_launch: unexpected shapes: n_in %d out %d ws %zu (need %zu)\n", n_in, out_size, ws_size, (size_t)WS_END); grid = -1; return; }
        int dev = 0, cus = 0, per_cu = 0;
        if (hipGetDevice(&dev) != hipSuccess || hipDeviceGetAttribute(&cus, hipDeviceAttributeMultiprocessorCount, dev) != hipSuccess) { fprintf(stderr, "kernel_launch: device query failed\n"); grid = -1; return; }
        if (hipFuncSetAttribute((const void*)mk_fwd, hipFuncAttributeMaxDynamicSharedMemorySize, LDS_BYTES) != hipSuccess) { fprintf(stderr, "kernel_launch: hipFuncSetAttribute(%d) failed\n", LDS_BYTES); grid = -1; return; }
        if (hipOccupancyMaxActiveBlocksPerMultiprocessor(&per_cu, (const void*)mk_fwd, NWAVES * 64, LDS_BYTES) != hipSuccess || per_cu < 1) { fprintf(stderr, "kernel_launch: occupancy query says %d blocks per CU\n", per_cu); }
        (void)hipGetLastError();
        grid = cus;
    }
    if (grid < 0) return;
    if (hipMemsetAsync((char*)d_ws + WS_CTL, 0, CTL_ZERO_BYTES, stream) != hipSuccess) { fprintf(stderr, "kernel_launch: memset failed\n"); return; }
    Args a{};
    for (int i = 0; i < 30; ++i) a.in[i] = (const float*)d_in[i];
    a.out = (float*)d_out; a.ws = (unsigned char*)d_ws;
#if MK_ONE_LAUNCH
    a.s_lo = 0; a.s_hi = N_STEPS;
    hipLaunchKernelGGL(mk_fwd, dim3(grid), dim3(NWAVES * 64), LDS_BYTES, stream, a);
#else
    for (int s = 0; s < N_STEPS; ++s) { a.s_lo = s; a.s_hi = s + 1; hipLaunchKernelGGL(mk_fwd, dim3(grid), dim3(NWAVES * 64), LDS_BYTES, stream, a); }
#endif
    const hipError_t le = hipPeekAtLastError();
    if (le != hipSuccess) fprintf(stderr, "kernel_launch: launch failed: %s\n", hipGetErrorName(le));
}
```

```cpp
#include <hip/hip_runtime.h>
#include <hip/hip_bf16.h>
#include <cstdio>
#include <cstdint>

__device__ __forceinline__ int tid_opaque() { int t = threadIdx.x; asm volatile("" : "+v"(t)); return t; }

namespace pg8 {
#define PG8_LAS __attribute__((address_space(3)))
typedef unsigned short bf16_t;
typedef short bf16x8 __attribute__((ext_vector_type(8)));
typedef float f32x4 __attribute__((ext_vector_type(4)));
typedef unsigned u32x4 __attribute__((ext_vector_type(4)));
constexpr int BM = 256, BK = 64, HALF = 128, HTB = HALF * BK * 2  , STAGE_BYTES = 8 * HTB, NXCD = 8, WGM = 8;

__host__ __device__ __forceinline__ int lds_byte(int r, int c) { const int st = (r >> 4) * 2 + (c >> 5), rr = r & 15, cc = c & 31, ob = rr * 64 + cc * 2; return st * 1024 + (ob ^ (((ob >> 9) & 1) << 5)); }
__host__ __device__ __forceinline__ void stage_rc(int b, int& R, int& C) { const int st = b / 1024, sb = b % 1024, swz = sb ^ (((sb >> 9) & 1) << 5); R = (st >> 1) * 16 + swz / 64; C = (st & 1) * 32 + (swz % 64) / 2; }
__host__ __device__ __forceinline__ int perm32(int rho) { const int n = rho >> 4, i = rho & 15; return 8 * (i >> 2) + 4 * n + (i & 3); }

struct Unit { int pm, pn; };
struct Gemm { const bf16_t* A; const bf16_t* Bt; int M, N, K; };

struct StaticOrder {
    int nM, nN, nwg, G, c;
    __host__ __device__ void init(int M, int N, int G_, int c_) { nM = M / BM; nN = N / BM; nwg = nM * nN; G = G_; c = c_; }
    __host__ __device__ bool next(int i, Unit& u) const {
        const long L = (long)i * G + c; if (L >= nwg) return false;
        int wgid = (int)L; { const int q = nwg / NXCD, r = nwg % NXCD, xcd = wgid % NXCD, off = wgid / NXCD; wgid = (xcd < r ? xcd * (q + 1) : r * (q + 1) + (xcd - r) * q) + off; }
        const int nig = WGM * nN, gid = wgid / nig, fm = gid * WGM, gsz = (nM - fm) < WGM ? (nM - fm) : WGM;
        u.pm = fm + ((wgid % nig) % gsz); u.pn = (wgid % nig) / gsz; return true;
    }
    __device__ __forceinline__ void a_ready(const Unit&) const {}
    __device__ __forceinline__ void done(const Unit&) const {}
};

__device__ __forceinline__ unsigned cvt_pk_bf16(float lo, float hi) { unsigned r; asm volatile("v_cvt_pk_bf16_f32 %0, %1, %2" : "=v"(r) : "v"(lo), "v"(hi)); return r; }

struct EpiBf16 {
    static constexpr bool PERM = true, AFTER_DRAIN = false;
    bf16_t* O; int ldc;
    __device__ __forceinline__ void operator()(const f32x4 (&acc)[2][2][4][2], const Unit& u, int wr, int wc, int fr, int fq) const {
        const int row0 = u.pm * BM + wr * 64 + fr; const int col0 = u.pn * BM + wc * 32 + 8 * fq;
#pragma unroll
        for (int ai = 0; ai < 2; ++ai)
#pragma unroll
            for (int m = 0; m < 4; ++m) { bf16_t* rowp = O + (size_t)(row0 + ai * HALF + m * 16) * ldc + col0;
#pragma unroll
                for (int bj = 0; bj < 2; ++bj) { const f32x4 v0 = acc[ai][bj][m][0], v1 = acc[ai][bj][m][1];
                    u32x4 w; w.x = cvt_pk_bf16(v0[0], v0[1]); w.y = cvt_pk_bf16(v0[2], v0[3]); w.z = cvt_pk_bf16(v1[0], v1[1]); w.w = cvt_pk_bf16(v1[2], v1[3]);
                    *(u32x4*)(rowp + bj * HALF) = w; } }
    }
};
struct EpiResid {
    static constexpr bool PERM = false, AFTER_DRAIN = false;
    float* X; int ldc; const float* gate_ctx; const float* gate_lat; int ctx_panels;
    __device__ __forceinline__ void operator()(const f32x4 (&acc)[2][2][4][2], const Unit& u, int wr, int wc, int fr, int fq) const {
        const int row0 = u.pm * BM + wr * 64 + fr, col0 = u.pn * BM + wc * 32 + 4 * fq;
        const float* gate = (u.pm < ctx_panels) ? gate_ctx : gate_lat;
        f32x4 gv[2][2];
#pragma unroll
        for (int bj = 0; bj < 2; ++bj)
#pragma unroll
            for (int n = 0; n < 2; ++n) gv[bj][n] = *(const f32x4*)(gate + col0 + bj * HALF + n * 16);
#pragma unroll
        for (int ai = 0; ai < 2; ++ai)
#pragma unroll
            for (int m = 0; m < 4; ++m) { float* rowp = X + (size_t)(row0 + ai * HALF + m * 16) * ldc + col0;
#pragma unroll
                for (int bj = 0; bj < 2; ++bj)
#pragma unroll
                    for (int n = 0; n < 2; ++n) { float* p = rowp + bj * HALF + n * 16; const f32x4 xv = *(const f32x4*)p; *(f32x4*)p = xv + gv[bj][n] * acc[ai][bj][m][n]; }
                asm volatile("" ::: "memory"); }
    }
};

template <class Epi, class Sched, bool ALIGN_EPI = false, bool SP2 = false>
__device__ __forceinline__ void gemm_phase(PG8_LAS unsigned char* lds, const Gemm g, const Sched& S, const Epi& E) {
    const int tid = tid_opaque(), wid = __builtin_amdgcn_readfirstlane(tid >> 6), lane = tid & 63, wr = wid >> 2, wc = wid & 3, fr = lane & 15, fq = lane >> 4;
    const int K = g.K, nt = K / BK;
    unsigned voffA[2], voffB[2];
#pragma unroll
    for (int i = 0; i < 2; ++i) { int R, C; stage_rc(tid * 16 + i * 8192, R, C); const int Rb = Epi::PERM ? ((R & ~31) + perm32(R & 31)) : R;
        voffA[i] = (unsigned)(R * K + C) * 2u; voffB[i] = (unsigned)(Rb * K + C) * 2u; }
    const size_t kstep = (size_t)(BK * 2);
    const size_t hstep = (size_t)HALF * K * 2;
    const size_t tstep = 2 * hstep;
    const unsigned ldsw = (unsigned)wid * 1024u;
    const int aoff = lds_byte(wr * 64 + fr, fq * 8), boff = lds_byte(wc * 32 + fr, fq * 8);
#define PG8_SA(b, h) (((b) * 2 + (h)) * HTB)
#define PG8_SB(b, h) ((4 + (b) * 2 + (h)) * HTB)
#define PG8_STAGE(bufoff, gbase, voff) do { _Pragma("unroll") for (int _i = 0; _i < 2; ++_i) \
        __builtin_amdgcn_global_load_lds((const unsigned*)((const char*)(gbase) + (voff)[_i]), (PG8_LAS unsigned*)(lds + (bufoff) + ldsw + _i * 8192), 16, 0, 0); } while (0)
#define PG8_LDA(dst, b, h) do { _Pragma("unroll") for (int m = 0; m < 4; ++m) _Pragma("unroll") for (int k = 0; k < 2; ++k) dst[m][k] = *(const PG8_LAS bf16x8*)(lds + PG8_SA(b, h) + aoff + m * 2048 + k * 1024); } while (0)
#define PG8_LDB(dst, b, h) do { _Pragma("unroll") for (int n = 0; n < 2; ++n) _Pragma("unroll") for (int k = 0; k < 2; ++k) dst[n][k] = *(const PG8_LAS bf16x8*)(lds + PG8_SB(b, h) + boff + n * 2048 + k * 1024); } while (0)
#define PG8_MMA(ai, bj, At, Bt) do { __builtin_amdgcn_s_setprio(1); _Pragma("unroll") for (int m = 0; m < 4; ++m) _Pragma("unroll") for (int n = 0; n < 2; ++n) _Pragma("unroll") for (int k = 0; k < 2; ++k) \
        acc[ai][bj][m][n] = __builtin_amdgcn_mfma_f32_16x16x32_bf16(Bt[n][k], At[m][k], acc[ai][bj][m][n], 0, 0, 0); __builtin_amdgcn_s_setprio(0); } while (0)
#define PG8_WAIT_V(n) asm volatile("s_waitcnt vmcnt(" #n ")" ::: "memory")
#define PG8_WAIT_L(n) asm volatile("s_waitcnt lgkmcnt(" #n ")" ::: "memory")
#define PG8_BAR __builtin_amdgcn_s_barrier()
#define PG8_SCHED __builtin_amdgcn_sched_barrier(0)
    Unit cur, nxt; int ui = 0;
    if (!S.next(0, cur)) return;
    f32x4 acc[2][2][4][2];
#pragma unroll
    for (int a = 0; a < 2; ++a)
#pragma unroll
        for (int b = 0; b < 2; ++b)
#pragma unroll
            for (int m = 0; m < 4; ++m)
#pragma unroll
                for (int n = 0; n < 2; ++n) acc[a][b][m][n] = (f32x4){0.f, 0.f, 0.f, 0.f};
    bf16x8 At[4][2], B0[2][2], B1[2][2];
    const char* cA = (const char*)g.A + (size_t)cur.pm * tstep; const char* cB = (const char*)g.Bt + (size_t)cur.pn * tstep;
    S.a_ready(cur);
    if constexpr (SP2) {
        PG8_STAGE(PG8_SB(0, 0), cB, voffB); PG8_STAGE(PG8_SB(0, 1), cB + hstep, voffB); PG8_STAGE(PG8_SA(0, 0), cA, voffA); PG8_STAGE(PG8_SA(0, 1), cA + hstep, voffA);
        if (wr == 1) PG8_BAR;
        PG8_WAIT_V(2); PG8_BAR;
        PG8_STAGE(PG8_SB(1, 0), cB + kstep, voffB); PG8_STAGE(PG8_SA(1, 0), cA + kstep, voffA); PG8_STAGE(PG8_SB(1, 1), cB + hstep + kstep, voffB);
        PG8_WAIT_V(6); PG8_BAR;
    } else {
        PG8_STAGE(PG8_SB(0, 0), cB, voffB); PG8_STAGE(PG8_SA(0, 0), cA, voffA); PG8_STAGE(PG8_SB(0, 1), cB + hstep, voffB); PG8_STAGE(PG8_SA(0, 1), cA + hstep, voffA);
        if (wr == 1) PG8_BAR;
        PG8_WAIT_V(4); PG8_BAR;
        PG8_STAGE(PG8_SB(1, 0), cB + kstep, voffB); PG8_STAGE(PG8_SA(1, 0), cA + kstep, voffA); PG8_STAGE(PG8_SB(1, 1), cB + hstep + kstep, voffB);
        PG8_WAIT_V(6); PG8_BAR;
    }
    for (;;) {
        const bool has_next = S.next(ui + 1, nxt);
        const char* nA = has_next ? (const char*)g.A + (size_t)nxt.pm * tstep : cA; const char* nB = has_next ? (const char*)g.Bt + (size_t)nxt.pn * tstep : cB;
        asm volatile(".p2align 8");
        for (int t = 0; t < nt; t += 2) {
            const bool last = (t == nt - 2);
            const char* a1 = cA + (size_t)(t + 1) * kstep;
            const char* a2 = last ? nA : cA + (size_t)(t + 2) * kstep; const char* b2 = last ? nB : cB + (size_t)(t + 2) * kstep;
            const char* a3 = a2 + kstep; const char* b3 = b2 + kstep;
            if (last && has_next) S.a_ready(nxt);
            if constexpr (SP2) {
            PG8_LDB(B0, 0, 0); PG8_LDB(B1, 0, 1); PG8_SCHED; PG8_LDA(At, 0, 0); PG8_STAGE(PG8_SA(1, 1), a1 + hstep, voffA);
            PG8_WAIT_V(8); PG8_WAIT_L(0); PG8_BAR; PG8_MMA(0, 0, At, B0); PG8_MMA(0, 1, At, B1); PG8_BAR; PG8_SCHED;
            PG8_LDA(At, 0, 1); PG8_STAGE(PG8_SB(0, 0), b2, voffB); PG8_STAGE(PG8_SB(0, 1), b2 + hstep, voffB); PG8_STAGE(PG8_SA(0, 0), a2, voffA);
            PG8_WAIT_V(8); PG8_WAIT_L(0); PG8_BAR; PG8_MMA(1, 0, At, B0); PG8_MMA(1, 1, At, B1); PG8_BAR; PG8_SCHED;
            PG8_LDB(B0, 1, 0); PG8_LDB(B1, 1, 1); PG8_SCHED; PG8_LDA(At, 1, 0); PG8_STAGE(PG8_SA(0, 1), a2 + hstep, voffA);
            PG8_WAIT_V(8); PG8_WAIT_L(0); PG8_BAR; PG8_MMA(0, 0, At, B0); PG8_MMA(0, 1, At, B1); PG8_BAR; PG8_SCHED;
            PG8_LDA(At, 1, 1); PG8_STAGE(PG8_SB(1, 0), b3, voffB); PG8_STAGE(PG8_SB(1, 1), b3 + hstep, voffB); PG8_STAGE(PG8_SA(1, 0), a3, voffA);
            PG8_WAIT_V(8); PG8_WAIT_L(0); PG8_BAR; PG8_MMA(1, 0, At, B0); PG8_MMA(1, 1, At, B1); PG8_BAR; PG8_SCHED;
            } else {
            PG8_LDB(B0, 0, 0); PG8_SCHED; PG8_LDA(At, 0, 0); PG8_STAGE(PG8_SA(1, 1), a1 + hstep, voffA);
            PG8_WAIT_L(8); PG8_BAR; PG8_WAIT_L(0); PG8_MMA(0, 0, At, B0); PG8_BAR; PG8_SCHED;
            PG8_LDB(B1, 0, 1); PG8_STAGE(PG8_SB(0, 0), b2, voffB);
            PG8_BAR; PG8_WAIT_L(0); PG8_MMA(0, 1, At, B1); PG8_BAR;
            PG8_LDA(At, 0, 1); PG8_STAGE(PG8_SA(0, 0), a2, voffA);
            PG8_BAR; PG8_WAIT_L(0); PG8_MMA(1, 0, At, B0); PG8_BAR; PG8_SCHED;
            PG8_STAGE(PG8_SB(0, 1), b2 + hstep, voffB);
            PG8_WAIT_V(6); PG8_BAR; PG8_MMA(1, 1, At, B1); PG8_BAR;
            PG8_LDB(B0, 1, 0); PG8_SCHED; PG8_LDA(At, 1, 0); PG8_STAGE(PG8_SA(0, 1), a2 + hstep, voffA);
            PG8_WAIT_L(8); PG8_BAR; PG8_WAIT_L(0); PG8_MMA(0, 0, At, B0); PG8_BAR; PG8_SCHED;
            PG8_LDB(B1, 1, 1); PG8_STAGE(PG8_SB(1, 0), b3, voffB);
            PG8_BAR; PG8_WAIT_L(0); PG8_MMA(0, 1, At, B1); PG8_BAR;
            PG8_LDA(At, 1, 1); PG8_STAGE(PG8_SA(1, 0), a3, voffA);
            PG8_BAR; PG8_WAIT_L(0); PG8_MMA(1, 0, At, B0); PG8_BAR; PG8_SCHED;
            PG8_STAGE(PG8_SB(1, 1), b3 + hstep, voffB);
            PG8_WAIT_V(6); PG8_BAR; PG8_MMA(1, 1, At, B1); PG8_BAR;
            }
        }
        if constexpr (ALIGN_EPI) { if (wr == 0) PG8_BAR; }
        if constexpr (!Epi::AFTER_DRAIN) { E(acc, cur, wr, wc, fr, fq); S.done(cur); }
        if (!has_next) break;
#pragma unroll
        for (int a = 0; a < 2; ++a)
#pragma unroll
            for (int b = 0; b < 2; ++b)
#pragma unroll
                for (int m = 0; m < 4; ++m)
#pragma unroll
                    for (int n = 0; n < 2; ++n) acc[a][b][m][n] = (f32x4){0.f, 0.f, 0.f, 0.f};
        cur = nxt; cA = nA; cB = nB; ++ui;
        if constexpr (ALIGN_EPI) { if (wr == 1) PG8_BAR; }
    }
    PG8_WAIT_V(0);
    if constexpr (!ALIGN_EPI) { if (wr == 0) PG8_BAR; }
    PG8_BAR;
    if constexpr (Epi::AFTER_DRAIN) { E.fused(acc, cur, wr, wc, fr, fq, lds, wid, lane); S.done(cur); }
#undef PG8_SA
#undef PG8_SB
#undef PG8_STAGE
#undef PG8_LDA
#undef PG8_LDB
#undef PG8_MMA
#undef PG8_WAIT_V
#undef PG8_WAIT_L
#undef PG8_BAR
#undef PG8_SCHED
}
}

namespace att {
using bf16 = __hip_bfloat16;
constexpr int   D = 128, NW = 8, QBLK = 32, KVBLK = 64;
constexpr float SCALE = 0.088388347648318440f;
constexpr float THR = 8.f;
constexpr int SDEPTH = 2;
constexpr int LDQ = 1536, LDK = 768, LDV = 5120, LDO = 1536;
constexpr size_t SHM_V = KVBLK * D * 2, SHM_K = KVBLK * D * 2, SHM_ATTN = 2 * SHM_V + 2 * SHM_K + NW * 64 * 4;
using bf16x8 = __attribute__((ext_vector_type(8))) short;
using s16x4  = __attribute__((ext_vector_type(4))) short;
using f32x16 = __attribute__((ext_vector_type(16))) float;
using f32x8  = __attribute__((ext_vector_type(8))) float;
using u32x4  = __attribute__((ext_vector_type(4))) unsigned;
#define KSWZ(row, colB) ((row) * 256 + ((colB) ^ (((row) & 7) << 4)))
#define SBAR() __builtin_amdgcn_sched_barrier(0)
__device__ __forceinline__ int crow(int r, int hi) { return (r & 3) + 8 * (r >> 2) + 4 * hi; }
__device__ __forceinline__ unsigned cvtpk(float lo, float hi) {
  unsigned r; asm volatile("v_cvt_pk_bf16_f32 %0, %1, %2" : "=v"(r) : "v"(lo), "v"(hi)); return r;
}
template <typename TIn> struct Stage;
template <> struct Stage<bf16>  { using T = bf16x8;
  __device__ static __forceinline__ T ld8(const bf16* p) { return *reinterpret_cast<const bf16x8*>(p); }
  __device__ static __forceinline__ bf16x8 tobf(T x) { return x; } };
template <> struct Stage<float> { using T = f32x8;
  __device__ static __forceinline__ T ld8(const float* p) { return *reinterpret_cast<const f32x8*>(p); }
  __device__ static __forceinline__ bf16x8 tobf(T x) {
    u32x4 w = {cvtpk(x[0], x[1]), cvtpk(x[2], x[3]), cvtpk(x[4], x[5]), cvtpk(x[6], x[7])}; return *reinterpret_cast<bf16x8*>(&w); } };

__device__ __forceinline__ void partialSM(f32x16& p0, f32x16& p1, float& m_reg, float& mn, float& alpha) {
  constexpr float C = SCALE * 1.4426950408889634f;
  float pmax = p0[0]; for (int r = 1; r < 16; ++r) pmax = fmaxf(pmax, p0[r]); for (int r = 0; r < 16; ++r) pmax = fmaxf(pmax, p1[r]);
  { auto rr = __builtin_amdgcn_permlane32_swap(__float_as_uint(pmax), __float_as_uint(pmax), false, false);
    pmax = fmaxf(__uint_as_float(rr[0]), __uint_as_float(rr[1])); }
  if (__builtin_expect(__all(pmax - m_reg <= THR / SCALE), 1)) { mn = m_reg; alpha = 1.f; }
  else { mn = fmaxf(m_reg, pmax); alpha = __builtin_amdgcn_exp2f((m_reg - mn) * C); m_reg = mn; }
  float mnC = -mn * C;
  for (int r = 0; r < 16; ++r) p0[r] = fmaf(p0[r], C, mnC); for (int r = 0; r < 16; ++r) p1[r] = fmaf(p1[r], C, mnC);
  for (int r = 0; r < 16; ++r) p0[r] = __builtin_amdgcn_exp2f(p0[r]);
}
__device__ __forceinline__ void finishSM(f32x16& p0, f32x16& p1, float alpha, float& l_reg, bf16x8& pa0, bf16x8& pa1, bf16x8& pa2, bf16x8& pa3) {
  for (int r = 0; r < 16; ++r) p1[r] = __builtin_amdgcn_exp2f(p1[r]);
  float ps = 0; for (int r = 0; r < 16; ++r) ps += p0[r]; for (int r = 0; r < 16; ++r) ps += p1[r];
  { auto rr = __builtin_amdgcn_permlane32_swap(__float_as_uint(ps), __float_as_uint(ps), false, false);
    ps = __uint_as_float(rr[0]) + __uint_as_float(rr[1]); }
  l_reg = l_reg * alpha + ps;
#define PK4(P, BASE, OUT) do { unsigned a0 = cvtpk(P[BASE + 0], P[BASE + 1]), a1 = cvtpk(P[BASE + 2], P[BASE + 3]);   \
    unsigned b0 = cvtpk(P[BASE + 4], P[BASE + 5]), b1 = cvtpk(P[BASE + 6], P[BASE + 7]);                              \
    auto r0 = __builtin_amdgcn_permlane32_swap(a0, b0, false, false); auto r1 = __builtin_amdgcn_permlane32_swap(a1, b1, false, false); \
    u32x4 w = {r0[0], r1[0], r0[1], r1[1]}; OUT = *reinterpret_cast<bf16x8*>(&w); } while (0)
  PK4(p0, 0, pa0); PK4(p0, 8, pa1); PK4(p1, 0, pa2); PK4(p1, 8, pa3);
#undef PK4
}
template <int ND0> __device__ __forceinline__ void qkt(f32x16& p0, f32x16& p1, const bf16* Ks, const bf16x8* qr, int r32, int hi, int kcb) {
  p0 = f32x16{}; p1 = f32x16{};
#pragma unroll
  for (int d0 = 0; d0 < ND0; ++d0) { int cb = (d0 * 16 + hi * 8) * 2 + kcb;
    bf16x8 b0 = *reinterpret_cast<const bf16x8*>((const char*)Ks + KSWZ(r32, cb));
    bf16x8 b1 = *reinterpret_cast<const bf16x8*>((const char*)Ks + KSWZ(32 + r32, cb));
    p0 = __builtin_amdgcn_mfma_f32_32x32x16_bf16(b0, qr[d0], p0, 0, 0, 0);
    p1 = __builtin_amdgcn_mfma_f32_32x32x16_bf16(b1, qr[d0], p1, 0, 0, 0); }
}
__device__ __forceinline__ int v_st(int k, int c) { const int kk = (k & ~0xC) | ((k & 4) << 1) | ((k & 8) >> 1); return ((kk >> 3) * 4 + (c >> 5)) * 512 + ((kk & 7) * 32 + (c & 31)) * 2; }
__device__ __forceinline__ int v_rd_base(int lane) { return ((lane & 3) << 3) | (((lane >> 2) & 3) << 6) | (((lane >> 4) & 1) << 5) | (((lane >> 5) & 1) << 8); }
constexpr int v_rd_off(int d0, int ks, int half) { return d0 * 512 + ks * 4096 + half * 2048; }
template <int OFF> __device__ __forceinline__ s16x4 tr_read(int vb) {
  s16x4 r; asm volatile("ds_read_b64_tr_b16 %0, %1 offset:%2" : "=&v"(r) : "v"(vb), "i"(OFF) : "memory"); return r;
}
template <int D0> __device__ __forceinline__ void pv_one(f32x16& od, int vb, bf16x8 pa0, bf16x8 pa1, bf16x8 pa2, bf16x8 pa3) {
  const s16x4 l0 = tr_read<v_rd_off(D0, 0, 0)>(vb), h0 = tr_read<v_rd_off(D0, 0, 1)>(vb), l1 = tr_read<v_rd_off(D0, 1, 0)>(vb), h1 = tr_read<v_rd_off(D0, 1, 1)>(vb);
  const s16x4 l2 = tr_read<v_rd_off(D0, 2, 0)>(vb), h2 = tr_read<v_rd_off(D0, 2, 1)>(vb), l3 = tr_read<v_rd_off(D0, 3, 0)>(vb), h3 = tr_read<v_rd_off(D0, 3, 1)>(vb);
  asm volatile("s_waitcnt lgkmcnt(0)" ::: "memory"); SBAR();
#define PK(L, H) (bf16x8){L[0], L[1], L[2], L[3], H[0], H[1], H[2], H[3]}
  od = __builtin_amdgcn_mfma_f32_32x32x16_bf16(pa0, PK(l0, h0), od, 0, 0, 0);
  od = __builtin_amdgcn_mfma_f32_32x32x16_bf16(pa1, PK(l1, h1), od, 0, 0, 0);
  od = __builtin_amdgcn_mfma_f32_32x32x16_bf16(pa2, PK(l2, h2), od, 0, 0, 0);
  od = __builtin_amdgcn_mfma_f32_32x32x16_bf16(pa3, PK(l3, h3), od, 0, 0, 0);
#undef PK
}
__device__ __forceinline__ void pv_d0(f32x16* o, int vb, bf16x8 pa0, bf16x8 pa1, bf16x8 pa2, bf16x8 pa3) {
  pv_one<0>(o[0], vb, pa0, pa1, pa2, pa3); pv_one<1>(o[1], vb, pa0, pa1, pa2, pa3); pv_one<2>(o[2], vb, pa0, pa1, pa2, pa3); pv_one<3>(o[3], vb, pa0, pa1, pa2, pa3);
}

template <typename TQ, int ND0, bool PARTIAL>
__device__ __forceinline__ void attn_dense_body(const TQ* __restrict__ Qb, const bf16* __restrict__ Kh, const bf16* __restrict__ Vh,
                                                float* __restrict__ Ob, int seq, char* lds, int kcb, float* __restrict__ ML) {
  using St = Stage<bf16>; using SQ = Stage<TQ>;
  const int tid = tid_opaque(), wid = tid >> 6, lane = tid & 63, r32 = lane & 31, hi = lane >> 5;
  bf16* V_lds = (bf16*)lds; bf16* K_lds = (bf16*)(lds + 2 * SHM_V);
  float* ws = (float*)(lds + 2 * SHM_V + 2 * SHM_K) + wid * 64; float* li_l = ws; float* al_l = ws + 32;
  float m_reg = -1e30f, l_reg = 0; f32x16 o[4] = {}; bf16x8 qr[8];
  const TQ* Qw = Qb + (long)(wid * QBLK + r32) * LDQ + hi * 8;
#pragma unroll
  for (int d0 = 0; d0 < ND0; ++d0) qr[d0] = SQ::tobf(SQ::ld8(Qw + d0 * 16));
  const int sr = tid >> 4, sc = (tid & 15) * 8, vst0 = v_st(sr, sc), vst1 = v_st(32 + sr, sc);
  const int vb0 = (int)(uintptr_t)V_lds + v_rd_base(lane);
  struct { typename St::T vs0, vs1, ks0, ks1; } sr_[SDEPTH];
#define SLOAD(i, k0) do { sr_[i].vs0 = St::ld8(&Vh[(long)((k0) + sr) * LDV + sc]); sr_[i].vs1 = St::ld8(&Vh[(long)((k0) + 32 + sr) * LDV + sc]); \
    sr_[i].ks0 = St::ld8(&Kh[(long)((k0) + sr) * LDK + sc]); sr_[i].ks1 = St::ld8(&Kh[(long)((k0) + 32 + sr) * LDK + sc]); } while (0)
#define SWRITE(b, i) do { *(bf16x8*)((char*)V_lds + (b) * SHM_V + vst0) = St::tobf(sr_[i].vs0);          \
    *(bf16x8*)((char*)V_lds + (b) * SHM_V + vst1) = St::tobf(sr_[i].vs1); int kc = sc * 2;               \
    *(bf16x8*)((char*)K_lds + (b) * SHM_K + KSWZ(sr, kc)) = St::tobf(sr_[i].ks0);                       \
    *(bf16x8*)((char*)K_lds + (b) * SHM_K + KSWZ(32 + sr, kc)) = St::tobf(sr_[i].ks1); } while (0)
#define SWAIT() do { if constexpr (SDEPTH == 2) asm volatile("s_waitcnt vmcnt(4)" ::: "memory"); else asm volatile("s_waitcnt vmcnt(0)" ::: "memory"); } while (0)
#define RESC(a) do { if (__any((a) < 1.f)) { if (hi == 0) al_l[r32] = (a); asm volatile("s_waitcnt lgkmcnt(0)" ::: "memory"); \
    for (int d = 0; d < 4; ++d) for (int r = 0; r < 16; ++r) o[d][r] *= al_l[crow(r, hi)]; } } while (0)
  f32x16 pA0, pA1, pB0, pB1; float mnA, mnB, alA, alB; bf16x8 pa0, pa1, pa2, pa3; const int NT = seq / KVBLK;
  constexpr int SE = 0, SO = SDEPTH - 1;
  SLOAD(SE, 0); asm volatile("s_waitcnt vmcnt(0)" ::: "memory"); SWRITE(0, SE); __syncthreads();
  qkt<ND0>(pA0, pA1, K_lds, qr, r32, hi, kcb); partialSM(pA0, pA1, m_reg, mnA, alA);
  SLOAD(SO, KVBLK); if constexpr (SDEPTH == 2) { if (2 < NT) SLOAD(SE, 2 * KVBLK); }
  SWAIT(); SWRITE(1, SO); __syncthreads();
  asm volatile(".p2align 8");
  for (int j = 1; j + 1 < NT; j += 2) {
    SBAR(); qkt<ND0>(pB0, pB1, (bf16*)((char*)K_lds + SHM_K), qr, r32, hi, kcb);
    finishSM(pA0, pA1, alA, l_reg, pa0, pa1, pa2, pa3); SBAR();
    SLOAD(SO, (j + SDEPTH) * KVBLK); SBAR();
    pv_d0(o, vb0, pa0, pa1, pa2, pa3); partialSM(pB0, pB1, m_reg, mnB, alB);
    __syncthreads(); SWAIT(); SWRITE(0, SE);
    RESC(alB); __syncthreads();
    SBAR(); qkt<ND0>(pA0, pA1, K_lds, qr, r32, hi, kcb);
    finishSM(pB0, pB1, alB, l_reg, pa0, pa1, pa2, pa3); SBAR();
    if (SDEPTH == 1 || j + 3 < NT) SLOAD(SE, (j + 1 + SDEPTH) * KVBLK); SBAR();
    pv_d0(o, vb0 + (int)SHM_V, pa0, pa1, pa2, pa3); partialSM(pA0, pA1, m_reg, mnA, alA);
    __syncthreads(); SWAIT(); SWRITE(1, SO);
    RESC(alA); __syncthreads();
  }
  SBAR(); qkt<ND0>(pB0, pB1, (bf16*)((char*)K_lds + SHM_K), qr, r32, hi, kcb);
  finishSM(pA0, pA1, alA, l_reg, pa0, pa1, pa2, pa3); SBAR();
  pv_d0(o, vb0, pa0, pa1, pa2, pa3); partialSM(pB0, pB1, m_reg, mnB, alB);
  __syncthreads(); RESC(alB);
  finishSM(pB0, pB1, alB, l_reg, pa0, pa1, pa2, pa3); SBAR();
  pv_d0(o, vb0 + (int)SHM_V, pa0, pa1, pa2, pa3);
  if (hi == 0) li_l[r32] = l_reg; asm volatile("s_waitcnt lgkmcnt(0)" ::: "memory");
  float rli[16];
#pragma unroll
  for (int r = 0; r < 16; ++r) rli[r] = PARTIAL ? 1.f : __builtin_amdgcn_rcpf(li_l[crow(r, hi)]);
  if (PARTIAL) { if (hi == 0) { float* mp = ML + (long)(wid * QBLK + r32) * 24; mp[0] = m_reg * (SCALE * 1.4426950408889634f); mp[1] = l_reg; } }
  float* Ow = Ob + (long)(wid * QBLK) * LDO;
#pragma unroll
  for (int r = 0; r < 16; ++r) { int orow = crow(r, hi);
    for (int d0 = 0; d0 < 4; ++d0) Ow[(long)orow * LDO + d0 * 32 + r32] = o[d0][r] * rli[r]; }
#undef SLOAD
#undef SWRITE
#undef SWAIT
#undef RESC
}
}

#define GAS __attribute__((address_space(1)))
typedef unsigned short bf16_t;
typedef unsigned v4u __attribute__((ext_vector_type(4)));
typedef unsigned v2u __attribute__((ext_vector_type(2)));
typedef float f32x4 __attribute__((ext_vector_type(4)));
typedef float f32x2 __attribute__((ext_vector_type(2)));
typedef short bf16x8 __attribute__((ext_vector_type(8)));

constexpr int DM = 2048, TL = 8192, TC = 256, TA = TL + TC, DEPTH = 4, DFF = 5632;
constexpr int NP = 5120, NIN = 5136;
constexpr int C_DAQ = 0, C_DAK = 512, C_DAV = 1024, C_GQ = 1536, C_GK = 2048, C_GV = 2304, C_LX = 2560, C_LG = 3072, C_SZ = 3584, C_SX = 4096, C_SB = 4608, C_SC = 4864, C_DT = 5120;
constexpr int QLD = 1536, KLD = 768;
constexpr float NEPS = 1e-6f;
constexpr int NWAVES = 8;
#ifndef FIN_INPLACE
#define FIN_INPLACE 1
#endif
#ifndef SUBM
#define SUBM 7
#endif

constexpr size_t MiB = 1u << 20;
constexpr size_t WS_CTL = 0, CTL_ZERO_BYTES = 1 * MiB;
constexpr size_t WS_WIN = 2 * MiB, WS_WOUT = 82 * MiB, WS_WUP = 114 * MiB, WS_WDN = 290 * MiB, WS_WG = 378 * MiB;
constexpr size_t WS_MODP = 380 * MiB, WS_MODF = 383 * MiB, WS_ROPE = 384 * MiB;
constexpr size_t WS_X = 385 * MiB, WS_XN = 451 * MiB, WS_P = 484 * MiB, WS_QB = 567 * MiB, WS_KB = 592 * MiB, WS_O = 605 * MiB;
constexpr size_t WS_DT = 655 * MiB, WS_ACUM = 656 * MiB, WS_HF = 657 * MiB, WS_PF = 674 * MiB, WS_HB = 691 * MiB, WS_PB = 708 * MiB, WS_LSUM = 725 * MiB;
constexpr size_t WS_YD = 727 * MiB, WS_XC = 744 * MiB, WS_ST = 749 * MiB, WS_SIN = 782 * MiB, WS_CHA = 799 * MiB;
constexpr size_t WS_YCAT = 800 * MiB, WS_GU = 833 * MiB, WS_H = 1015 * MiB, WS_OP1 = 1106 * MiB, WS_ML = 1156 * MiB, WS_YD2 = 1158 * MiB, WS_END = 1175 * MiB;
static_assert(WS_WIN + 4ull * NP * DM * 2 <= WS_WOUT && WS_WOUT + 4ull * DM * DM * 2 <= WS_WUP && WS_WUP + 4ull * 2 * DFF * DM * 2 <= WS_WDN && WS_WDN + 4ull * DM * DFF * 2 <= WS_WG, "weights map");
static_assert(WS_X + (size_t)TA * DM * 4 <= WS_XN && WS_XN + (size_t)TA * DM * 2 <= WS_P && WS_P + (size_t)TA * NP * 2 <= WS_QB && WS_QB + (size_t)TA * QLD * 2 <= WS_KB && WS_KB + (size_t)TA * KLD * 2 <= WS_O && WS_O + (size_t)TA * QLD * 4 <= WS_DT, "act map 1");
static_assert(WS_HF + (size_t)TA * 512 * 4 <= WS_PF && WS_LSUM + 132ull * 2 * 2 * 512 * 4 <= WS_YD && WS_YD + (size_t)TA * 512 * 4 <= WS_XC && WS_XC + (size_t)TA * 256 * 2 <= WS_ST && WS_ST + 66ull * 2 * 65536 * 4 <= WS_SIN && WS_SIN + 66ull * 2 * 65536 * 2 <= WS_CHA, "act map 2");
static_assert(WS_YCAT + (size_t)TA * DM * 2 <= WS_GU && WS_GU + (size_t)TA * 2 * DFF * 2 <= WS_H && WS_H + (size_t)TA * DFF * 2 <= WS_END, "act map 3");
constexpr int CW_BAR = 4096;

constexpr int PH_LDS = 147456;
constexpr int MISC_OFF = PH_LDS;
constexpr int LDS_BYTES = PH_LDS + 1024;

#define LAS __attribute__((address_space(3)))
#define LDS_WAIT() asm volatile("s_waitcnt lgkmcnt(0)" ::: "memory")
#define VM_WAIT() asm volatile("s_waitcnt vmcnt(0)" ::: "memory")
#define RLX_AGENT __ATOMIC_RELAXED, __HIP_MEMORY_SCOPE_AGENT

__device__ __forceinline__ unsigned f2bf(float f) { unsigned u = __builtin_bit_cast(unsigned, f); return (u + 0x7fffu + ((u >> 16) & 1u)) >> 16; }
__device__ __forceinline__ unsigned pk2(float lo, float hi) { unsigned r; asm volatile("v_cvt_pk_bf16_f32 %0, %1, %2" : "=v"(r) : "v"(lo), "v"(hi)); return r; }
__device__ __forceinline__ float bflo(unsigned w) { return __uint_as_float(w << 16); }
__device__ __forceinline__ float bfhi(unsigned w) { return __uint_as_float(w & 0xffff0000u); }
__device__ __forceinline__ float bf1(bf16_t b) { return __uint_as_float(((unsigned)b) << 16); }
__device__ __forceinline__ void unpack8(const v4u w, float (&x)[8]) { x[0] = bflo(w.x); x[1] = bfhi(w.x); x[2] = bflo(w.y); x[3] = bfhi(w.y); x[4] = bflo(w.z); x[5] = bfhi(w.z); x[6] = bflo(w.w); x[7] = bfhi(w.w); }
__device__ __forceinline__ v4u pack8(const float (&x)[8]) { v4u w; w.x = pk2(x[0], x[1]); w.y = pk2(x[2], x[3]); w.z = pk2(x[4], x[5]); w.w = pk2(x[6], x[7]); return w; }
__device__ __forceinline__ float wave_sum(float v) {
#pragma unroll
    for (int o = 1; o < 64; o <<= 1) v += __shfl_xor(v, o);
    return v;
}
__device__ __forceinline__ float siluf(float x) { return x / (1.f + __expf(-x)); }
__device__ __forceinline__ float sigmf(float x) { return 1.f / (1.f + __expf(-x)); }
__device__ __forceinline__ float softplusf(float x) { return fmaxf(x, 0.f) + log1pf(__expf(-fabsf(x))); }
__device__ __forceinline__ float gelu_tanh(float x) { const float u = 0.7978845608028654f * (x + 0.044715f * x * x * x); return 0.5f * x * (1.f + tanhf(u)); }
#define MFMA16(a, b, c) __builtin_amdgcn_mfma_f32_16x16x32_bf16((a), (b), (c), 0, 0, 0)

struct Fr { LAS unsigned char* lds; char* ldsg; int tid, lane, wave, G, bid, vcu; };
__device__ __forceinline__ Fr fr_refresh(const Fr& F0) { Fr F = F0; F.tid = tid_opaque(); F.lane = F.tid & 63; F.wave = __builtin_amdgcn_readfirstlane(F.tid >> 6); return F; }

struct Args { const float* in[30]; float* out; unsigned char* ws; int s_lo, s_hi; };
constexpr int TBL_OFF = PH_LDS + 256;
struct PArgs { LAS unsigned long long* tbl;
    __device__ __forceinline__ unsigned long long get(int k) const { const unsigned long long v = tbl[k];
        const unsigned lo = __builtin_amdgcn_readfirstlane((unsigned)v), hi = __builtin_amdgcn_readfirstlane((unsigned)(v >> 32)); return ((unsigned long long)hi << 32) | lo; }
    __device__ __forceinline__ const float* inp(int k) const { return (const float*)(const GAS float*)get(k); }
    __device__ __forceinline__ float* outp() const { return (float*)(GAS float*)get(30); }
    __device__ __forceinline__ unsigned char* wsp() const { return (unsigned char*)(GAS unsigned char*)get(31); }
};


#define XB_TMO      128
#define XB_XCNT(j)  (256  + 64 * (j))
#define XB_XSUB(j)  (1280 + 64 * (j))
#define XB_XGEN(j)  (2304 + 64 * (j))
#define XB_TOP      3328
#define XB_TOPGEN   3392
#define XCD_BAR_WORDS 3456
#define XB_SPIN_CAP (1u << 18)

__device__ __forceinline__ unsigned xb_ld(unsigned* p)              { return __hip_atomic_load(p, __ATOMIC_RELAXED, __HIP_MEMORY_SCOPE_AGENT); }
__device__ __forceinline__ unsigned xb_add(unsigned* p, unsigned v) { return __hip_atomic_fetch_add(p, v, __ATOMIC_RELAXED, __HIP_MEMORY_SCOPE_AGENT); }
__device__ __forceinline__ unsigned xb_xcc_id() { return (unsigned)__builtin_amdgcn_s_getreg((3 << 11) | 20) & 0xFu; }
#define XB_SPIN(cond, bar) do { unsigned _sp = 0; while (cond) { __builtin_amdgcn_s_sleep(1); \
    if ((++_sp & 255u) == 0u) { if (xb_ld(&(bar)[XB_TMO])) break; if (_sp > XB_SPIN_CAP) { atomicAdd(&(bar)[XB_TMO], 1u); break; } } } } while (0)

struct XcdBarrier {
    unsigned* bar; unsigned x;
    volatile LAS unsigned* st;
};

__device__ __forceinline__ XcdBarrier xcd_barrier_post(unsigned* bar, volatile LAS unsigned* st) {
    XcdBarrier b; b.bar = bar; b.x = xb_xcc_id(); b.st = st;
    if (threadIdx.x == 0) (void)xb_add(&bar[XB_XCNT(b.x)], 1u);
    return b;
}
__device__ __forceinline__ void xcd_barrier_complete(unsigned* bar, unsigned x, unsigned& nloc, unsigned& nx) {
    const unsigned G = gridDim.x * gridDim.y * gridDim.z;
    unsigned sum, cnt, mine, sp = 0u;
    for (;;) {
        sum = 0u; cnt = 0u; mine = 0u;
#pragma unroll
        for (unsigned j = 0; j < 16; ++j) { const unsigned c = xb_ld(&bar[XB_XCNT(j)]); sum += c; cnt += (c > 0u) ? 1u : 0u; mine = (j == x) ? c : mine; }
        if (sum == G) break;
        __builtin_amdgcn_s_sleep(1);
        if ((++sp & 255u) == 0u) { if (xb_ld(&bar[XB_TMO])) break; if (sp > XB_SPIN_CAP) { atomicAdd(&bar[XB_TMO], 1u); break; } }
    }
    nloc = mine > 0u ? mine : 1u; nx = cnt > 0u ? cnt : 1u;
}

__device__ __forceinline__ void xcd_barrier(const XcdBarrier& b) {
    asm volatile("s_waitcnt vmcnt(0)" ::: "memory");
    __syncthreads();
    if (threadIdx.x == 0) {
        unsigned* bar = b.bar;
        __builtin_amdgcn_s_waitcnt(0);
        unsigned nloc = b.st[0], nx = b.st[1];
        if (nloc == 0u) { xcd_barrier_complete(bar, b.x, nloc, nx); b.st[0] = nloc; b.st[1] = nx; }
        const unsigned old = xb_add(&bar[XB_XSUB(b.x)], 1u);
        const unsigned gen = old / nloc;
        if (old + 1u == (gen + 1u) * nloc) {
            __builtin_amdgcn_fence(__ATOMIC_RELEASE, "agent");
            asm volatile("s_waitcnt vmcnt(0)" ::: "memory");
            const unsigned og = xb_add(&bar[XB_TOP], 1u);
            const unsigned tg = og / nx;
            if (og + 1u == (tg + 1u) * nx) xb_add(&bar[XB_TOPGEN], 1u);
            else XB_SPIN(xb_ld(&bar[XB_TOPGEN]) == tg, bar);
            __builtin_amdgcn_fence(__ATOMIC_ACQUIRE, "agent");
            xb_add(&bar[XB_XGEN(b.x)], 1u);
            asm volatile("s_waitcnt vmcnt(0)" ::: "memory");
        } else {
            XB_SPIN(xb_ld(&bar[XB_XGEN(b.x)]) == gen, bar);
            __builtin_amdgcn_fence(__ATOMIC_ACQUIRE, "agent");
            asm volatile("s_waitcnt vmcnt(0)" ::: "memory");
        }
    }
    __syncthreads();
}

__device__ __forceinline__ void tr_item(const float* W, int ldW, int Nuse, bf16_t* WT, int K, LAS float* scr, int item, int lane) {
    const int nblk = Nuse / 32, kb = item / nblk, nb = item % nblk, k0 = 64 * kb, n0 = 32 * nb;
#pragma unroll 8
    for (int i = 0; i < 32; ++i) { const int kk = 2 * i + (lane >> 5); scr[kk * 33 + (lane & 31)] = W[(size_t)(k0 + kk) * ldW + n0 + (lane & 31)]; }
    LDS_WAIT(); asm volatile("" ::: "memory");
    const int c = lane & 7;
#pragma unroll
    for (int j = 0; j < 4; ++j) { const int n = (lane >> 3) + 8 * j; const LAS float* s = scr + (8 * c) * 33 + n;
        v4u o; o.x = pk2(s[0 * 33], s[1 * 33]); o.y = pk2(s[2 * 33], s[3 * 33]); o.z = pk2(s[4 * 33], s[5 * 33]); o.w = pk2(s[6 * 33], s[7 * 33]);
        *(v4u*)(WT + (size_t)(n0 + n) * K + k0 + 8 * c) = o; }
    LDS_WAIT(); asm volatile("" ::: "memory");
}
__device__ __forceinline__ void sincos_small(float x, float& s, float& c) {
    const float q = rintf(x * 0.6366197723675814f); const int n = (int)q;
    float r = fmaf(q, -1.5703125f, x); r = fmaf(q, -4.837512969970703125e-4f, r); r = fmaf(q, -7.54978995489188216e-8f, r);
    const float z = r * r;
    const float sp = r + r * z * (-1.6666654611e-1f + z * (8.3321608736e-3f + z * (-1.9515295891e-4f)));
    const float cp = 1.f - 0.5f * z + z * z * (4.166664568298827e-2f + z * (-1.388731625493765e-3f + z * 2.443315711809948e-5f));
    switch (n & 3) { case 0: s = sp; c = cp; break; case 1: s = cp; c = -sp; break; case 2: s = -sp; c = -cp; break; default: s = -cp; c = sp; break; }
}
__device__ __forceinline__ void ph_prologue(const Fr& F0, const PArgs& A) {
    const Fr F = fr_refresh(F0);
    unsigned char* ws = A.wsp();
    const int gw = F.bid * NWAVES + F.wave, NGW = F.G * NWAVES;
    LAS float* scr = (LAS float*)(F.lds + F.wave * 8704);
    constexpr int I_IN = 32 * 160, I_OUT = 32 * 64, I_UP = 32 * 352, I_DN = 88 * 64, I_WG = 16 * 8, I_L = I_IN + I_OUT + I_UP + I_DN + I_WG;
    for (int it = gw; it < DEPTH * I_L; it += NGW) {
        const int L = it / I_L; int r = it % I_L;
        if (r < I_IN) { tr_item(A.inp(8) + (size_t)L * DM * NIN, NIN, NP, (bf16_t*)(ws + WS_WIN) + (size_t)L * NP * DM, DM, scr, r, F.lane); continue; } r -= I_IN;
        if (r < I_OUT) { tr_item(A.inp(9) + (size_t)L * DM * DM, DM, DM, (bf16_t*)(ws + WS_WOUT) + (size_t)L * DM * DM, DM, scr, r, F.lane); continue; } r -= I_OUT;
        if (r < I_UP) { tr_item(A.inp(25) + (size_t)L * DM * 2 * DFF, 2 * DFF, 2 * DFF, (bf16_t*)(ws + WS_WUP) + (size_t)L * 2 * DFF * DM, DM, scr, r, F.lane); continue; } r -= I_UP;
        if (r < I_DN) { tr_item(A.inp(28) + (size_t)L * DFF * DM, DM, DM, (bf16_t*)(ws + WS_WDN) + (size_t)L * DM * DFF, DFF, scr, r, F.lane); continue; } r -= I_DN;
        { const int mi = r / 8; tr_item(A.inp(16) + (size_t)(L * 16 + mi) * 16384, 128, 128, (bf16_t*)(ws + WS_WG) + (size_t)(L * 16 + mi) * 16384, 128, scr, r % 8, F.lane); }
    }
    float* modp = (float*)(ws + WS_MODP);
    for (int it = gw; it < DEPTH * 48 * 8; it += NGW) {
        const int L = it / 384, r = it % 384, nb = r / 8, ks = r % 8, k0 = ks * 256;
        f32x4 c0 = *(const f32x4*)(A.inp(1) + k0 + 4 * F.lane), c1 = *(const f32x4*)(A.inp(3) + k0 + 4 * F.lane);
#pragma unroll
        for (int i = 0; i < 4; ++i) { c0[i] = siluf(c0[i]); c1[i] = siluf(c1[i]); }
        f32x4 a0 = {0.f, 0.f, 0.f, 0.f}, a1 = {0.f, 0.f, 0.f, 0.f};
        const float* wp = A.inp(4) + ((size_t)(L * DM + k0)) * (6 * DM) + nb * 256 + 4 * F.lane;
#pragma unroll 2
        for (int q = 0; q < 64; ++q) {
#pragma unroll
            for (int i = 0; i < 4; ++i) {
                const float s0 = __uint_as_float(__builtin_amdgcn_readlane(__float_as_uint(c0[i]), q)), s1 = __uint_as_float(__builtin_amdgcn_readlane(__float_as_uint(c1[i]), q));
                const f32x4 w = *(const f32x4*)(wp + (size_t)(4 * q + i) * (6 * DM));
                a0 += s0 * w; a1 += s1 * w; }
        }
        *(f32x4*)(modp + ((size_t)((L * 8 + ks) * 2 + 0)) * (6 * DM) + nb * 256 + 4 * F.lane) = a0;
        *(f32x4*)(modp + ((size_t)((L * 8 + ks) * 2 + 1)) * (6 * DM) + nb * 256 + 4 * F.lane) = a1;
    }
    { const int gt = F.bid * 512 + F.tid, NT = F.G * 512; f32x4* X4 = (f32x4*)(ws + WS_X);
      const f32x4* c4 = (const f32x4*)A.inp(2); const f32x4* x4 = (const f32x4*)A.inp(0);
      constexpr int NC4 = TC * DM / 4, NA4 = TA * DM / 4;
      for (int i = gt; i < NA4; i += NT) X4[i] = (i < NC4) ? c4[i] : x4[i - NC4]; }
    { const int gt = F.bid * 512 + F.tid; if (gt < 128 * 48) { const int pos = gt / 48, f = gt % 48;
        const float fr = (f < 16) ? powf(10000.f, -(float)f / 16.f) : powf(10000.f, -(float)(f - 16) / 32.f);
        float s, c; sincos_small((float)pos * fr, s, c); ((f32x2*)(ws + WS_ROPE))[gt] = (f32x2){c, s}; } }
}
__device__ __forceinline__ void ph_modf(const Fr& F0, const PArgs& A) {
    const Fr F = fr_refresh(F0);
    const float* modp = (const float*)(A.wsp() + WS_MODP); float* modf = (float*)(A.wsp() + WS_MODF);
    for (int i = F.bid * 512 + F.tid; i < DEPTH * 2 * 6 * DM; i += F.G * 512) {
        const int L = i / (2 * 6 * DM), r = i % (2 * 6 * DM), cd = r / (6 * DM), n = r % (6 * DM);
        float s = A.inp(5)[L * 6 * DM + n];
#pragma unroll
        for (int ks = 0; ks < 8; ++ks) s += modp[((size_t)((L * 8 + ks) * 2 + cd)) * (6 * DM) + n];
        modf[i] = s; }
}

template <bool DTP>
__device__ __forceinline__ void ph_norm(const Fr& F0, const float* X, bf16_t* XN, const float* nw, const float* mod_lat, const float* mod_ctx, int sh_off, int sc_off,
                                        const float* win_layer, const float* dt_bias, float* DT) {
    const Fr F = fr_refresh(F0);
    LAS float* AL = (LAS float*)F.lds; LAS float* BL = AL + DM; LAS float* WDT = BL + DM;
    for (int k = F.tid; k < DM; k += 512) { AL[k] = nw[k] * (1.f + mod_lat[sc_off + k]); BL[k] = mod_lat[sh_off + k]; }
    if (DTP) for (int idx = F.tid; idx < DM * 16; idx += 512) { const int k = idx >> 4, j = idx & 15; WDT[j * DM + k] = win_layer[(size_t)k * NIN + C_DT + j]; }
    __syncthreads();
    const int gw = F.bid * NWAVES + F.wave, NGW = F.G * NWAVES, lane = F.lane;
    for (int row = gw; row < TA; row += NGW) {
        const f32x4* xr = (const f32x4*)(X + (size_t)row * DM) + lane;
        f32x4 v[8]; float ss = 0.f;
#pragma unroll
        for (int j = 0; j < 8; ++j) { v[j] = xr[64 * j]; ss += (v[j].x * v[j].x + v[j].y * v[j].y) + (v[j].z * v[j].z + v[j].w * v[j].w); }
        const float rs = 1.0f / sqrtf(wave_sum(ss) * (1.f / DM) + NEPS);
        const bool isctx = row < TC;
        v2u* o8 = (v2u*)(XN + (size_t)row * DM) + lane;
#pragma unroll
        for (int j = 0; j < 8; ++j) { const int k = 4 * lane + 256 * j; f32x4 a4, b4;
            if (isctx) { const f32x4 w4 = *(const f32x4*)(nw + k), s4 = *(const f32x4*)(mod_ctx + sc_off + k); a4 = w4 * (1.f + s4); b4 = *(const f32x4*)(mod_ctx + sh_off + k); }
            else { a4 = *(const LAS f32x4*)(AL + k); b4 = *(const LAS f32x4*)(BL + k); }
            v[j] = v[j] * rs * a4 + b4;
            v2u o; o.x = pk2(v[j].x, v[j].y); o.y = pk2(v[j].z, v[j].w); o8[64 * j] = o; }
        if (DTP) {
            float acc[16];
#pragma unroll
            for (int jj = 0; jj < 16; ++jj) acc[jj] = 0.f;
#pragma unroll
            for (int j = 0; j < 8; ++j)
#pragma unroll
                for (int jj = 0; jj < 16; ++jj) { const f32x4 w4 = *(const LAS f32x4*)(WDT + jj * DM + 4 * lane + 256 * j);
                    acc[jj] += (v[j].x * w4.x + v[j].y * w4.y) + (v[j].z * w4.z + v[j].w * w4.w); }
            float r8[8], r4[4], r2[2], r1;
#pragma unroll
            for (int i = 0; i < 8; ++i) { const bool up = (lane & 32) != 0; const float keep = up ? acc[i + 8] : acc[i], send = up ? acc[i] : acc[i + 8]; r8[i] = keep + __shfl_xor(send, 32); }
#pragma unroll
            for (int i = 0; i < 4; ++i) { const bool up = (lane & 16) != 0; const float keep = up ? r8[i + 4] : r8[i], send = up ? r8[i] : r8[i + 4]; r4[i] = keep + __shfl_xor(send, 16); }
#pragma unroll
            for (int i = 0; i < 2; ++i) { const bool up = (lane & 8) != 0; const float keep = up ? r4[i + 2] : r4[i], send = up ? r4[i] : r4[i + 2]; r2[i] = keep + __shfl_xor(send, 8); }
            { const bool up = (lane & 4) != 0; const float keep = up ? r2[1] : r2[0], send = up ? r2[0] : r2[1]; r1 = keep + __shfl_xor(send, 4); }
            r1 += __shfl_xor(r1, 2); r1 += __shfl_xor(r1, 1);
            const int col = ((lane >> 5) & 1) * 8 + ((lane >> 4) & 1) * 4 + ((lane >> 3) & 1) * 2 + ((lane >> 2) & 1);
            if ((lane & 3) == 0) DT[(size_t)row * 16 + col] = softplusf(r1 + dt_bias[col]);
        }
    }
    __syncthreads();
}

__device__ __forceinline__ void prep_rope_unit(const Fr& F, const PArgs& A, int L, int unit) {
    unsigned char* ws = A.wsp(); const int lane = F.lane;
    const bf16_t* P = (const bf16_t*)(ws + WS_P); bf16_t* QB = (bf16_t*)(ws + WS_QB); bf16_t* KB = (bf16_t*)(ws + WS_KB);
    const f32x2* RT = (const f32x2*)(ws + WS_ROPE);
    const float* qn = A.inp(12) + L * 128; const float* kn = A.inp(13) + L * 128;
    for (int i = 0; i < 8; ++i) {
        const int r = unit * 64 + F.wave * 8 + i; const bool lat = r >= TC; const int t = r - TC, prow = lat ? (t >> 6) : 0, pcol = lat ? (t & 63) : 0;
        const bf16_t* pr = P + (size_t)r * NP;
        {   const int hd = lane >> 3, o = (lane & 7) * 8, axis = o >> 5, p = o & 31, fi = p & 15; const bool first = p < 16; const int pos = axis ? pcol : prow;
            float xq[8], xk[8], yq[8], yk[8];
            unpack8(*(const v4u*)(pr + C_DAQ + 8 * lane), xq); unpack8(*(const v4u*)(pr + C_DAK + 8 * lane), xk);
#pragma unroll
            for (int e = 0; e < 8; ++e) { const float pq = __shfl_xor(xq[e], 2), pk = __shfl_xor(xk[e], 2);
                f32x2 cs = lat ? RT[pos * 48 + fi + e] : (f32x2){1.f, 0.f};
                const float sg = first ? -cs.y : cs.y;
                yq[e] = (xq[e] * cs.x + pq * sg) * 1.41421356237f; yk[e] = xk[e] * cs.x + pk * sg; }
            bf16_t* qd = QB + (size_t)r * QLD + hd * 128; const int m = hd & 1;
            *(v4u*)(qd + m * 64 + o) = pack8(yq); { unsigned zz = 0u; asm volatile("" : "+v"(zz)); *(v4u*)(qd + (1 - m) * 64 + o) = (v4u){zz, zz, zz, zz}; }
            *(v4u*)(KB + (size_t)r * KLD + 8 * lane) = pack8(yk);
        }
        {   const int o = (lane & 15) * 8, axis = o >> 6, p = o & 63, fi = p & 31; const bool first = p < 32; const int pos = axis ? pcol : prow;
            const int lk = lane & 31;
            float xq[8], xk[8], yq[8], yk[8];
            unpack8(*(const v4u*)(pr + C_GQ + 8 * lane), xq); unpack8(*(const v4u*)(pr + C_GK + 8 * lk), xk);
            float sq = 0.f, sk = 0.f;
#pragma unroll
            for (int e = 0; e < 8; ++e) { sq += xq[e] * xq[e]; sk += xk[e] * xk[e]; }
#pragma unroll
            for (int s = 1; s < 16; s <<= 1) { sq += __shfl_xor(sq, s); sk += __shfl_xor(sk, s); }
            const float rq = 1.0f / sqrtf(sq * (1.f / 128.f) + NEPS), rk = 1.0f / sqrtf(sk * (1.f / 128.f) + NEPS);
#pragma unroll
            for (int e = 0; e < 8; ++e) { xq[e] = xq[e] * rq * qn[o + e]; xk[e] = xk[e] * rk * kn[o + e]; }
#pragma unroll
            for (int e = 0; e < 8; ++e) { const float pq = __shfl_xor(xq[e], 4), pk = __shfl_xor(xk[e], 4);
                f32x2 cs = lat ? RT[pos * 48 + 16 + fi + e] : (f32x2){1.f, 0.f};
                const float sg = first ? -cs.y : cs.y;
                yq[e] = xq[e] * cs.x + pq * sg; yk[e] = xk[e] * cs.x + pk * sg; }
            *(v4u*)(QB + (size_t)r * QLD + 1024 + 8 * lane) = pack8(yq);
            if (lane < 32) *(v4u*)(KB + (size_t)r * KLD + 512 + 8 * lane) = pack8(yk);
        }
    }
}

__device__ __forceinline__ void prep_lru_unit(const Fr& F, const PArgs& A, int L, int unit) {
    unsigned char* ws = A.wsp(); const int lane = F.lane, tid = F.tid, c64 = unit >> 2, blk = unit & 3, r0 = c64 * 64;
    const int seg_lo = (r0 < TC) ? 0 : TC, seg_hi = (r0 < TC) ? TC : TA;
    const bf16_t* P = (const bf16_t*)(ws + WS_P);
    LAS float* XCv = (LAS float*)F.lds;
    LAS f32x2* AU = (LAS f32x2*)(F.lds + 64 * 132 * 4);
    const float* cw = A.inp(14) + (size_t)L * 4 * 512 + blk * 128; const float* cb = A.inp(15) + L * 512 + blk * 128;
    {
        const int tk = tid >> 3, c0 = (tid & 7) * 16, r = r0 + tk;
        float acc[16];
#pragma unroll
        for (int e = 0; e < 16; ++e) acc[e] = cb[c0 + e];
#pragma unroll
        for (int k = 0; k < 4; ++k) { const int rr = r + k - 2; if (rr >= seg_lo && rr < seg_hi) {
            const bf16_t* src = P + (size_t)rr * NP + C_LX + blk * 128 + c0; float x0[8], x1[8]; unpack8(*(const v4u*)src, x0); unpack8(*(const v4u*)(src + 8), x1);
#pragma unroll
            for (int e = 0; e < 8; ++e) { acc[e] += cw[k * 512 + c0 + e] * x0[e]; acc[8 + e] += cw[k * 512 + c0 + 8 + e] * x1[e]; } } }
#pragma unroll
        for (int e = 0; e < 16; e += 4) *(LAS f32x4*)(XCv + tk * 132 + c0 + e) = (f32x4){acc[e], acc[e + 1], acc[e + 2], acc[e + 3]};
    }
    __syncthreads();
    const int w = F.wave, fr = lane & 15, fq = lane >> 4;
    bf16x8 af[4][4];
#pragma unroll
    for (int m = 0; m < 4; ++m)
#pragma unroll
        for (int ks = 0; ks < 4; ++ks) { const LAS float* s = XCv + (16 * m + fr) * 132 + 32 * ks + 8 * fq; const f32x4 a = *(const LAS f32x4*)s, b = *(const LAS f32x4*)(s + 4);
            v4u wv; wv.x = pk2(a.x, a.y); wv.y = pk2(a.z, a.w); wv.z = pk2(b.x, b.y); wv.w = pk2(b.z, b.w); af[m][ks] = __builtin_bit_cast(bf16x8, wv); }
    const bf16_t* WG = (const bf16_t*)(ws + WS_WG) + (size_t)L * 16 * 16384;
    const int ch = 16 * w + fr, chg = blk * 128 + ch;
    for (int dir = 0; dir < 2; ++dir) {
        const bf16_t* Wr = WG + (size_t)((dir * 2 + 0) * 4 + blk) * 16384 + (size_t)ch * 128 + 8 * fq;
        const bf16_t* Wi = WG + (size_t)((dir * 2 + 1) * 4 + blk) * 16384 + (size_t)ch * 128 + 8 * fq;
        f32x4 ar[4], ai[4];
#pragma unroll
        for (int m = 0; m < 4; ++m) { ar[m] = (f32x4){0.f, 0.f, 0.f, 0.f}; ai[m] = (f32x4){0.f, 0.f, 0.f, 0.f}; }
#pragma unroll
        for (int ks = 0; ks < 4; ++ks) { const bf16x8 br = *(const bf16x8*)(Wr + 32 * ks), bi = *(const bf16x8*)(Wi + 32 * ks);
#pragma unroll
            for (int m = 0; m < 4; ++m) { ar[m] = MFMA16(af[m][ks], br, ar[m]); ai[m] = MFMA16(af[m][ks], bi, ai[m]); } }
        const float bgr = A.inp(17)[((size_t)(L * 2 + dir) * 2 + 0) * 512 + chg], bgi = A.inp(17)[((size_t)(L * 2 + dir) * 2 + 1) * 512 + chg];
        const float lam = A.inp(18)[(size_t)(L * 2 + dir) * 512 + chg];
        const float lsg = fminf(lam, 0.f) - log1pf(__expf(-fabsf(lam)));
#pragma unroll
        for (int m = 0; m < 4; ++m)
#pragma unroll
            for (int rg = 0; rg < 4; ++rg) { const int tok = 16 * m + 4 * fq + rg;
                const float rr = sigmf(ar[m][rg] + bgr), ii = sigmf(ai[m][rg] + bgi);
                const float log_a = 8.0f * rr * lsg, a = __expf(log_a), beta = sqrtf(fmaxf(-expm1f(2.f * log_a), 0.f));
                AU[tok * 128 + ch] = (f32x2){a, beta * (ii * XCv[tok * 132 + ch])}; }
        __syncthreads();
        if (tid < 128) {
            float* Hb = (float*)(ws + (dir ? WS_HB : WS_HF)); float* Pb = (float*)(ws + (dir ? WS_PB : WS_PF));
            float h = 0.f, pr = 1.f;
            for (int s = 0; s < 64; ++s) { const int tok = dir ? 63 - s : s; const f32x2 au = AU[tok * 128 + tid];
                h = au.x * h + au.y; pr *= au.x;
                const size_t o = (size_t)(r0 + tok) * 512 + blk * 128 + tid; Hb[o] = h; Pb[o] = pr; }
            float* LS = (float*)(ws + WS_LSUM) + ((size_t)(dir * 132 + c64) * 2) * 512 + blk * 128 + tid;
            LS[0] = pr; LS[512] = h;
        }
        __syncthreads();
    }
}

constexpr int SLD = 136, XLD = 72;
typedef short v4i16_t __attribute__((ext_vector_type(4)));
__device__ __forceinline__ bf16x8 lds_tr_frag(const LAS bf16_t* img, int ld, int r0, int c0, int fr, int fq) {
    const LAS bf16_t* p = img + (r0 + 8 * fq + (fr >> 2)) * ld + c0 + 4 * (fr & 3);
    const v4i16_t lo = __builtin_amdgcn_ds_read_tr16_b64_v4i16((LAS v4i16_t*)p), hi = __builtin_amdgcn_ds_read_tr16_b64_v4i16((LAS v4i16_t*)(p + 4 * ld));
    return (bf16x8){lo[0], lo[1], lo[2], lo[3], hi[0], hi[1], hi[2], hi[3]};
}
__device__ __forceinline__ void prep_ssd_unit(const Fr& F, const PArgs& A, int L, int unit) {
    unsigned char* ws = A.wsp(); const int lane = F.lane, tid = F.tid, c = unit >> 3, h = unit & 7, g = h >> 2, r0 = c * 128;
    const int seg_lo = (r0 < TC) ? 0 : TC, seg_hi = (r0 < TC) ? TC : TA;
    const bf16_t* P = (const bf16_t*)(ws + WS_P);
    LAS bf16_t* CG = (LAS bf16_t*)F.lds;
    LAS bf16_t* BG = CG + 128 * SLD;
    LAS bf16_t* XS = BG + 128 * SLD;
    LAS float* VEC = (LAS float*)(XS + 128 * XLD);
    LAS float* AFv = VEC, *ABv = VEC + 128, *DTF = VEC + 256, *DTB = VEC + 384, *WFv = VEC + 512, *WBv = VEC + 640;
    if (F.wave == 0) {
        const float* DT = (const float*)(ws + WS_DT);
        const float a_f = -__expf(A.inp(22)[(L * 2 + 0) * 8 + h]), a_b = -__expf(A.inp(22)[(L * 2 + 1) * 8 + h]);
        const int t0 = 2 * lane;
        const float df0 = DT[(size_t)(r0 + t0) * 16 + h], df1 = DT[(size_t)(r0 + t0 + 1) * 16 + h], db0 = DT[(size_t)(r0 + t0) * 16 + 8 + h], db1 = DT[(size_t)(r0 + t0 + 1) * 16 + 8 + h];
        const float xf0 = df0 * a_f, xf1 = df1 * a_f, xb0 = db0 * a_b, xb1 = db1 * a_b;
        float sf = xf0 + xf1, sb = xb0 + xb1;
#pragma unroll
        for (int o = 1; o < 64; o <<= 1) { const float uf = __shfl_up(sf, o), ub = __shfl_down(sb, o); if (lane >= o) sf += uf; if (lane + o < 64) sb += ub; }
        const float af1 = sf, af0 = sf - xf1;
        const float ab0 = sb, ab1 = sb - xb0;
        const float aft = __shfl(sf, 63), abt = __shfl(sb, 0);
        AFv[t0] = af0; AFv[t0 + 1] = af1; ABv[t0] = ab0; ABv[t0 + 1] = ab1; DTF[t0] = df0; DTF[t0 + 1] = df1; DTB[t0] = db0; DTB[t0 + 1] = db1;
        WFv[t0] = __expf(aft - af0) * df0; WFv[t0 + 1] = __expf(aft - af1) * df1; WBv[t0] = __expf(abt - ab0) * db0; WBv[t0 + 1] = __expf(abt - ab1) * db1;
        float* AC = (float*)(ws + WS_ACUM);
        AC[(size_t)(r0 + t0) * 16 + h] = af0; AC[(size_t)(r0 + t0 + 1) * 16 + h] = af1; AC[(size_t)(r0 + t0) * 16 + 8 + h] = ab0; AC[(size_t)(r0 + t0 + 1) * 16 + 8 + h] = ab1;
        if (lane == 0) { float* CH = (float*)(ws + WS_CHA); CH[(c * 2 + 0) * 8 + h] = aft; CH[(c * 2 + 1) * 8 + h] = abt; }
    }
    const float* cw = A.inp(19) + (size_t)L * 4 * 1024; const float* cb = A.inp(20) + (size_t)L * 1024;
    bf16_t* XCg = (bf16_t*)(ws + WS_XC);
    for (int id = tid; id < 640; id += 512) {
        const int cgp = id % 40, t0 = (id / 40) * 8;
        int ccol, off, ld; LAS bf16_t* img;
        if (cgp < 8) { off = cgp * 8; ccol = 64 * h + off; img = XS; ld = XLD; } else if (cgp < 24) { off = (cgp - 8) * 8; ccol = 512 + 128 * g + off; img = BG; ld = SLD; } else { off = (cgp - 24) * 8; ccol = 768 + 128 * g + off; img = CG; ld = SLD; }
        const bool cglob = (cgp >= 24) && ((h & 3) == 0);
        float wk[4][8], bb[8];
#pragma unroll
        for (int e = 0; e < 8; ++e) { bb[e] = cb[ccol + e];
#pragma unroll
            for (int k = 0; k < 4; ++k) wk[k][e] = cw[k * 1024 + ccol + e]; }
        const bf16_t* src = P + (size_t)(r0 + t0) * NP + C_SX + ccol;
        float wn[4][8];
#pragma unroll
        for (int j = 0; j < 3; ++j) { const int rr = r0 + t0 + j - 2;
            if (rr >= seg_lo && rr < seg_hi) unpack8(*(const v4u*)(src + (ptrdiff_t)(j - 2) * NP), wn[j]);
            else {
#pragma unroll
                for (int e = 0; e < 8; ++e) wn[j][e] = 0.f; } }
#pragma unroll
        for (int t = 0; t < 8; ++t) { const int rr = r0 + t0 + t + 1;
            if (rr < seg_hi) unpack8(*(const v4u*)(src + (ptrdiff_t)(t + 1) * NP), wn[3]);
            else {
#pragma unroll
                for (int e = 0; e < 8; ++e) wn[3][e] = 0.f; }
            float o8[8];
#pragma unroll
            for (int e = 0; e < 8; ++e) { const float sv = bb[e] + wk[0][e] * wn[0][e] + wk[1][e] * wn[1][e] + wk[2][e] * wn[2][e] + wk[3][e] * wn[3][e];
                o8[e] = siluf(sv); wn[0][e] = wn[1][e]; wn[1][e] = wn[2][e]; wn[2][e] = wn[3][e]; }
            const v4u pv = pack8(o8);
            *(LAS v4u*)(img + (t0 + t) * ld + off) = pv;
            if (cglob) *(v4u*)(XCg + (size_t)(r0 + t0 + t) * 256 + 128 * g + off) = pv; }
    }
    __syncthreads();
    const int w = F.wave, fr = lane & 15, fq = lane >> 4;
    {
        bf16x8 ca[4];
#pragma unroll
        for (int ks = 0; ks < 4; ++ks) ca[ks] = *(const LAS bf16x8*)(CG + (16 * w + fr) * SLD + 32 * ks + 8 * fq);
        float afl[4], abl[4];
#pragma unroll
        for (int rg = 0; rg < 4; ++rg) { afl[rg] = AFv[16 * w + 4 * fq + rg]; abl[rg] = ABv[16 * w + 4 * fq + rg]; }
#pragma unroll 2
        for (int st = 0; st < 8; ++st) { f32x4 gacc = {0.f, 0.f, 0.f, 0.f};
#pragma unroll
            for (int ks = 0; ks < 4; ++ks) { const bf16x8 bfr = *(const LAS bf16x8*)(BG + (16 * st + fr) * SLD + 32 * ks + 8 * fq); gacc = MFMA16(ca[ks], bfr, gacc); }
            const int s = 16 * st + fr; const float afs = AFv[s], abs_ = ABv[s], dfs = DTF[s], dbs = DTB[s];
#pragma unroll
            for (int rg = 0; rg < 4; ++rg) { const int l = 16 * w + 4 * fq + rg; float f;
                if (s < l) f = __expf(afl[rg] - afs) * dfs; else if (s > l) f = __expf(abl[rg] - abs_) * dbs; else f = dfs + dbs;
                CG[l * SLD + s] = (bf16_t)f2bf(gacc[rg] * f); } }
    }
    __syncthreads();
    {
        bf16x8 ma[4];
#pragma unroll
        for (int ks = 0; ks < 4; ++ks) ma[ks] = *(const LAS bf16x8*)(CG + (16 * w + fr) * SLD + 32 * ks + 8 * fq);
        const float Dh = A.inp(23)[L * 8 + h]; float* YD = (float*)(ws + WS_YD);
#pragma unroll
        for (int pt = 0; pt < 4; ++pt) { f32x4 acc = {0.f, 0.f, 0.f, 0.f};
#pragma unroll
            for (int ks = 0; ks < 4; ++ks) { const bf16x8 xb = lds_tr_frag(XS, XLD, 32 * ks, 16 * pt, fr, fq); acc = MFMA16(ma[ks], xb, acc); }
#pragma unroll
            for (int rg = 0; rg < 4; ++rg) { const int l = 16 * w + 4 * fq + rg, p = 16 * pt + fr;
                YD[(size_t)(r0 + l) * 512 + 64 * h + p] = acc[rg] + Dh * bf1(XS[l * XLD + p]); } }
    }
    {
        const int d = w >> 2, ptile = w & 3; const LAS float* Wv = d ? WBv : WFv;
        bf16x8 xa[4];
#pragma unroll
        for (int ks = 0; ks < 4; ++ks) { float x8[8]; unpack8(__builtin_bit_cast(v4u, lds_tr_frag(XS, XLD, 32 * ks, 16 * ptile, fr, fq)), x8);
            const f32x4 w0 = *(const LAS f32x4*)(Wv + 32 * ks + 8 * fq), w1 = *(const LAS f32x4*)(Wv + 32 * ks + 8 * fq + 4);
            x8[0] *= w0.x; x8[1] *= w0.y; x8[2] *= w0.z; x8[3] *= w0.w; x8[4] *= w1.x; x8[5] *= w1.y; x8[6] *= w1.z; x8[7] *= w1.w;
            xa[ks] = __builtin_bit_cast(bf16x8, pack8(x8)); }
        float* ST = (float*)(ws + WS_ST) + ((size_t)((c * 2 + d) * 8 + h)) * 8192;
#pragma unroll 2
        for (int nt = 0; nt < 8; ++nt) { f32x4 acc = {0.f, 0.f, 0.f, 0.f};
#pragma unroll
            for (int ks = 0; ks < 4; ++ks) { const bf16x8 bb2 = lds_tr_frag(BG, SLD, 32 * ks, 16 * nt, fr, fq); acc = MFMA16(xa[ks], bb2, acc); }
#pragma unroll
            for (int rg = 0; rg < 4; ++rg) ST[(16 * ptile + 4 * fq + rg) * 128 + 16 * nt + fr] = acc[rg]; }
    }
    __syncthreads();
}

__device__ __forceinline__ void ph_prep(const Fr& F0, const PArgs& A, int L) {
    const Fr F = fr_refresh(F0);
    constexpr int N_SSD = 66 * 8, N_LRU = 132 * 4, N_ROPE = TA / 64;
    for (int u = F.vcu; u < N_SSD + N_LRU + N_ROPE; u += F.G) {
        if (u < N_SSD) { if (SUBM & 1) prep_ssd_unit(F, A, L, u); }
        else if (u < N_SSD + N_LRU) { if (SUBM & 2) prep_lru_unit(F, A, L, u - N_SSD); }
        else { if (SUBM & 4) prep_rope_unit(F, A, L, u - N_SSD - N_LRU); }
    }
}

__device__ __forceinline__ void ph_state_scan(const Fr& F0, const PArgs& A) {
    const Fr F = fr_refresh(F0);
    unsigned char* ws = A.wsp(); const float* ST = (const float*)(ws + WS_ST); bf16_t* SIN = (bf16_t*)(ws + WS_SIN); unsigned* CH = (unsigned*)(ws + WS_CHA);
    for (int e = F.bid * 512 + F.tid; e < 2 * 65536; e += F.G * 512) {
        const int d = e >> 16, rest = e & 65535, h = rest >> 13;
        float run = 0.f;
#pragma unroll 6
        for (int i = 0; i < 66; ++i) { const int c = d ? (i == 0 ? 1 : (i == 1 ? 0 : 67 - i)) : i; const size_t o = ((size_t)(c * 2 + d) << 16) + rest;
            SIN[o] = (bf16_t)f2bf(run);
            const float dec = __expf(__uint_as_float(__hip_atomic_load(CH + (c * 2 + d) * 8 + h, RLX_AGENT)));
            run = dec * run + ST[o]; }
    }
}
__device__ __forceinline__ void ph_attn(const Fr& F0, const PArgs& A, int L) {
    const Fr F = fr_refresh(F0);
    unsigned char* ws = A.wsp();
    const att::bf16* QB = (const att::bf16*)(ws + WS_QB); const att::bf16* KB = (const att::bf16*)(ws + WS_KB); const att::bf16* P = (const att::bf16*)(ws + WS_P);
    const int nunits = 768 + (L < DEPTH - 1 ? 12 : 0);
    for (int u = F.vcu; u < nunits; u += F.G) {
        int vh, row0, seq, kh, k0;
        if (u < 768) { const int v = (u < 512) ? u : u - 512; vh = ((u < 512) ? 0 : 8) + (v >> 6); row0 = TC + 256 * ((v & 63) >> 1); kh = v & 1; seq = TA / 2; k0 = kh * (TA / 2); }
        else { vh = u - 768; row0 = 0; seq = TC; kh = 0; k0 = 0; }
        const int kvh = vh >> 1;
        const att::bf16* Vh = P + (size_t)k0 * NP + (kvh < 4 ? C_DAV + 128 * kvh : C_GV + 128 * (kvh - 4));
        const att::bf16* Kh = KB + (size_t)k0 * KLD + kvh * 128;
        float* Ob = (float*)(ws + (kh ? WS_OP1 : WS_O)) + (size_t)row0 * QLD + vh * 128;
        float* ML = (float*)(ws + WS_ML) + ((size_t)(kh * TA + row0) * 12 + vh) * 2;
        if (vh < 8) { const int m = vh & 1; att::attn_dense_body<att::bf16, 4, true>(QB + (size_t)row0 * QLD + vh * 128 + 64 * m, Kh, Vh, Ob, seq, F.ldsg, 128 * m, ML); }
        else att::attn_dense_body<att::bf16, 8, true>(QB + (size_t)row0 * QLD + vh * 128, Kh, Vh, Ob, seq, F.ldsg, 0, ML);
        __syncthreads();
    }
}

__device__ __forceinline__ void attn_combine8(const float* O0, const float* O1, const float* ML0, const float* ML1, size_t r, int vh, int c0, bool split, float (&o8)[8]) {
    const f32x4 a0 = *(const f32x4*)(O0 + r * QLD + vh * 128 + c0), a1 = *(const f32x4*)(O0 + r * QLD + vh * 128 + c0 + 4);
    const f32x2 mla = *(const f32x2*)(ML0 + (r * 12 + vh) * 2);
    if (split) {
        const f32x4 b0 = *(const f32x4*)(O1 + r * QLD + vh * 128 + c0), b1 = *(const f32x4*)(O1 + r * QLD + vh * 128 + c0 + 4);
        const f32x2 mlb = *(const f32x2*)(ML1 + (r * 12 + vh) * 2);
        const float m = fmaxf(mla.x, mlb.x), wa = __builtin_amdgcn_exp2f(mla.x - m), wb = __builtin_amdgcn_exp2f(mlb.x - m), inv = 1.0f / (mla.y * wa + mlb.y * wb), ka = wa * inv, kb = wb * inv;
        o8[0] = a0.x * ka + b0.x * kb; o8[1] = a0.y * ka + b0.y * kb; o8[2] = a0.z * ka + b0.z * kb; o8[3] = a0.w * ka + b0.w * kb;
        o8[4] = a1.x * ka + b1.x * kb; o8[5] = a1.y * ka + b1.y * kb; o8[6] = a1.z * ka + b1.z * kb; o8[7] = a1.w * ka + b1.w * kb;
    } else { const float inv = 1.0f / mla.y;
        o8[0] = a0.x * inv; o8[1] = a0.y * inv; o8[2] = a0.z * inv; o8[3] = a0.w * inv; o8[4] = a1.x * inv; o8[5] = a1.y * inv; o8[6] = a1.z * inv; o8[7] = a1.w * inv; }
}
__device__ __forceinline__ void fin_attn_unit(const Fr& F, const PArgs& A, int L, int unit, float lam, float lam_init) {
    unsigned char* ws = A.wsp(); const int lane = F.lane; bf16_t* Y = (bf16_t*)(ws + WS_YCAT);
    const float* O0 = (const float*)(ws + WS_O); const float* O1 = (const float*)(ws + WS_OP1); const float* ML0 = (const float*)(ws + WS_ML); const float* ML1 = ML0 + (size_t)TA * 24;
    const float* sub = A.inp(11) + L * 128;
    const bool split = unit >= TC / 64;
#pragma unroll 2
    for (int i = 0; i < 8; ++i) {
        const size_t r = (size_t)unit * 64 + F.wave * 8 + i;
        {   const int hh = lane >> 4, d0 = (lane & 15) * 8;
            float x1[8], x2[8], o8[8];
            attn_combine8(O0, O1, ML0, ML1, r, 2 * hh, d0, split, x1); attn_combine8(O0, O1, ML0, ML1, r, 2 * hh + 1, d0, split, x2);
            float ss = 0.f;
#pragma unroll
            for (int e = 0; e < 8; ++e) { o8[e] = x1[e] - lam * x2[e]; ss += o8[e] * o8[e]; }
#pragma unroll
            for (int s = 1; s < 16; s <<= 1) ss += __shfl_xor(ss, s);
            const float rs = (1.0f / sqrtf(ss * (1.f / 128.f) + NEPS)) * (1.f - lam_init);
#pragma unroll
            for (int e = 0; e < 8; ++e) o8[e] = o8[e] * rs * sub[d0 + e];
            *(v4u*)(Y + r * DM + 128 * hh + d0) = pack8(o8); }
        {   float o8[8]; attn_combine8(O0, O1, ML0, ML1, r, 8 + (lane >> 4), (lane & 15) * 8, split, o8);
            *(v4u*)(Y + r * DM + 512 + 8 * lane) = pack8(o8); }
    }
}
__device__ __forceinline__ void fin_lru_unit(const Fr& F, const PArgs& A, int c64) {
    unsigned char* ws = A.wsp(); const int ch = F.tid;
    const float* LS = (const float*)(ws + WS_LSUM);
    float cf = 0.f, cbk = 0.f;
    for (int j0 = 0; j0 < c64; j0 += 8) { float a[8], hh[8];
#pragma unroll
        for (int k = 0; k < 8; ++k) { const int j = min(j0 + k, c64 - 1); a[k] = LS[((size_t)(0 * 132 + j) * 2) * 512 + ch]; hh[k] = LS[((size_t)(0 * 132 + j) * 2 + 1) * 512 + ch]; }
#pragma unroll
        for (int k = 0; k < 8; ++k) { const bool ok = j0 + k < c64; cf = ok ? a[k] * cf + hh[k] : cf; } }
    const int pos = (c64 < 4) ? 3 - c64 : 135 - c64;
    for (int i0 = 0; i0 < pos; i0 += 8) { float a[8], hh[8];
#pragma unroll
        for (int k = 0; k < 8; ++k) { const int i = min(i0 + k, pos - 1), j = (i < 4) ? 3 - i : 135 - i; a[k] = LS[((size_t)(1 * 132 + j) * 2) * 512 + ch]; hh[k] = LS[((size_t)(1 * 132 + j) * 2 + 1) * 512 + ch]; }
#pragma unroll
        for (int k = 0; k < 8; ++k) { const bool ok = i0 + k < pos; cbk = ok ? a[k] * cbk + hh[k] : cbk; } }
    const float* HF = (const float*)(ws + WS_HF); const float* PF = (const float*)(ws + WS_PF); const float* HB = (const float*)(ws + WS_HB); const float* PB = (const float*)(ws + WS_PB);
    const bf16_t* P = (const bf16_t*)(ws + WS_P); bf16_t* Y = (bf16_t*)(ws + WS_YCAT);
#pragma unroll 8
    for (int t = 0; t < 64; ++t) { const size_t r = (size_t)c64 * 64 + t, o = r * 512 + ch;
        const float hf = HF[o] + PF[o] * cf, hb = HB[o] + PB[o] * cbk, gg = bf1(P[r * NP + C_LG + ch]);
        Y[r * DM + 1024 + ch] = (bf16_t)f2bf((hf + hb) * gelu_tanh(gg)); }
}
constexpr int CLD = 264;
__device__ __forceinline__ void fin_ssd_unit(const Fr& F, const PArgs& A, int L, int c) {
    unsigned char* ws = A.wsp(); const int lane = F.lane, tid = F.tid, w = F.wave, fr = lane & 15, fq = lane >> 4, r0 = c * 128;
    LAS bf16_t* CI = (LAS bf16_t*)F.lds;
    LAS float* EF = (LAS float*)(CI + 128 * CLD);
    const bf16_t* XCg = (const bf16_t*)(ws + WS_XC); const float* AC = (const float*)(ws + WS_ACUM);
    for (int id = tid; id < 128 * 32; id += 512) { const int t = id >> 5, q = id & 31; *(LAS v4u*)(CI + t * CLD + 8 * q) = *(const v4u*)(XCg + (size_t)(r0 + t) * 256 + 8 * q); }
    for (int id = tid; id < 128 * 16; id += 512) { const int t = id >> 4, j = id & 15; EF[j * 128 + t] = __expf(AC[(size_t)(r0 + t) * 16 + j]); }
    __syncthreads();
    const bf16_t* SIN = (const bf16_t*)(ws + WS_SIN); const float* YD = (const float*)(ws + WS_YD); float* YDw = (float*)(ws + (FIN_INPLACE ? WS_YD : WS_YD2)); const bf16_t* P = (const bf16_t*)(ws + WS_P);
    float ss[4] = {0.f, 0.f, 0.f, 0.f};
    for (int h = 0; h < 8; ++h) { const int g = h >> 2;
        bf16x8 ca[4];
#pragma unroll
        for (int ks = 0; ks < 4; ++ks) ca[ks] = *(const LAS bf16x8*)(CI + (16 * w + fr) * CLD + 128 * g + 32 * ks + 8 * fq);
        const bf16_t* S0 = SIN + ((size_t)((c * 2 + 0) * 8 + h)) * 8192; const bf16_t* S1 = SIN + ((size_t)((c * 2 + 1) * 8 + h)) * 8192;
        float ef[4], eb[4];
#pragma unroll
        for (int rg = 0; rg < 4; ++rg) { ef[rg] = EF[h * 128 + 16 * w + 4 * fq + rg]; eb[rg] = EF[(8 + h) * 128 + 16 * w + 4 * fq + rg]; }
#pragma unroll 2
        for (int pt = 0; pt < 4; ++pt) { f32x4 a0 = {0.f, 0.f, 0.f, 0.f}, a1 = {0.f, 0.f, 0.f, 0.f};
#pragma unroll
            for (int ks = 0; ks < 4; ++ks) { const bf16x8 b0 = *(const bf16x8*)(S0 + (16 * pt + fr) * 128 + 32 * ks + 8 * fq), b1 = *(const bf16x8*)(S1 + (16 * pt + fr) * 128 + 32 * ks + 8 * fq);
                a0 = MFMA16(ca[ks], b0, a0); a1 = MFMA16(ca[ks], b1, a1); }
#pragma unroll
            for (int rg = 0; rg < 4; ++rg) { const int l = 16 * w + 4 * fq + rg, col = 64 * h + 16 * pt + fr; const size_t r = (size_t)(r0 + l);
                float y = YD[r * 512 + col] + ef[rg] * a0[rg] + eb[rg] * a1[rg];
                y *= siluf(bf1(P[r * NP + C_SZ + col])); YDw[r * 512 + col] = y; ss[rg] += y * y; } }
    }
    const float* nw = A.inp(24) + L * 512; bf16_t* Y = (bf16_t*)(ws + WS_YCAT);
#pragma unroll
    for (int rg = 0; rg < 4; ++rg) {
#pragma unroll
        for (int s = 1; s < 16; s <<= 1) ss[rg] += __shfl_xor(ss[rg], s);
        ss[rg] = 1.0f / sqrtf(ss[rg] * (1.f / 512.f) + NEPS); }
#pragma unroll 4
    for (int ct = 0; ct < 32; ++ct) { const int col = 16 * ct + fr; const float wv = nw[col];
#pragma unroll
        for (int rg = 0; rg < 4; ++rg) { const size_t r = (size_t)(r0 + 16 * w + 4 * fq + rg); Y[r * DM + 1536 + col] = (bf16_t)f2bf(YDw[r * 512 + col] * ss[rg] * wv); } }
    __syncthreads();
}
__device__ __forceinline__ void ph_finish(const Fr& F0, const PArgs& A, int L) {
    const Fr F = fr_refresh(F0);
    const float lam_init = 0.8f - 0.6f * expf(-0.3f * (float)L);
    const float* lv = A.inp(10) + L * 256;
    const float s1 = wave_sum(lv[F.lane] * lv[64 + F.lane]), s2 = wave_sum(lv[128 + F.lane] * lv[192 + F.lane]);
    const float lam = expf(s1) - expf(s2) + lam_init;
    const bool need_ctx = L < DEPTH - 1;
    constexpr int N_SSD = 66, N_LRU = 132, N_ATT = TA / 64;
    for (int u = F.vcu; u < N_SSD + N_LRU + N_ATT; u += F.G) {
        if (u < N_SSD) { if ((SUBM & 1) && (need_ctx || u >= 2)) fin_ssd_unit(F, A, L, u); }
        else if (u < N_SSD + N_LRU) { const int c64 = u - N_SSD; if ((SUBM & 2) && (need_ctx || c64 >= 4)) fin_lru_unit(F, A, c64); }
        else { const int un = u - N_SSD - N_LRU; if ((SUBM & 4) && (need_ctx || un >= 4)) fin_attn_unit(F, A, L, un, lam, lam_init); }
    }
}

__device__ __forceinline__ void ph_act(const Fr& F0, const PArgs& A, int L, int row_lo) {
    const Fr F = fr_refresh(F0);
    unsigned char* ws = A.wsp(); const bf16_t* GU = (const bf16_t*)(ws + WS_GU); bf16_t* H = (bf16_t*)(ws + WS_H);
    const float* cw = A.inp(26) + (size_t)L * 3 * DFF; const float* cb = A.inp(27) + (size_t)L * DFF;
    constexpr int NCG = DFF / 8;
    const int ntb = (TA - row_lo) / 8;
    for (int it = F.bid * 512 + F.tid; it < ntb * NCG; it += F.G * 512) {
        const int tb = it / NCG, cg = it % NCG, r0 = row_lo + tb * 8, c0 = cg * 8;
        const int seg_lo = (r0 < TC) ? 0 : TC, seg_hi = (r0 < TC) ? TC : TA;
        float w0[8], w1[8], w2[8], bb[8];
#pragma unroll
        for (int e = 0; e < 8; ++e) { w0[e] = cw[c0 + e]; w1[e] = cw[DFF + c0 + e]; w2[e] = cw[2 * DFF + c0 + e]; bb[e] = cb[c0 + e]; }
        float prev[8], cur[8], nxt[8];
        if (r0 - 1 >= seg_lo) unpack8(*(const v4u*)(GU + (size_t)(r0 - 1) * (2 * DFF) + c0), prev); else {
#pragma unroll
            for (int e = 0; e < 8; ++e) prev[e] = 0.f; }
        unpack8(*(const v4u*)(GU + (size_t)r0 * (2 * DFF) + c0), cur);
#pragma unroll
        for (int t = 0; t < 8; ++t) { const int r = r0 + t;
            if (r + 1 < seg_hi) unpack8(*(const v4u*)(GU + (size_t)(r + 1) * (2 * DFF) + c0), nxt); else {
#pragma unroll
                for (int e = 0; e < 8; ++e) nxt[e] = 0.f; }
            float up[8], o8[8]; unpack8(*(const v4u*)(GU + (size_t)r * (2 * DFF) + DFF + c0), up);
#pragma unroll
            for (int e = 0; e < 8; ++e) { const float gt = bb[e] + w0[e] * prev[e] + w1[e] * cur[e] + w2[e] * nxt[e]; o8[e] = siluf(gt) * up[e]; }
            *(v4u*)(H + (size_t)r * DFF + c0) = pack8(o8);
#pragma unroll
            for (int e = 0; e < 8; ++e) { prev[e] = cur[e]; cur[e] = nxt[e]; } }
    }
}

__device__ __forceinline__ void ph_final(const Fr& F0, const PArgs& A) {
    const Fr F = fr_refresh(F0);
    const float* X = (const float*)(A.wsp() + WS_X) + (size_t)TC * DM; const float* nw = A.inp(29);
    const int gw = F.bid * NWAVES + F.wave, NGW = F.G * NWAVES, lane = F.lane;
    for (int row = gw; row < TL; row += NGW) {
        const f32x4* xr = (const f32x4*)(X + (size_t)row * DM) + lane; f32x4* orow = (f32x4*)(A.outp() + (size_t)row * DM) + lane;
        f32x4 v[8]; float ss = 0.f;
#pragma unroll
        for (int j = 0; j < 8; ++j) { v[j] = xr[64 * j]; ss += (v[j].x * v[j].x + v[j].y * v[j].y) + (v[j].z * v[j].z + v[j].w * v[j].w); }
        const float rs = 1.0f / sqrtf(wave_sum(ss) * (1.f / DM) + NEPS);
#pragma unroll
        for (int j = 0; j < 8; ++j) { const f32x4 w4 = *(const f32x4*)(nw + 4 * lane + 256 * j); orow[64 * j] = v[j] * rs * w4; }
    }
}

constexpr int N_STEPS = 2 + 10 * DEPTH + 1;
#ifndef PH_MASK
#define PH_MASK 0xFFFF
#endif
#define PHE(b) ((PH_MASK >> (b)) & 1)
#ifndef DBL_MASK
#define DBL_MASK 0
#endif
#define NREP(b) (((DBL_MASK >> (b)) & 1) ? 2 : 1)
#ifndef MK_ONE_LAUNCH
#define MK_ONE_LAUNCH 1
#endif
__global__ void __launch_bounds__(NWAVES * 64, 2) mk_fwd(Args args) {
    extern __shared__ __attribute__((aligned(16))) unsigned char lds[];
    Fr F;
    F.lds = (LAS unsigned char*)lds; F.ldsg = (char*)lds;
    F.tid = 0; F.lane = 0; F.wave = 0;
    F.G = gridDim.x; F.bid = blockIdx.x; F.vcu = (F.G % 8 == 0) ? (F.bid % 8) * (F.G / 8) + F.bid / 8 : F.bid;
    volatile LAS unsigned* MISC = (volatile LAS unsigned*)(F.lds + MISC_OFF);
    for (int u = threadIdx.x; u < (LDS_BYTES - MISC_OFF) / 4; u += NWAVES * 64) ((LAS unsigned*)(F.lds + MISC_OFF))[u] = 0u;
    __syncthreads();
    if (threadIdx.x == 0) { LAS unsigned long long* tb = (LAS unsigned long long*)(F.lds + TBL_OFF);
#pragma unroll
        for (int i = 0; i < 30; ++i) tb[i] = (unsigned long long)args.in[i];
        tb[30] = (unsigned long long)args.out; tb[31] = (unsigned long long)args.ws; }
    __syncthreads();
    PArgs PA; PA.tbl = (LAS unsigned long long*)(F.lds + TBL_OFF);
    unsigned char* ws = args.ws;
    const int lo = args.s_lo, hi = args.s_hi;
    if (hi - lo > 1) (void)xcd_barrier_post((unsigned*)(ws + WS_CTL) + CW_BAR, MISC + 8);
#define IN(k) (lo <= (k) && (k) < hi)
#define SEAM(k) do { if (IN(k) && IN((k) + 1)) { XcdBarrier b2; b2.bar = (unsigned*)(PA.wsp() + WS_CTL) + CW_BAR; b2.x = xb_xcc_id(); b2.st = MISC + 8; xcd_barrier(b2); } } while (0)

    if (PHE(0) && IN(0)) for (int rep = 0; rep < NREP(0); ++rep) { ph_prologue(F, PA); } SEAM(0);
    if (PHE(1) && IN(1)) { ph_modf(F, PA); } SEAM(1);

    for (int L = 0; L < DEPTH; ++L) {
        const int s0 = 2 + 10 * L;
        { int z = 0; asm volatile("" : "+s"(z)); F.lds = (LAS unsigned char*)lds + z; F.ldsg = (char*)lds + z; PA.tbl = (LAS unsigned long long*)(F.lds + TBL_OFF); MISC = (volatile LAS unsigned*)(F.lds + MISC_OFF); }
        ws = PA.wsp();
        const float* modf = (const float*)(ws + WS_MODF); float* X = (float*)(ws + WS_X); bf16_t* XN = (bf16_t*)(ws + WS_XN);
        const float* mod_lat = modf + (size_t)(L * 2 + 0) * 6 * DM; const float* mod_ctx = modf + (size_t)(L * 2 + 1) * 6 * DM;
        const bool need_ctx = L < DEPTH - 1;
        const int rlo = need_ctx ? 0 : TC;
        if (PHE(2) && IN(s0 + 0)) for (int rep = 0; rep < NREP(2); ++rep) { ph_norm<true>(F, X, XN, PA.inp(6) + L * DM, mod_lat, mod_ctx, 0, DM, PA.inp(8) + (size_t)L * DM * NIN, PA.inp(21) + L * 16, (float*)(ws + WS_DT)); }
        SEAM(s0 + 0);
        if (PHE(3) && IN(s0 + 1)) for (int rep = 0; rep < NREP(3); ++rep) {
            pg8::Gemm g{XN, (const bf16_t*)(ws + WS_WIN) + (size_t)L * NP * DM, TA, NP, DM}; pg8::StaticOrder S; S.init(TA, NP, F.G, F.bid);
            pg8::EpiBf16 E{(bf16_t*)(ws + WS_P), NP};
            pg8::gemm_phase<pg8::EpiBf16, pg8::StaticOrder, true, true>(F.lds, g, S, E); }
        SEAM(s0 + 1);
        if (PHE(4) && IN(s0 + 2)) for (int rep = 0; rep < NREP(4); ++rep) { ph_prep(F, PA, L); }
        SEAM(s0 + 2);
        if (PHE(5) && IN(s0 + 3)) for (int rep = 0; rep < NREP(5); ++rep) { ph_state_scan(F, PA); ph_attn(F, PA, L); }
        SEAM(s0 + 3);
        if (PHE(6) && IN(s0 + 4)) for (int rep = 0; rep < NREP(6); ++rep) { ph_finish(F, PA, L); }
        SEAM(s0 + 4);
        if (PHE(7) && IN(s0 + 5)) {
            pg8::Gemm g{(const bf16_t*)(ws + WS_YCAT) + (size_t)rlo * DM, (const bf16_t*)(ws + WS_WOUT) + (size_t)L * DM * DM, TA - rlo, DM, DM}; pg8::StaticOrder S; S.init(TA - rlo, DM, F.G, F.bid);
            pg8::EpiResid E{X + (size_t)rlo * DM, DM, mod_ctx + 2 * DM, mod_lat + 2 * DM, need_ctx ? 1 : 0};
            pg8::gemm_phase<pg8::EpiResid, pg8::StaticOrder, true, true>(F.lds, g, S, E); }
        SEAM(s0 + 5);
        if (PHE(8) && IN(s0 + 6)) for (int rep = 0; rep < NREP(8); ++rep) { ph_norm<false>(F, X, XN, PA.inp(7) + L * DM, mod_lat, mod_ctx, 3 * DM, 4 * DM, nullptr, nullptr, nullptr); }
        SEAM(s0 + 6);
        if (PHE(9) && IN(s0 + 7)) for (int rep = 0; rep < NREP(9); ++rep) {
            pg8::Gemm g{XN + (size_t)rlo * DM, (const bf16_t*)(ws + WS_WUP) + (size_t)L * 2 * DFF * DM, TA - rlo, 2 * DFF, DM}; pg8::StaticOrder S; S.init(TA - rlo, 2 * DFF, F.G, F.bid);
            pg8::EpiBf16 E{(bf16_t*)(ws + WS_GU) + (size_t)rlo * 2 * DFF, 2 * DFF};
            pg8::gemm_phase<pg8::EpiBf16, pg8::StaticOrder, true, true>(F.lds, g, S, E); }
        SEAM(s0 + 7);
        if (PHE(10) && IN(s0 + 8)) for (int rep = 0; rep < NREP(10); ++rep) { ph_act(F, PA, L, rlo); }
        SEAM(s0 + 8);
        if (PHE(11) && IN(s0 + 9)) {
            pg8::Gemm g{(const bf16_t*)(ws + WS_H) + (size_t)rlo * DFF, (const bf16_t*)(ws + WS_WDN) + (size_t)L * DM * DFF, TA - rlo, DM, DFF}; pg8::StaticOrder S; S.init(TA - rlo, DM, F.G, F.bid);
            pg8::EpiResid E{X + (size_t)rlo * DM, DM, mod_ctx + 5 * DM, mod_lat + 5 * DM, need_ctx ? 1 : 0};
            pg8::gemm_phase<pg8::EpiResid, pg8::StaticOrder, true, true>(F.lds, g, S, E); }
        SEAM(s0 + 9);
    }
    if (PHE(12) && IN(N_STEPS - 1)) { ph_final(F, PA); }
#undef IN
#undef SEAM
}

extern "C" void kernel_launch(void* const* d_in, const int* in_sizes, int n_in, void* d_out, int out_size, void* d_ws, size_t ws_size, hipStream_t stream) {
    static int grid = 0;
    if (grid == 0) {
        if (n_in != 30 || out_size != TL * DM || ws_size < WS_END) { fprintf(stderr, "kernel_launch: unexpected shapes: n_in %d out %d ws %zu (need %zu)\n", n_in, out_size, ws_size, (size_t)WS_END); grid = -1; return; }
        int dev = 0, cus = 0, per_cu = 0;
        if (hipGetDevice(&dev) != hipSuccess || hipDeviceGetAttribute(&cus, hipDeviceAttributeMultiprocessorCount, dev) != hipSuccess) { fprintf(stderr, "kernel_launch: device query failed\n"); grid = -1; return; }
        if (hipFuncSetAttribute((const void*)mk_fwd, hipFuncAttributeMaxDynamicSharedMemorySize, LDS_BYTES) != hipSuccess) { fprintf(stderr, "kernel_launch: hipFuncSetAttribute(%d) failed\n", LDS_BYTES); grid = -1; return; }
        if (hipOccupancyMaxActiveBlocksPerMultiprocessor(&per_cu, (const void*)mk_fwd, NWAVES * 64, LDS_BYTES) != hipSuccess || per_cu < 1) { fprintf(stderr, "kernel_launch: occupancy query says %d blocks per CU\n", per_cu); }
        (void)hipGetLastError();
        grid = cus;
    }
    if (grid < 0) return;
    if (hipMemsetAsync((char*)d_ws + WS_CTL, 0, CTL_ZERO_BYTES, stream) != hipSuccess) { fprintf(stderr, "kernel_launch: memset failed\n"); return; }
    Args a{};
    for (int i = 0; i < 30; ++i) a.in[i] = (const float*)d_in[i];
    a.out = (float*)d_out; a.ws = (unsigned char*)d_ws;
#if MK_ONE_LAUNCH
    a.s_lo = 0; a.s_hi = N_STEPS;
    hipLaunchKernelGGL(mk_fwd, dim3(grid), dim3(NWAVES * 64), LDS_BYTES, stream, a);
#else
    for (int s = 0; s < N_STEPS; ++s) { a.s_lo = s; a.s_hi = s + 1; hipLaunchKernelGGL(mk_fwd, dim3(grid), dim3(NWAVES * 64), LDS_BYTES, stream, a); }
#endif
    const hipError_t le = hipPeekAtLastError();
    if (le != hipSuccess) fprintf(stderr, "kernel_launch: launch failed: %s\n", hipGetErrorName(le));
}
```

```cpp
#include <hip/hip_runtime.h>
#include <hip/hip_bf16.h>
#include <cstdio>
#include <cstdint>

constexpr int WMAP_OFF = 147456 + 512;
__device__ __forceinline__ int lane_now() { int l; asm volatile("v_mbcnt_lo_u32_b32 %0, -1, 0\n\tv_mbcnt_hi_u32_b32 %0, -1, %0" : "=v"(l)); return l; }
__device__ __forceinline__ int wave_now() { const unsigned h = (unsigned)__builtin_amdgcn_s_getreg((5 << 11) | 4) & 63u;
    return __builtin_amdgcn_readfirstlane(((volatile __attribute__((address_space(3))) int*)(unsigned long)WMAP_OFF)[h]); }
__device__ __forceinline__ int tid_opaque() { int t = wave_now() * 64 + lane_now(); asm volatile("" : "+v"(t)); return t; }
__device__ __forceinline__ float shx(float v, int o) { return __builtin_bit_cast(float, __builtin_amdgcn_ds_bpermute((lane_now() ^ o) << 2, __builtin_bit_cast(int, v))); }
__device__ __forceinline__ float shup(float v, int o) { return __builtin_bit_cast(float, __builtin_amdgcn_ds_bpermute(((lane_now() - o) & 63) << 2, __builtin_bit_cast(int, v))); }
__device__ __forceinline__ float shdn(float v, int o) { return __builtin_bit_cast(float, __builtin_amdgcn_ds_bpermute(((lane_now() + o) & 63) << 2, __builtin_bit_cast(int, v))); }
__device__ __forceinline__ float shidx(float v, int src) { return __builtin_bit_cast(float, __builtin_amdgcn_ds_bpermute(src << 2, __builtin_bit_cast(int, v))); }

namespace pg8 {
#define PG8_LAS __attribute__((address_space(3)))
typedef unsigned short bf16_t;
typedef short bf16x8 __attribute__((ext_vector_type(8)));
typedef float f32x4 __attribute__((ext_vector_type(4)));
typedef unsigned u32x4 __attribute__((ext_vector_type(4)));
constexpr int BM = 256, BK = 64, HALF = 128, HTB = HALF * BK * 2  , STAGE_BYTES = 8 * HTB, NXCD = 8, WGM = 8;

__host__ __device__ __forceinline__ int lds_byte(int r, int c) { const int st = (r >> 4) * 2 + (c >> 5), rr = r & 15, cc = c & 31, ob = rr * 64 + cc * 2; return st * 1024 + (ob ^ (((ob >> 9) & 1) << 5)); }
__host__ __device__ __forceinline__ void stage_rc(int b, int& R, int& C) { const int st = b / 1024, sb = b % 1024, swz = sb ^ (((sb >> 9) & 1) << 5); R = (st >> 1) * 16 + swz / 64; C = (st & 1) * 32 + (swz % 64) / 2; }
__host__ __device__ __forceinline__ int perm32(int rho) { const int n = rho >> 4, i = rho & 15; return 8 * (i >> 2) + 4 * n + (i & 3); }

struct Unit { int pm, pn, k0; };
struct Gemm { const bf16_t* A; const bf16_t* Bt; int M, N, K, ld; };

struct StaticOrder {
    int nM, nN, nwg, G, c;
    __host__ __device__ void init(int M, int N, int G_, int c_) { nM = M / BM; nN = N / BM; nwg = nM * nN; G = G_; c = c_; }
    __host__ __device__ bool next(int i, Unit& u) const {
        const long L = (long)i * G + c; if (L >= nwg) return false;
        int wgid = (int)L; { const int q = nwg / NXCD, r = nwg % NXCD, xcd = wgid % NXCD, off = wgid / NXCD; wgid = (xcd < r ? xcd * (q + 1) : r * (q + 1) + (xcd - r) * q) + off; }
        const int nig = WGM * nN, gid = wgid / nig, fm = gid * WGM, gsz = (nM - fm) < WGM ? (nM - fm) : WGM;
        u.pm = fm + ((wgid % nig) % gsz); u.pn = (wgid % nig) / gsz; u.k0 = 0; return true;
    }
    __device__ __forceinline__ void a_ready(const Unit&) const {}
    __device__ __forceinline__ void done(const Unit&) const {}
};

struct SplitKOrder {
    int nN, S, kslice, G, c, pm;
    __host__ __device__ bool next(int i, Unit& u) const { const long L = (long)i * G + c; if (L >= (long)nN * S) return false; u.pm = pm; u.pn = (int)L / S; u.k0 = ((int)L % S) * kslice; return true; }
    __device__ __forceinline__ void a_ready(const Unit&) const {}
    __device__ __forceinline__ void done(const Unit&) const {}
};

__device__ __forceinline__ unsigned cvt_pk_bf16(float lo, float hi) { unsigned r; asm volatile("v_cvt_pk_bf16_f32 %0, %1, %2" : "=v"(r) : "v"(lo), "v"(hi)); return r; }

struct EpiBf16 {
    static constexpr bool PERM = true, AFTER_DRAIN = false;
    bf16_t* O; int ldc;
    __device__ __forceinline__ void operator()(const f32x4 (&acc)[2][2][4][2], const Unit& u, int wr, int wc, int fr, int fq) const {
        const int row0 = u.pm * BM + wr * 64 + fr; const int col0 = u.pn * BM + wc * 32 + 8 * fq;
#pragma unroll
        for (int ai = 0; ai < 2; ++ai)
#pragma unroll
            for (int m = 0; m < 4; ++m) { bf16_t* rowp = O + (size_t)(row0 + ai * HALF + m * 16) * ldc + col0;
#pragma unroll
                for (int bj = 0; bj < 2; ++bj) { const f32x4 v0 = acc[ai][bj][m][0], v1 = acc[ai][bj][m][1];
                    u32x4 w; w.x = cvt_pk_bf16(v0[0], v0[1]); w.y = cvt_pk_bf16(v0[2], v0[3]); w.z = cvt_pk_bf16(v1[0], v1[1]); w.w = cvt_pk_bf16(v1[2], v1[3]);
                    *(u32x4*)(rowp + bj * HALF) = w; } }
    }
};
struct EpiResid {
    static constexpr bool PERM = false, AFTER_DRAIN = false;
    float* X; int ldc; const float* gate_ctx; const float* gate_lat; int ctx_panels;
    __device__ __forceinline__ void operator()(const f32x4 (&acc)[2][2][4][2], const Unit& u, int wr, int wc, int fr, int fq) const {
        const int row0 = u.pm * BM + wr * 64 + fr, col0 = u.pn * BM + wc * 32 + 4 * fq;
        const float* gate = (u.pm < ctx_panels) ? gate_ctx : gate_lat;
        f32x4 gv[2][2];
#pragma unroll
        for (int bj = 0; bj < 2; ++bj)
#pragma unroll
            for (int n = 0; n < 2; ++n) gv[bj][n] = *(const f32x4*)(gate + col0 + bj * HALF + n * 16);
#pragma unroll
        for (int ai = 0; ai < 2; ++ai)
#pragma unroll
            for (int m = 0; m < 4; ++m) { float* rowp = X + (size_t)(row0 + ai * HALF + m * 16) * ldc + col0;
#pragma unroll
                for (int bj = 0; bj < 2; ++bj)
#pragma unroll
                    for (int n = 0; n < 2; ++n) { float* p = rowp + bj * HALF + n * 16; const f32x4 xv = *(const f32x4*)p; *(f32x4*)p = xv + gv[bj][n] * acc[ai][bj][m][n]; }
                asm volatile("" ::: "memory"); }
    }
};
struct EpiPart {
    static constexpr bool PERM = false, AFTER_DRAIN = false;
    float* part; int ldc, kslice, rows;
    __device__ __forceinline__ void operator()(const f32x4 (&acc)[2][2][4][2], const Unit& u, int wr, int wc, int fr, int fq) const {
        const int row0 = u.pm * BM + wr * 64 + fr, col0 = u.pn * BM + wc * 32 + 4 * fq;
        float* base = part + (size_t)(u.k0 / kslice) * rows * ldc;
#pragma unroll
        for (int ai = 0; ai < 2; ++ai)
#pragma unroll
            for (int m = 0; m < 4; ++m) { float* rowp = base + (size_t)(row0 + ai * HALF + m * 16) * ldc + col0;
#pragma unroll
                for (int bj = 0; bj < 2; ++bj)
#pragma unroll
                    for (int n = 0; n < 2; ++n) *(f32x4*)(rowp + bj * HALF + n * 16) = acc[ai][bj][m][n]; }
    }
};

template <class Epi, class Sched, bool ALIGN_EPI = false, bool SP2 = false>
__device__ __forceinline__ void gemm_phase(PG8_LAS unsigned char* lds, const Gemm g, const Sched& S, const Epi& E) {
    const int tid = tid_opaque(), wid = __builtin_amdgcn_readfirstlane(tid >> 6), lane = tid & 63, wr = wid >> 2, wc = wid & 3, fr = lane & 15, fq = lane >> 4;
    const int K = g.K, nt = K / BK, ld = g.ld;
    unsigned voffA[2], voffB[2];
#pragma unroll
    for (int i = 0; i < 2; ++i) { int R, C; stage_rc(tid * 16 + i * 8192, R, C); const int Rb = Epi::PERM ? ((R & ~31) + perm32(R & 31)) : R;
        voffA[i] = (unsigned)(R * ld + C) * 2u; voffB[i] = (unsigned)(Rb * ld + C) * 2u; }
    const size_t kstep = (size_t)(BK * 2);
    const size_t hstep = (size_t)HALF * ld * 2;
    const size_t tstep = 2 * hstep;
    const unsigned ldsw = (unsigned)wid * 1024u;
    const int aoff = lds_byte(wr * 64 + fr, fq * 8), boff = lds_byte(wc * 32 + fr, fq * 8);
#define PG8_SA(b, h) (((b) * 2 + (h)) * HTB)
#define PG8_SB(b, h) ((4 + (b) * 2 + (h)) * HTB)
#define PG8_STAGE(bufoff, gbase, voff) do { _Pragma("unroll") for (int _i = 0; _i < 2; ++_i) \
        __builtin_amdgcn_global_load_lds((const unsigned*)((const char*)(gbase) + (voff)[_i]), (PG8_LAS unsigned*)(lds + (bufoff) + ldsw + _i * 8192), 16, 0, 0); } while (0)
#define PG8_LDA(dst, b, h) do { _Pragma("unroll") for (int m = 0; m < 4; ++m) _Pragma("unroll") for (int k = 0; k < 2; ++k) dst[m][k] = *(const PG8_LAS bf16x8*)(lds + PG8_SA(b, h) + aoff + m * 2048 + k * 1024); } while (0)
#define PG8_LDB(dst, b, h) do { _Pragma("unroll") for (int n = 0; n < 2; ++n) _Pragma("unroll") for (int k = 0; k < 2; ++k) dst[n][k] = *(const PG8_LAS bf16x8*)(lds + PG8_SB(b, h) + boff + n * 2048 + k * 1024); } while (0)
#define PG8_MMA(ai, bj, At, Bt) do { __builtin_amdgcn_s_setprio(1); _Pragma("unroll") for (int m = 0; m < 4; ++m) _Pragma("unroll") for (int n = 0; n < 2; ++n) _Pragma("unroll") for (int k = 0; k < 2; ++k) \
        acc[ai][bj][m][n] = __builtin_amdgcn_mfma_f32_16x16x32_bf16(Bt[n][k], At[m][k], acc[ai][bj][m][n], 0, 0, 0); __builtin_amdgcn_s_setprio(0); } while (0)
#define PG8_WAIT_V(n) asm volatile("s_waitcnt vmcnt(" #n ")" ::: "memory")
#define PG8_WAIT_L(n) asm volatile("s_waitcnt lgkmcnt(" #n ")" ::: "memory")
#define PG8_BAR __builtin_amdgcn_s_barrier()
#define PG8_SCHED __builtin_amdgcn_sched_barrier(0)
    Unit cur, nxt; int ui = 0;
    if (!S.next(0, cur)) return;
    f32x4 acc[2][2][4][2];
#pragma unroll
    for (int a = 0; a < 2; ++a)
#pragma unroll
        for (int b = 0; b < 2; ++b)
#pragma unroll
            for (int m = 0; m < 4; ++m)
#pragma unroll
                for (int n = 0; n < 2; ++n) acc[a][b][m][n] = (f32x4){0.f, 0.f, 0.f, 0.f};
    bf16x8 At[4][2], B0[2][2], B1[2][2];
    const char* cA = (const char*)g.A + (size_t)cur.pm * tstep + (size_t)cur.k0 * 2; const char* cB = (const char*)g.Bt + (size_t)cur.pn * tstep + (size_t)cur.k0 * 2;
    S.a_ready(cur);
    if constexpr (SP2) {
        PG8_STAGE(PG8_SB(0, 0), cB, voffB); PG8_STAGE(PG8_SB(0, 1), cB + hstep, voffB); PG8_STAGE(PG8_SA(0, 0), cA, voffA); PG8_STAGE(PG8_SA(0, 1), cA + hstep, voffA);
        if (wr == 1) PG8_BAR;
        PG8_WAIT_V(2); PG8_BAR;
        PG8_STAGE(PG8_SB(1, 0), cB + kstep, voffB); PG8_STAGE(PG8_SA(1, 0), cA + kstep, voffA); PG8_STAGE(PG8_SB(1, 1), cB + hstep + kstep, voffB);
        PG8_WAIT_V(6); PG8_BAR;
    } else {
        PG8_STAGE(PG8_SB(0, 0), cB, voffB); PG8_STAGE(PG8_SA(0, 0), cA, voffA); PG8_STAGE(PG8_SB(0, 1), cB + hstep, voffB); PG8_STAGE(PG8_SA(0, 1), cA + hstep, voffA);
        if (wr == 1) PG8_BAR;
        PG8_WAIT_V(4); PG8_BAR;
        PG8_STAGE(PG8_SB(1, 0), cB + kstep, voffB); PG8_STAGE(PG8_SA(1, 0), cA + kstep, voffA); PG8_STAGE(PG8_SB(1, 1), cB + hstep + kstep, voffB);
        PG8_WAIT_V(6); PG8_BAR;
    }
    for (;;) {
        const bool has_next = S.next(ui + 1, nxt);
        const char* nA = has_next ? (const char*)g.A + (size_t)nxt.pm * tstep + (size_t)nxt.k0 * 2 : cA; const char* nB = has_next ? (const char*)g.Bt + (size_t)nxt.pn * tstep + (size_t)nxt.k0 * 2 : cB;
        asm volatile(".p2align 8");
        for (int t = 0; t < nt; t += 2) {
            const bool last = (t == nt - 2);
            const char* a1 = cA + (size_t)(t + 1) * kstep;
            const char* a2 = last ? nA : cA + (size_t)(t + 2) * kstep; const char* b2 = last ? nB : cB + (size_t)(t + 2) * kstep;
            const char* a3 = a2 + kstep; const char* b3 = b2 + kstep;
            if (last && has_next) S.a_ready(nxt);
            if constexpr (SP2) {
            PG8_LDB(B0, 0, 0); PG8_LDB(B1, 0, 1); PG8_SCHED; PG8_LDA(At, 0, 0); PG8_STAGE(PG8_SA(1, 1), a1 + hstep, voffA);
            PG8_WAIT_V(8); PG8_WAIT_L(0); PG8_BAR; PG8_MMA(0, 0, At, B0); PG8_MMA(0, 1, At, B1); PG8_BAR; PG8_SCHED;
            PG8_LDA(At, 0, 1); PG8_STAGE(PG8_SB(0, 0), b2, voffB); PG8_STAGE(PG8_SB(0, 1), b2 + hstep, voffB); PG8_STAGE(PG8_SA(0, 0), a2, voffA);
            PG8_WAIT_V(8); PG8_WAIT_L(0); PG8_BAR; PG8_MMA(1, 0, At, B0); PG8_MMA(1, 1, At, B1); PG8_BAR; PG8_SCHED;
            PG8_LDB(B0, 1, 0); PG8_LDB(B1, 1, 1); PG8_SCHED; PG8_LDA(At, 1, 0); PG8_STAGE(PG8_SA(0, 1), a2 + hstep, voffA);
            PG8_WAIT_V(8); PG8_WAIT_L(0); PG8_BAR; PG8_MMA(0, 0, At, B0); PG8_MMA(0, 1, At, B1); PG8_BAR; PG8_SCHED;
            PG8_LDA(At, 1, 1); PG8_STAGE(PG8_SB(1, 0), b3, voffB); PG8_STAGE(PG8_SB(1, 1), b3 + hstep, voffB); PG8_STAGE(PG8_SA(1, 0), a3, voffA);
            PG8_WAIT_V(8); PG8_WAIT_L(0); PG8_BAR; PG8_MMA(1, 0, At, B0); PG8_MMA(1, 1, At, B1); PG8_BAR; PG8_SCHED;
            } else {
            PG8_LDB(B0, 0, 0); PG8_SCHED; PG8_LDA(At, 0, 0); PG8_STAGE(PG8_SA(1, 1), a1 + hstep, voffA);
            PG8_WAIT_L(8); PG8_BAR; PG8_WAIT_L(0); PG8_MMA(0, 0, At, B0); PG8_BAR; PG8_SCHED;
            PG8_LDB(B1, 0, 1); PG8_STAGE(PG8_SB(0, 0), b2, voffB);
            PG8_BAR; PG8_WAIT_L(0); PG8_MMA(0, 1, At, B1); PG8_BAR;
            PG8_LDA(At, 0, 1); PG8_STAGE(PG8_SA(0, 0), a2, voffA);
            PG8_BAR; PG8_WAIT_L(0); PG8_MMA(1, 0, At, B0); PG8_BAR; PG8_SCHED;
            PG8_STAGE(PG8_SB(0, 1), b2 + hstep, voffB);
            PG8_WAIT_V(6); PG8_BAR; PG8_MMA(1, 1, At, B1); PG8_BAR;
            PG8_LDB(B0, 1, 0); PG8_SCHED; PG8_LDA(At, 1, 0); PG8_STAGE(PG8_SA(0, 1), a2 + hstep, voffA);
            PG8_WAIT_L(8); PG8_BAR; PG8_WAIT_L(0); PG8_MMA(0, 0, At, B0); PG8_BAR; PG8_SCHED;
            PG8_LDB(B1, 1, 1); PG8_STAGE(PG8_SB(1, 0), b3, voffB);
            PG8_BAR; PG8_WAIT_L(0); PG8_MMA(0, 1, At, B1); PG8_BAR;
            PG8_LDA(At, 1, 1); PG8_STAGE(PG8_SA(1, 0), a3, voffA);
            PG8_BAR; PG8_WAIT_L(0); PG8_MMA(1, 0, At, B0); PG8_BAR; PG8_SCHED;
            PG8_STAGE(PG8_SB(1, 1), b3 + hstep, voffB);
            PG8_WAIT_V(6); PG8_BAR; PG8_MMA(1, 1, At, B1); PG8_BAR;
            }
        }
        if constexpr (ALIGN_EPI) { if (wr == 0) PG8_BAR; }
        if constexpr (!Epi::AFTER_DRAIN) { E(acc, cur, wr, wc, fr, fq); S.done(cur); }
        if (!has_next) break;
#pragma unroll
        for (int a = 0; a < 2; ++a)
#pragma unroll
            for (int b = 0; b < 2; ++b)
#pragma unroll
                for (int m = 0; m < 4; ++m)
#pragma unroll
                    for (int n = 0; n < 2; ++n) acc[a][b][m][n] = (f32x4){0.f, 0.f, 0.f, 0.f};
        cur = nxt; cA = nA; cB = nB; ++ui;
        if constexpr (ALIGN_EPI) { if (wr == 1) PG8_BAR; }
    }
    PG8_WAIT_V(0);
    if constexpr (!ALIGN_EPI) { if (wr == 0) PG8_BAR; }
    PG8_BAR;
    if constexpr (Epi::AFTER_DRAIN) { E.fused(acc, cur, wr, wc, fr, fq, lds, wid, lane); S.done(cur); }
#undef PG8_SA
#undef PG8_SB
#undef PG8_STAGE
#undef PG8_LDA
#undef PG8_LDB
#undef PG8_MMA
#undef PG8_WAIT_V
#undef PG8_WAIT_L
#undef PG8_BAR
#undef PG8_SCHED
}
}

namespace att {
using bf16 = __hip_bfloat16;
constexpr int   D = 128, NW = 8, QBLK = 32, KVBLK = 64;
constexpr float SCALE = 0.088388347648318440f;
constexpr float THR = 8.f;
constexpr int SDEPTH = 2;
constexpr int LDQ = 1536, LDK = 768, LDV = 5120, LDO = 1536;
constexpr size_t SHM_V = KVBLK * D * 2, SHM_K = KVBLK * D * 2, SHM_ATTN = 2 * SHM_V + 2 * SHM_K + NW * 64 * 4;
using bf16x8 = __attribute__((ext_vector_type(8))) short;
using s16x4  = __attribute__((ext_vector_type(4))) short;
using f32x16 = __attribute__((ext_vector_type(16))) float;
using f32x8  = __attribute__((ext_vector_type(8))) float;
using u32x4  = __attribute__((ext_vector_type(4))) unsigned;
#define KSWZ(row, colB) ((row) * 256 + ((colB) ^ (((row) & 7) << 4)))
#define SBAR() __builtin_amdgcn_sched_barrier(0)
__device__ __forceinline__ int crow(int r, int hi) { return (r & 3) + 8 * (r >> 2) + 4 * hi; }
__device__ __forceinline__ unsigned cvtpk(float lo, float hi) {
  unsigned r; asm volatile("v_cvt_pk_bf16_f32 %0, %1, %2" : "=v"(r) : "v"(lo), "v"(hi)); return r;
}
template <typename TIn> struct Stage;
template <> struct Stage<bf16>  { using T = bf16x8;
  __device__ static __forceinline__ T ld8(const bf16* p) { return *reinterpret_cast<const bf16x8*>(p); }
  __device__ static __forceinline__ bf16x8 tobf(T x) { return x; } };
template <> struct Stage<float> { using T = f32x8;
  __device__ static __forceinline__ T ld8(const float* p) { return *reinterpret_cast<const f32x8*>(p); }
  __device__ static __forceinline__ bf16x8 tobf(T x) {
    u32x4 w = {cvtpk(x[0], x[1]), cvtpk(x[2], x[3]), cvtpk(x[4], x[5]), cvtpk(x[6], x[7])}; return *reinterpret_cast<bf16x8*>(&w); } };

__device__ __forceinline__ void partialSM(f32x16& p0, f32x16& p1, float& m_reg, float& mn, float& alpha) {
  constexpr float C = SCALE * 1.4426950408889634f;
  float pmax = p0[0]; for (int r = 1; r < 16; ++r) pmax = fmaxf(pmax, p0[r]); for (int r = 0; r < 16; ++r) pmax = fmaxf(pmax, p1[r]);
  { auto rr = __builtin_amdgcn_permlane32_swap(__float_as_uint(pmax), __float_as_uint(pmax), false, false);
    pmax = fmaxf(__uint_as_float(rr[0]), __uint_as_float(rr[1])); }
  if (__builtin_expect(__all(pmax - m_reg <= THR / SCALE), 1)) { mn = m_reg; alpha = 1.f; }
  else { mn = fmaxf(m_reg, pmax); alpha = __builtin_amdgcn_exp2f((m_reg - mn) * C); m_reg = mn; }
  float mnC = -mn * C;
  for (int r = 0; r < 16; ++r) p0[r] = fmaf(p0[r], C, mnC); for (int r = 0; r < 16; ++r) p1[r] = fmaf(p1[r], C, mnC);
  for (int r = 0; r < 16; ++r) p0[r] = __builtin_amdgcn_exp2f(p0[r]);
}
__device__ __forceinline__ void finishSM(f32x16& p0, f32x16& p1, float alpha, float& l_reg, bf16x8& pa0, bf16x8& pa1, bf16x8& pa2, bf16x8& pa3) {
  for (int r = 0; r < 16; ++r) p1[r] = __builtin_amdgcn_exp2f(p1[r]);
  float ps = 0; for (int r = 0; r < 16; ++r) ps += p0[r]; for (int r = 0; r < 16; ++r) ps += p1[r];
  { auto rr = __builtin_amdgcn_permlane32_swap(__float_as_uint(ps), __float_as_uint(ps), false, false);
    ps = __uint_as_float(rr[0]) + __uint_as_float(rr[1]); }
  l_reg = l_reg * alpha + ps;
#define PK4(P, BASE, OUT) do { unsigned a0 = cvtpk(P[BASE + 0], P[BASE + 1]), a1 = cvtpk(P[BASE + 2], P[BASE + 3]);   \
    unsigned b0 = cvtpk(P[BASE + 4], P[BASE + 5]), b1 = cvtpk(P[BASE + 6], P[BASE + 7]);                              \
    auto r0 = __builtin_amdgcn_permlane32_swap(a0, b0, false, false); auto r1 = __builtin_amdgcn_permlane32_swap(a1, b1, false, false); \
    u32x4 w = {r0[0], r1[0], r0[1], r1[1]}; OUT = *reinterpret_cast<bf16x8*>(&w); } while (0)
  PK4(p0, 0, pa0); PK4(p0, 8, pa1); PK4(p1, 0, pa2); PK4(p1, 8, pa3);
#undef PK4
}
template <int ND0> __device__ __forceinline__ void qkt(f32x16& p0, f32x16& p1, const bf16* Ks, const bf16x8* qr, int r32, int hi, int kcb) {
  p0 = f32x16{}; p1 = f32x16{};
#pragma unroll
  for (int d0 = 0; d0 < ND0; ++d0) { int cb = (d0 * 16 + hi * 8) * 2 + kcb;
    bf16x8 b0 = *reinterpret_cast<const bf16x8*>((const char*)Ks + KSWZ(r32, cb));
    bf16x8 b1 = *reinterpret_cast<const bf16x8*>((const char*)Ks + KSWZ(32 + r32, cb));
    p0 = __builtin_amdgcn_mfma_f32_32x32x16_bf16(b0, qr[d0], p0, 0, 0, 0);
    p1 = __builtin_amdgcn_mfma_f32_32x32x16_bf16(b1, qr[d0], p1, 0, 0, 0); }
}
__device__ __forceinline__ int v_st(int k, int c) { const int kk = (k & ~0xC) | ((k & 4) << 1) | ((k & 8) >> 1); return ((kk >> 3) * 4 + (c >> 5)) * 512 + ((kk & 7) * 32 + (c & 31)) * 2; }
__device__ __forceinline__ int v_rd_base(int lane) { return ((lane & 3) << 3) | (((lane >> 2) & 3) << 6) | (((lane >> 4) & 1) << 5) | (((lane >> 5) & 1) << 8); }
constexpr int v_rd_off(int d0, int ks, int half) { return d0 * 512 + ks * 4096 + half * 2048; }
template <int OFF> __device__ __forceinline__ s16x4 tr_read(int vb) {
  s16x4 r; asm volatile("ds_read_b64_tr_b16 %0, %1 offset:%2" : "=&v"(r) : "v"(vb), "i"(OFF) : "memory"); return r;
}
template <int D0> __device__ __forceinline__ void pv_one(f32x16& od, int vb, bf16x8 pa0, bf16x8 pa1, bf16x8 pa2, bf16x8 pa3) {
  const s16x4 l0 = tr_read<v_rd_off(D0, 0, 0)>(vb), h0 = tr_read<v_rd_off(D0, 0, 1)>(vb), l1 = tr_read<v_rd_off(D0, 1, 0)>(vb), h1 = tr_read<v_rd_off(D0, 1, 1)>(vb);
  const s16x4 l2 = tr_read<v_rd_off(D0, 2, 0)>(vb), h2 = tr_read<v_rd_off(D0, 2, 1)>(vb), l3 = tr_read<v_rd_off(D0, 3, 0)>(vb), h3 = tr_read<v_rd_off(D0, 3, 1)>(vb);
  asm volatile("s_waitcnt lgkmcnt(0)" ::: "memory"); SBAR();
#define PK(L, H) (bf16x8){L[0], L[1], L[2], L[3], H[0], H[1], H[2], H[3]}
  od = __builtin_amdgcn_mfma_f32_32x32x16_bf16(pa0, PK(l0, h0), od, 0, 0, 0);
  od = __builtin_amdgcn_mfma_f32_32x32x16_bf16(pa1, PK(l1, h1), od, 0, 0, 0);
  od = __builtin_amdgcn_mfma_f32_32x32x16_bf16(pa2, PK(l2, h2), od, 0, 0, 0);
  od = __builtin_amdgcn_mfma_f32_32x32x16_bf16(pa3, PK(l3, h3), od, 0, 0, 0);
#undef PK
}
__device__ __forceinline__ void pv_d0(f32x16* o, int vb, bf16x8 pa0, bf16x8 pa1, bf16x8 pa2, bf16x8 pa3) {
  pv_one<0>(o[0], vb, pa0, pa1, pa2, pa3); pv_one<1>(o[1], vb, pa0, pa1, pa2, pa3); pv_one<2>(o[2], vb, pa0, pa1, pa2, pa3); pv_one<3>(o[3], vb, pa0, pa1, pa2, pa3);
}

template <typename TQ, int ND0, bool PARTIAL>
__device__ __forceinline__ void attn_dense_body(const TQ* __restrict__ Qb, const bf16* __restrict__ Kh, const bf16* __restrict__ Vh,
                                                float* __restrict__ Ob, int seq, char* lds, int kcb, float* __restrict__ ML) {
  using St = Stage<bf16>; using SQ = Stage<TQ>;
  const int tid = tid_opaque(), wid = tid >> 6, lane = tid & 63, r32 = lane & 31, hi = lane >> 5;
  bf16* V_lds = (bf16*)lds; bf16* K_lds = (bf16*)(lds + 2 * SHM_V);
  float* ws = (float*)(lds + 2 * SHM_V + 2 * SHM_K) + wid * 64; float* li_l = ws; float* al_l = ws + 32;
  float m_reg = -1e30f, l_reg = 0; f32x16 o[4] = {}; bf16x8 qr[8];
  const TQ* Qw = Qb + (long)(wid * QBLK + r32) * LDQ + hi * 8;
#pragma unroll
  for (int d0 = 0; d0 < ND0; ++d0) qr[d0] = SQ::tobf(SQ::ld8(Qw + d0 * 16));
  const int sr = tid >> 4, sc = (tid & 15) * 8, vst0 = v_st(sr, sc), vst1 = v_st(32 + sr, sc);
  const int vb0 = (int)(uintptr_t)V_lds + v_rd_base(lane);
  struct { typename St::T vs0, vs1, ks0, ks1; } sr_[SDEPTH];
#define SLOAD(i, k0) do { sr_[i].vs0 = St::ld8(&Vh[(long)((k0) + sr) * LDV + sc]); sr_[i].vs1 = St::ld8(&Vh[(long)((k0) + 32 + sr) * LDV + sc]); \
    sr_[i].ks0 = St::ld8(&Kh[(long)((k0) + sr) * LDK + sc]); sr_[i].ks1 = St::ld8(&Kh[(long)((k0) + 32 + sr) * LDK + sc]); } while (0)
#define SWRITE(b, i) do { *(bf16x8*)((char*)V_lds + (b) * SHM_V + vst0) = St::tobf(sr_[i].vs0);          \
    *(bf16x8*)((char*)V_lds + (b) * SHM_V + vst1) = St::tobf(sr_[i].vs1); int kc = sc * 2;               \
    *(bf16x8*)((char*)K_lds + (b) * SHM_K + KSWZ(sr, kc)) = St::tobf(sr_[i].ks0);                       \
    *(bf16x8*)((char*)K_lds + (b) * SHM_K + KSWZ(32 + sr, kc)) = St::tobf(sr_[i].ks1); } while (0)
#define SWAIT() do { if constexpr (SDEPTH == 2) asm volatile("s_waitcnt vmcnt(4)" ::: "memory"); else asm volatile("s_waitcnt vmcnt(0)" ::: "memory"); } while (0)
#define RESC(a) do { if (__any((a) < 1.f)) { if (hi == 0) al_l[r32] = (a); asm volatile("s_waitcnt lgkmcnt(0)" ::: "memory"); \
    for (int d = 0; d < 4; ++d) for (int r = 0; r < 16; ++r) o[d][r] *= al_l[crow(r, hi)]; } } while (0)
  f32x16 pA0, pA1, pB0, pB1; float mnA, mnB, alA, alB; bf16x8 pa0, pa1, pa2, pa3; const int NT = seq / KVBLK;
  constexpr int SE = 0, SO = SDEPTH - 1;
  SLOAD(SE, 0); asm volatile("s_waitcnt vmcnt(0)" ::: "memory"); SWRITE(0, SE); __syncthreads();
  qkt<ND0>(pA0, pA1, K_lds, qr, r32, hi, kcb); partialSM(pA0, pA1, m_reg, mnA, alA);
  SLOAD(SO, KVBLK); if constexpr (SDEPTH == 2) { if (2 < NT) SLOAD(SE, 2 * KVBLK); }
  SWAIT(); SWRITE(1, SO); __syncthreads();
  asm volatile(".p2align 8");
  for (int j = 1; j + 1 < NT; j += 2) {
    SBAR(); qkt<ND0>(pB0, pB1, (bf16*)((char*)K_lds + SHM_K), qr, r32, hi, kcb);
    finishSM(pA0, pA1, alA, l_reg, pa0, pa1, pa2, pa3); SBAR();
    SLOAD(SO, (j + SDEPTH) * KVBLK); SBAR();
    pv_d0(o, vb0, pa0, pa1, pa2, pa3); partialSM(pB0, pB1, m_reg, mnB, alB);
    __syncthreads(); SWAIT(); SWRITE(0, SE);
    RESC(alB); __syncthreads();
    SBAR(); qkt<ND0>(pA0, pA1, K_lds, qr, r32, hi, kcb);
    finishSM(pB0, pB1, alB, l_reg, pa0, pa1, pa2, pa3); SBAR();
    if (SDEPTH == 1 || j + 3 < NT) SLOAD(SE, (j + 1 + SDEPTH) * KVBLK); SBAR();
    pv_d0(o, vb0 + (int)SHM_V, pa0, pa1, pa2, pa3); partialSM(pA0, pA1, m_reg, mnA, alA);
    __syncthreads(); SWAIT(); SWRITE(1, SO);
    RESC(alA); __syncthreads();
  }
  SBAR(); qkt<ND0>(pB0, pB1, (bf16*)((char*)K_lds + SHM_K), qr, r32, hi, kcb);
  finishSM(pA0, pA1, alA, l_reg, pa0, pa1, pa2, pa3); SBAR();
  pv_d0(o, vb0, pa0, pa1, pa2, pa3); partialSM(pB0, pB1, m_reg, mnB, alB);
  __syncthreads(); RESC(alB);
  finishSM(pB0, pB1, alB, l_reg, pa0, pa1, pa2, pa3); SBAR();
  pv_d0(o, vb0 + (int)SHM_V, pa0, pa1, pa2, pa3);
  if (hi == 0) li_l[r32] = l_reg; asm volatile("s_waitcnt lgkmcnt(0)" ::: "memory");
  float rli[16];
#pragma unroll
  for (int r = 0; r < 16; ++r) rli[r] = PARTIAL ? 1.f : __builtin_amdgcn_rcpf(li_l[crow(r, hi)]);
  if (PARTIAL) { if (hi == 0) { float* mp = ML + (long)(wid * QBLK + r32) * 24; mp[0] = m_reg * (SCALE * 1.4426950408889634f); mp[1] = l_reg; } }
  float* Ow = Ob + (long)(wid * QBLK) * LDO;
#pragma unroll
  for (int r = 0; r < 16; ++r) { int orow = crow(r, hi);
    for (int d0 = 0; d0 < 4; ++d0) Ow[(long)orow * LDO + d0 * 32 + r32] = o[d0][r] * rli[r]; }
#undef SLOAD
#undef SWRITE
#undef SWAIT
#undef RESC
}
}

#define GAS __attribute__((address_space(1)))
typedef unsigned short bf16_t;
typedef unsigned v4u __attribute__((ext_vector_type(4)));
typedef unsigned v2u __attribute__((ext_vector_type(2)));
typedef float f32x4 __attribute__((ext_vector_type(4)));
typedef float f32x2 __attribute__((ext_vector_type(2)));
typedef short bf16x8 __attribute__((ext_vector_type(8)));

constexpr int DM = 2048, TL = 8192, TC = 256, TA = TL + TC, DEPTH = 4, DFF = 5632;
constexpr int NP = 5120, NIN = 5136;
constexpr int C_DAQ = 0, C_DAK = 512, C_DAV = 1024, C_GQ = 1536, C_GK = 2048, C_GV = 2304, C_LX = 2560, C_LG = 3072, C_SZ = 3584, C_SX = 4096, C_SB = 4608, C_SC = 4864, C_DT = 5120;
constexpr int QLD = 1536, KLD = 768;
constexpr float NEPS = 1e-6f;
constexpr int NWAVES = 8;
#ifndef FIN_INPLACE
#define FIN_INPLACE 1
#endif
#ifndef SUBM
#define SUBM 7
#endif

constexpr size_t MiB = 1u << 20;
constexpr size_t WS_CTL = 0, CTL_ZERO_BYTES = 1 * MiB;
constexpr size_t WS_WIN = 2 * MiB, WS_WOUT = 82 * MiB, WS_WUP = 114 * MiB, WS_WDN = 290 * MiB, WS_WG = 378 * MiB;
constexpr size_t WS_MODP = 380 * MiB, WS_MODF = 383 * MiB, WS_ROPE = 384 * MiB;
constexpr size_t WS_X = 385 * MiB, WS_XN = 451 * MiB, WS_P = 484 * MiB, WS_QB = 567 * MiB, WS_KB = 592 * MiB, WS_O = 605 * MiB;
constexpr size_t WS_DT = 655 * MiB, WS_ACUM = 656 * MiB, WS_HF = 657 * MiB, WS_PF = 674 * MiB, WS_HB = 691 * MiB, WS_PB = 708 * MiB, WS_LSUM = 725 * MiB;
constexpr size_t WS_YD = 727 * MiB, WS_XC = 744 * MiB, WS_ST = 749 * MiB, WS_SIN = 782 * MiB, WS_CHA = 799 * MiB;
constexpr size_t WS_YCAT = 800 * MiB, WS_GU = 833 * MiB, WS_H = 1015 * MiB, WS_OP1 = 1106 * MiB, WS_ML = 1156 * MiB, WS_YD2 = 1158 * MiB, WS_PART = 1175 * MiB, WS_END = 1197 * MiB;
static_assert(WS_WIN + 4ull * NP * DM * 2 <= WS_WOUT && WS_WOUT + 4ull * DM * DM * 2 <= WS_WUP && WS_WUP + 4ull * 2 * DFF * DM * 2 <= WS_WDN && WS_WDN + 4ull * DM * DFF * 2 <= WS_WG, "weights map");
static_assert(WS_X + (size_t)TA * DM * 4 <= WS_XN && WS_XN + (size_t)TA * DM * 2 <= WS_P && WS_P + (size_t)TA * NP * 2 <= WS_QB && WS_QB + (size_t)TA * QLD * 2 <= WS_KB && WS_KB + (size_t)TA * KLD * 2 <= WS_O && WS_O + (size_t)TA * QLD * 4 <= WS_DT, "act map 1");
static_assert(WS_HF + (size_t)TA * 512 * 4 <= WS_PF && WS_LSUM + 132ull * 2 * 2 * 512 * 4 <= WS_YD && WS_YD + (size_t)TA * 512 * 4 <= WS_XC && WS_XC + (size_t)TA * 256 * 2 <= WS_ST && WS_ST + 66ull * 2 * 65536 * 4 <= WS_SIN && WS_SIN + 66ull * 2 * 65536 * 2 <= WS_CHA, "act map 2");
static_assert(WS_YCAT + (size_t)TA * DM * 2 <= WS_GU && WS_GU + (size_t)TA * 2 * DFF * 2 <= WS_H && WS_H + (size_t)TA * DFF * 2 <= WS_END, "act map 3");
constexpr int CW_BAR = 4096;

constexpr int PH_LDS = 147456;
constexpr int MISC_OFF = PH_LDS;
constexpr int LDS_BYTES = PH_LDS + 1024;
static_assert(WMAP_OFF == MISC_OFF + 512 && WMAP_OFF + 256 <= LDS_BYTES, "wave map inside the LDS control area");

#define LAS __attribute__((address_space(3)))
#define LDS_WAIT() asm volatile("s_waitcnt lgkmcnt(0)" ::: "memory")
#define VM_WAIT() asm volatile("s_waitcnt vmcnt(0)" ::: "memory")
#define RLX_AGENT __ATOMIC_RELAXED, __HIP_MEMORY_SCOPE_AGENT

__device__ __forceinline__ unsigned f2bf(float f) { unsigned u = __builtin_bit_cast(unsigned, f); return (u + 0x7fffu + ((u >> 16) & 1u)) >> 16; }
__device__ __forceinline__ unsigned pk2(float lo, float hi) { unsigned r; asm volatile("v_cvt_pk_bf16_f32 %0, %1, %2" : "=v"(r) : "v"(lo), "v"(hi)); return r; }
__device__ __forceinline__ float bflo(unsigned w) { return __uint_as_float(w << 16); }
__device__ __forceinline__ float bfhi(unsigned w) { return __uint_as_float(w & 0xffff0000u); }
__device__ __forceinline__ float bf1(bf16_t b) { return __uint_as_float(((unsigned)b) << 16); }
__device__ __forceinline__ void unpack8(const v4u w, float (&x)[8]) { x[0] = bflo(w.x); x[1] = bfhi(w.x); x[2] = bflo(w.y); x[3] = bfhi(w.y); x[4] = bflo(w.z); x[5] = bfhi(w.z); x[6] = bflo(w.w); x[7] = bfhi(w.w); }
__device__ __forceinline__ v4u pack8(const float (&x)[8]) { v4u w; w.x = pk2(x[0], x[1]); w.y = pk2(x[2], x[3]); w.z = pk2(x[4], x[5]); w.w = pk2(x[6], x[7]); return w; }
__device__ __forceinline__ float wave_sum(float v) {
#pragma unroll
    for (int o = 1; o < 64; o <<= 1) v += shx(v, o);
    return v;
}
__device__ __forceinline__ float siluf(float x) { return x / (1.f + __expf(-x)); }
__device__ __forceinline__ float sigmf(float x) { return 1.f / (1.f + __expf(-x)); }
__device__ __forceinline__ float softplusf(float x) { return fmaxf(x, 0.f) + log1pf(__expf(-fabsf(x))); }
__device__ __forceinline__ float gelu_tanh(float x) { const float u = 0.7978845608028654f * (x + 0.044715f * x * x * x); return 0.5f * x * (1.f + tanhf(u)); }
#define MFMA16(a, b, c) __builtin_amdgcn_mfma_f32_16x16x32_bf16((a), (b), (c), 0, 0, 0)

struct Fr { LAS unsigned char* lds; char* ldsg; int tid, lane, wave, G, bid, vcu; };
__device__ __forceinline__ Fr fr_refresh(const Fr& F0) { Fr F = F0; F.tid = tid_opaque(); F.lane = F.tid & 63; F.wave = __builtin_amdgcn_readfirstlane(F.tid >> 6);
    asm volatile("" : "+s"(F.bid), "+s"(F.vcu), "+s"(F.G)); return F; }

struct Args { const float* in[30]; float* out; unsigned char* ws; int s_lo, s_hi; };
constexpr int TBL_OFF = PH_LDS + 256;
struct PArgs { LAS unsigned long long* tbl;
    __device__ __forceinline__ unsigned long long get(int k) const { const unsigned long long v = tbl[k];
        const unsigned lo = __builtin_amdgcn_readfirstlane((unsigned)v), hi = __builtin_amdgcn_readfirstlane((unsigned)(v >> 32)); return ((unsigned long long)hi << 32) | lo; }
    __device__ __forceinline__ const float* inp(int k) const { return (const float*)(const GAS float*)get(k); }
    __device__ __forceinline__ float* outp() const { return (float*)(GAS float*)get(30); }
    __device__ __forceinline__ unsigned char* wsp() const { return (unsigned char*)(GAS unsigned char*)get(31); }
};


#define XB_TMO      128
#define XB_XCNT(j)  (256  + 64 * (j))
#define XB_XSUB(j)  (1280 + 64 * (j))
#define XB_XGEN(j)  (2304 + 64 * (j))
#define XB_TOP      3328
#define XB_TOPGEN   3392
#define XCD_BAR_WORDS 3456
#define XB_SPIN_CAP (1u << 18)

__device__ __forceinline__ unsigned xb_ld(unsigned* p)              { return __hip_atomic_load(p, __ATOMIC_RELAXED, __HIP_MEMORY_SCOPE_AGENT); }
__device__ __forceinline__ unsigned xb_add(unsigned* p, unsigned v) { return __hip_atomic_fetch_add(p, v, __ATOMIC_RELAXED, __HIP_MEMORY_SCOPE_AGENT); }
__device__ __forceinline__ unsigned xb_xcc_id() { return (unsigned)__builtin_amdgcn_s_getreg((3 << 11) | 20) & 0xFu; }
#define XB_SPIN(cond, bar) do { unsigned _sp = 0; while (cond) { __builtin_amdgcn_s_sleep(1); \
    if ((++_sp & 255u) == 0u) { if (xb_ld(&(bar)[XB_TMO])) break; if (_sp > XB_SPIN_CAP) { atomicAdd(&(bar)[XB_TMO], 1u); break; } } } } while (0)

struct XcdBarrier {
    unsigned* bar; unsigned x;
    volatile LAS unsigned* st;
};

__device__ __forceinline__ XcdBarrier xcd_barrier_post(unsigned* bar, volatile LAS unsigned* st) {
    XcdBarrier b; b.bar = bar; b.x = xb_xcc_id(); b.st = st;
    if (tid_opaque() == 0) (void)xb_add(&bar[XB_XCNT(b.x)], 1u);
    return b;
}
__device__ __forceinline__ void xcd_barrier_complete(unsigned* bar, unsigned x, unsigned& nloc, unsigned& nx) {
    const unsigned G = gridDim.x * gridDim.y * gridDim.z;
    unsigned sum, cnt, mine, sp = 0u;
    for (;;) {
        sum = 0u; cnt = 0u; mine = 0u;
#pragma unroll
        for (unsigned j = 0; j < 16; ++j) { const unsigned c = xb_ld(&bar[XB_XCNT(j)]); sum += c; cnt += (c > 0u) ? 1u : 0u; mine = (j == x) ? c : mine; }
        if (sum == G) break;
        __builtin_amdgcn_s_sleep(1);
        if ((++sp & 255u) == 0u) { if (xb_ld(&bar[XB_TMO])) break; if (sp > XB_SPIN_CAP) { atomicAdd(&bar[XB_TMO], 1u); break; } }
    }
    nloc = mine > 0u ? mine : 1u; nx = cnt > 0u ? cnt : 1u;
}

__device__ __forceinline__ void xcd_barrier(const XcdBarrier& b) {
    asm volatile("s_waitcnt vmcnt(0)" ::: "memory");
    __syncthreads();
    if (tid_opaque() == 0) {
        unsigned* bar = b.bar;
        __builtin_amdgcn_s_waitcnt(0);
        unsigned nloc = b.st[0], nx = b.st[1];
        if (nloc == 0u) { xcd_barrier_complete(bar, b.x, nloc, nx); b.st[0] = nloc; b.st[1] = nx; }
        const unsigned old = xb_add(&bar[XB_XSUB(b.x)], 1u);
        const unsigned gen = old / nloc;
        if (old + 1u == (gen + 1u) * nloc) {
            __builtin_amdgcn_fence(__ATOMIC_RELEASE, "agent");
            asm volatile("s_waitcnt vmcnt(0)" ::: "memory");
            const unsigned og = xb_add(&bar[XB_TOP], 1u);
            const unsigned tg = og / nx;
            if (og + 1u == (tg + 1u) * nx) xb_add(&bar[XB_TOPGEN], 1u);
            else XB_SPIN(xb_ld(&bar[XB_TOPGEN]) == tg, bar);
            __builtin_amdgcn_fence(__ATOMIC_ACQUIRE, "agent");
            xb_add(&bar[XB_XGEN(b.x)], 1u);
            asm volatile("s_waitcnt vmcnt(0)" ::: "memory");
        } else {
            XB_SPIN(xb_ld(&bar[XB_XGEN(b.x)]) == gen, bar);
            __builtin_amdgcn_fence(__ATOMIC_ACQUIRE, "agent");
            asm volatile("s_waitcnt vmcnt(0)" ::: "memory");
        }
    }
    __syncthreads();
}

__device__ __forceinline__ void tr_item(const float* W, int ldW, int Nuse, bf16_t* WT, int K, LAS float* scr, int item, int lane) {
    const int nblk = Nuse / 32, kb = item / nblk, nb = item % nblk, k0 = 64 * kb, n0 = 32 * nb;
#pragma unroll 8
    for (int i = 0; i < 32; ++i) { const int kk = 2 * i + (lane >> 5); scr[kk * 33 + (lane & 31)] = W[(size_t)(k0 + kk) * ldW + n0 + (lane & 31)]; }
    LDS_WAIT(); asm volatile("" ::: "memory");
    const int c = lane & 7;
#pragma unroll
    for (int j = 0; j < 4; ++j) { const int n = (lane >> 3) + 8 * j; const LAS float* s = scr + (8 * c) * 33 + n;
        v4u o; o.x = pk2(s[0 * 33], s[1 * 33]); o.y = pk2(s[2 * 33], s[3 * 33]); o.z = pk2(s[4 * 33], s[5 * 33]); o.w = pk2(s[6 * 33], s[7 * 33]);
        *(v4u*)(WT + (size_t)(n0 + n) * K + k0 + 8 * c) = o; }
    LDS_WAIT(); asm volatile("" ::: "memory");
}
__device__ __forceinline__ void sincos_small(float x, float& s, float& c) {
    const float q = rintf(x * 0.6366197723675814f); const int n = (int)q;
    float r = fmaf(q, -1.5703125f, x); r = fmaf(q, -4.837512969970703125e-4f, r); r = fmaf(q, -7.54978995489188216e-8f, r);
    const float z = r * r;
    const float sp = r + r * z * (-1.6666654611e-1f + z * (8.3321608736e-3f + z * (-1.9515295891e-4f)));
    const float cp = 1.f - 0.5f * z + z * z * (4.166664568298827e-2f + z * (-1.388731625493765e-3f + z * 2.443315711809948e-5f));
    switch (n & 3) { case 0: s = sp; c = cp; break; case 1: s = cp; c = -sp; break; case 2: s = -sp; c = -cp; break; default: s = -cp; c = sp; break; }
}
__device__ __forceinline__ void ph_prologue(const Fr& F0, const PArgs& A) {
    const Fr F = fr_refresh(F0);
    unsigned char* ws = A.wsp();
    const int gw = F.bid * NWAVES + F.wave, NGW = F.G * NWAVES;
    LAS float* scr = (LAS float*)(F.lds + F.wave * 8704);
    constexpr int I_IN = 32 * 160, I_OUT = 32 * 64, I_UP = 32 * 352, I_DN = 88 * 64, I_WG = 16 * 8, I_L = I_IN + I_OUT + I_UP + I_DN + I_WG;
    for (int it = gw; it < DEPTH * I_L; it += NGW) {
        const int L = it / I_L; int r = it % I_L;
        if (r < I_IN) { tr_item(A.inp(8) + (size_t)L * DM * NIN, NIN, NP, (bf16_t*)(ws + WS_WIN) + (size_t)L * NP * DM, DM, scr, r, F.lane); continue; } r -= I_IN;
        if (r < I_OUT) { tr_item(A.inp(9) + (size_t)L * DM * DM, DM, DM, (bf16_t*)(ws + WS_WOUT) + (size_t)L * DM * DM, DM, scr, r, F.lane); continue; } r -= I_OUT;
        if (r < I_UP) { tr_item(A.inp(25) + (size_t)L * DM * 2 * DFF, 2 * DFF, 2 * DFF, (bf16_t*)(ws + WS_WUP) + (size_t)L * 2 * DFF * DM, DM, scr, r, F.lane); continue; } r -= I_UP;
        if (r < I_DN) { tr_item(A.inp(28) + (size_t)L * DFF * DM, DM, DM, (bf16_t*)(ws + WS_WDN) + (size_t)L * DM * DFF, DFF, scr, r, F.lane); continue; } r -= I_DN;
        { const int mi = r / 8; tr_item(A.inp(16) + (size_t)(L * 16 + mi) * 16384, 128, 128, (bf16_t*)(ws + WS_WG) + (size_t)(L * 16 + mi) * 16384, 128, scr, r % 8, F.lane); }
    }
    float* modp = (float*)(ws + WS_MODP);
    for (int it = gw; it < DEPTH * 48 * 8; it += NGW) {
        const int L = it / 384, r = it % 384, nb = r / 8, ks = r % 8, k0 = ks * 256;
        f32x4 c0 = *(const f32x4*)(A.inp(1) + k0 + 4 * F.lane), c1 = *(const f32x4*)(A.inp(3) + k0 + 4 * F.lane);
#pragma unroll
        for (int i = 0; i < 4; ++i) { c0[i] = siluf(c0[i]); c1[i] = siluf(c1[i]); }
        f32x4 a0 = {0.f, 0.f, 0.f, 0.f}, a1 = {0.f, 0.f, 0.f, 0.f};
        const float* wp = A.inp(4) + ((size_t)(L * DM + k0)) * (6 * DM) + nb * 256 + 4 * F.lane;
#pragma unroll 2
        for (int q = 0; q < 64; ++q) {
#pragma unroll
            for (int i = 0; i < 4; ++i) {
                const float s0 = __uint_as_float(__builtin_amdgcn_readlane(__float_as_uint(c0[i]), q)), s1 = __uint_as_float(__builtin_amdgcn_readlane(__float_as_uint(c1[i]), q));
                const f32x4 w = *(const f32x4*)(wp + (size_t)(4 * q + i) * (6 * DM));
                a0 += s0 * w; a1 += s1 * w; }
        }
        *(f32x4*)(modp + ((size_t)((L * 8 + ks) * 2 + 0)) * (6 * DM) + nb * 256 + 4 * F.lane) = a0;
        *(f32x4*)(modp + ((size_t)((L * 8 + ks) * 2 + 1)) * (6 * DM) + nb * 256 + 4 * F.lane) = a1;
    }
    { const int gt = F.bid * 512 + F.tid, NT = F.G * 512; f32x4* X4 = (f32x4*)(ws + WS_X);
      const f32x4* c4 = (const f32x4*)A.inp(2); const f32x4* x4 = (const f32x4*)A.inp(0);
      constexpr int NC4 = TC * DM / 4, NA4 = TA * DM / 4;
      for (int i = gt; i < NA4; i += NT) X4[i] = (i < NC4) ? c4[i] : x4[i - NC4]; }
    { const int gt = F.bid * 512 + F.tid; if (gt < 128 * 48) { const int pos = gt / 48, f = gt % 48;
        const float fr = (f < 16) ? powf(10000.f, -(float)f / 16.f) : powf(10000.f, -(float)(f - 16) / 32.f);
        float s, c; sincos_small((float)pos * fr, s, c); ((f32x2*)(ws + WS_ROPE))[gt] = (f32x2){c, s}; } }
}
__device__ __forceinline__ void ph_modf(const Fr& F0, const PArgs& A) {
    const Fr F = fr_refresh(F0);
    const float* modp = (const float*)(A.wsp() + WS_MODP); float* modf = (float*)(A.wsp() + WS_MODF);
    for (int i = F.bid * 512 + F.tid; i < DEPTH * 2 * 6 * DM; i += F.G * 512) {
        const int L = i / (2 * 6 * DM), r = i % (2 * 6 * DM), cd = r / (6 * DM), n = r % (6 * DM);
        float s = A.inp(5)[L * 6 * DM + n];
#pragma unroll
        for (int ks = 0; ks < 8; ++ks) s += modp[((size_t)((L * 8 + ks) * 2 + cd)) * (6 * DM) + n];
        modf[i] = s; }
}

template <bool DTP>
__device__ __forceinline__ void ph_norm(const Fr& F0, float* X, bf16_t* XN, const float* nw, const float* mod_lat, const float* mod_ctx, int sh_off, int sc_off,
                                        const float* win_layer, const float* dt_bias, float* DT, const float* part, int nsl, const float* gate_ctx) {
    const Fr F = fr_refresh(F0);
    LAS float* AL = (LAS float*)F.lds; LAS float* BL = AL + DM; LAS float* WDT = BL + DM;
    for (int k = F.tid; k < DM; k += 512) { AL[k] = nw[k] * (1.f + mod_lat[sc_off + k]); BL[k] = mod_lat[sh_off + k]; }
    if (DTP) for (int idx = F.tid; idx < DM * 16; idx += 512) { const int k = idx >> 4, j = idx & 15; WDT[j * DM + k] = win_layer[(size_t)k * NIN + C_DT + j]; }
    __syncthreads();
    const int gw = F.bid * NWAVES + F.wave, NGW = F.G * NWAVES, lane = F.lane;
    for (int row = gw; row < TA; row += NGW) {
        const f32x4* xr = (const f32x4*)(X + (size_t)row * DM) + lane;
        f32x4 v[8]; float ss = 0.f;
        const bool isctx = row < TC;
#pragma unroll
        for (int j = 0; j < 8; ++j) v[j] = xr[64 * j];
        if (isctx && nsl > 0) {
            f32x4* xw = (f32x4*)(X + (size_t)row * DM) + lane;
#pragma unroll
            for (int hf = 0; hf < 2; ++hf) { f32x4 acc4[4];
#pragma unroll
                for (int j = 0; j < 4; ++j) acc4[j] = (f32x4){0.f, 0.f, 0.f, 0.f};
                for (int s = 0; s < nsl; ++s) { const f32x4* pr = (const f32x4*)(part + ((size_t)s * TC + row) * DM) + lane + 256 * hf; f32x4 t[4];
#pragma unroll
                    for (int j = 0; j < 4; ++j) t[j] = pr[64 * j];
#pragma unroll
                    for (int j = 0; j < 4; ++j) acc4[j] += t[j]; }
#pragma unroll
                for (int j = 0; j < 4; ++j) { v[4 * hf + j] += *(const f32x4*)(gate_ctx + 4 * lane + 256 * (4 * hf + j)) * acc4[j]; xw[64 * (4 * hf + j)] = v[4 * hf + j]; } } }
#pragma unroll
        for (int j = 0; j < 8; ++j) ss += (v[j].x * v[j].x + v[j].y * v[j].y) + (v[j].z * v[j].z + v[j].w * v[j].w);
        const float rs = 1.0f / sqrtf(wave_sum(ss) * (1.f / DM) + NEPS);
        v2u* o8 = (v2u*)(XN + (size_t)row * DM) + lane;
#pragma unroll
        for (int j = 0; j < 8; ++j) { const int k = 4 * lane + 256 * j; f32x4 a4, b4;
            if (isctx) { const f32x4 w4 = *(const f32x4*)(nw + k), s4 = *(const f32x4*)(mod_ctx + sc_off + k); a4 = w4 * (1.f + s4); b4 = *(const f32x4*)(mod_ctx + sh_off + k); }
            else { a4 = *(const LAS f32x4*)(AL + k); b4 = *(const LAS f32x4*)(BL + k); }
            v[j] = v[j] * rs * a4 + b4;
            v2u o; o.x = pk2(v[j].x, v[j].y); o.y = pk2(v[j].z, v[j].w); o8[64 * j] = o; }
        if (DTP) {
            float acc[16];
#pragma unroll
            for (int jj = 0; jj < 16; ++jj) acc[jj] = 0.f;
            const LAS float* W0 = WDT + 4 * lane; const LAS float* W1 = W0 + 8 * DM; asm volatile("" : "+v"(W1));
#pragma unroll
            for (int j = 0; j < 8; ++j)
#pragma unroll
                for (int jj = 0; jj < 16; ++jj) { const f32x4 w4 = *(const LAS f32x4*)((jj < 8 ? W0 : W1) + (jj & 7) * DM + 256 * j);
                    acc[jj] += (v[j].x * w4.x + v[j].y * w4.y) + (v[j].z * w4.z + v[j].w * w4.w); }
            float r8[8], r4[4], r2[2], r1;
#pragma unroll
            for (int i = 0; i < 8; ++i) { const bool up = (lane & 32) != 0; const float keep = up ? acc[i + 8] : acc[i], send = up ? acc[i] : acc[i + 8]; r8[i] = keep + shx(send, 32); }
#pragma unroll
            for (int i = 0; i < 4; ++i) { const bool up = (lane & 16) != 0; const float keep = up ? r8[i + 4] : r8[i], send = up ? r8[i] : r8[i + 4]; r4[i] = keep + shx(send, 16); }
#pragma unroll
            for (int i = 0; i < 2; ++i) { const bool up = (lane & 8) != 0; const float keep = up ? r4[i + 2] : r4[i], send = up ? r4[i] : r4[i + 2]; r2[i] = keep + shx(send, 8); }
            { const bool up = (lane & 4) != 0; const float keep = up ? r2[1] : r2[0], send = up ? r2[0] : r2[1]; r1 = keep + shx(send, 4); }
            r1 += shx(r1, 2); r1 += shx(r1, 1);
            const int col = ((lane >> 5) & 1) * 8 + ((lane >> 4) & 1) * 4 + ((lane >> 3) & 1) * 2 + ((lane >> 2) & 1);
            if ((lane & 3) == 0) DT[(size_t)row * 16 + col] = softplusf(r1 + dt_bias[col]);
        }
    }
    __syncthreads();
}

__device__ __forceinline__ void prep_rope_unit(const Fr& F, const PArgs& A, int L, int unit) {
    unsigned char* ws = A.wsp(); const int lane = F.lane;
    const bf16_t* P = (const bf16_t*)(ws + WS_P); bf16_t* QB = (bf16_t*)(ws + WS_QB); bf16_t* KB = (bf16_t*)(ws + WS_KB);
    const f32x2* RT = (const f32x2*)(ws + WS_ROPE);
    const float* qn = A.inp(12) + L * 128; const float* kn = A.inp(13) + L * 128;
    for (int i = 0; i < 8; ++i) {
        const int r = unit * 64 + F.wave * 8 + i; const bool lat = r >= TC; const int t = r - TC, prow = lat ? (t >> 6) : 0, pcol = lat ? (t & 63) : 0;
        const bf16_t* pr = P + (size_t)r * NP;
        {   const int hd = lane >> 3, o = (lane & 7) * 8, axis = o >> 5, p = o & 31, fi = p & 15; const bool first = p < 16; const int pos = axis ? pcol : prow;
            float xq[8], xk[8], yq[8], yk[8];
            unpack8(*(const v4u*)(pr + C_DAQ + 8 * lane), xq); unpack8(*(const v4u*)(pr + C_DAK + 8 * lane), xk);
#pragma unroll
            for (int e = 0; e < 8; ++e) { const float pq = shx(xq[e], 2), pk = shx(xk[e], 2);
                f32x2 cs = lat ? RT[pos * 48 + fi + e] : (f32x2){1.f, 0.f};
                const float sg = first ? -cs.y : cs.y;
                yq[e] = (xq[e] * cs.x + pq * sg) * 1.41421356237f; yk[e] = xk[e] * cs.x + pk * sg; }
            bf16_t* qd = QB + (size_t)r * QLD + hd * 128; const int m = hd & 1;
            *(v4u*)(qd + m * 64 + o) = pack8(yq); { unsigned zz = 0u; asm volatile("" : "+v"(zz)); *(v4u*)(qd + (1 - m) * 64 + o) = (v4u){zz, zz, zz, zz}; }
            *(v4u*)(KB + (size_t)r * KLD + 8 * lane) = pack8(yk);
        }
        {   const int o = (lane & 15) * 8, axis = o >> 6, p = o & 63, fi = p & 31; const bool first = p < 32; const int pos = axis ? pcol : prow;
            const int lk = lane & 31;
            float xq[8], xk[8], yq[8], yk[8];
            unpack8(*(const v4u*)(pr + C_GQ + 8 * lane), xq); unpack8(*(const v4u*)(pr + C_GK + 8 * lk), xk);
            float sq = 0.f, sk = 0.f;
#pragma unroll
            for (int e = 0; e < 8; ++e) { sq += xq[e] * xq[e]; sk += xk[e] * xk[e]; }
#pragma unroll
            for (int s = 1; s < 16; s <<= 1) { sq += shx(sq, s); sk += shx(sk, s); }
            const float rq = 1.0f / sqrtf(sq * (1.f / 128.f) + NEPS), rk = 1.0f / sqrtf(sk * (1.f / 128.f) + NEPS);
#pragma unroll
            for (int e = 0; e < 8; ++e) { xq[e] = xq[e] * rq * qn[o + e]; xk[e] = xk[e] * rk * kn[o + e]; }
#pragma unroll
            for (int e = 0; e < 8; ++e) { const float pq = shx(xq[e], 4), pk = shx(xk[e], 4);
                f32x2 cs = lat ? RT[pos * 48 + 16 + fi + e] : (f32x2){1.f, 0.f};
                const float sg = first ? -cs.y : cs.y;
                yq[e] = xq[e] * cs.x + pq * sg; yk[e] = xk[e] * cs.x + pk * sg; }
            *(v4u*)(QB + (size_t)r * QLD + 1024 + 8 * lane) = pack8(yq);
            if (lane < 32) *(v4u*)(KB + (size_t)r * KLD + 512 + 8 * lane) = pack8(yk);
        }
    }
}

__device__ __forceinline__ void prep_lru_unit(const Fr& F, const PArgs& A, int L, int unit) {
    unsigned char* ws = A.wsp(); const int lane = F.lane, tid = F.tid, c64 = unit >> 2, blk = unit & 3, r0 = c64 * 64;
    const int seg_lo = (r0 < TC) ? 0 : TC, seg_hi = (r0 < TC) ? TC : TA;
    const bf16_t* P = (const bf16_t*)(ws + WS_P);
    LAS float* XCv = (LAS float*)F.lds;
    LAS f32x2* AU = (LAS f32x2*)(F.lds + 64 * 132 * 4);
    const float* cw = A.inp(14) + (size_t)L * 4 * 512 + blk * 128; const float* cb = A.inp(15) + L * 512 + blk * 128;
    {
        const int tk = tid >> 3, c0 = (tid & 7) * 16, r = r0 + tk;
        float acc[16];
#pragma unroll
        for (int e = 0; e < 16; ++e) acc[e] = cb[c0 + e];
#pragma unroll
        for (int k = 0; k < 4; ++k) { const int rr = r + k - 2; if (rr >= seg_lo && rr < seg_hi) {
            const bf16_t* src = P + (size_t)rr * NP + C_LX + blk * 128 + c0; float x0[8], x1[8]; unpack8(*(const v4u*)src, x0); unpack8(*(const v4u*)(src + 8), x1);
#pragma unroll
            for (int e = 0; e < 8; ++e) { acc[e] += cw[k * 512 + c0 + e] * x0[e]; acc[8 + e] += cw[k * 512 + c0 + 8 + e] * x1[e]; } } }
#pragma unroll
        for (int e = 0; e < 16; e += 4) *(LAS f32x4*)(XCv + tk * 132 + c0 + e) = (f32x4){acc[e], acc[e + 1], acc[e + 2], acc[e + 3]};
    }
    __syncthreads();
    const int w = F.wave, fr = lane & 15, fq = lane >> 4;
    bf16x8 af[4][4];
#pragma unroll
    for (int m = 0; m < 4; ++m)
#pragma unroll
        for (int ks = 0; ks < 4; ++ks) { const LAS float* s = XCv + (16 * m + fr) * 132 + 32 * ks + 8 * fq; const f32x4 a = *(const LAS f32x4*)s, b = *(const LAS f32x4*)(s + 4);
            v4u wv; wv.x = pk2(a.x, a.y); wv.y = pk2(a.z, a.w); wv.z = pk2(b.x, b.y); wv.w = pk2(b.z, b.w); af[m][ks] = __builtin_bit_cast(bf16x8, wv); }
    const bf16_t* WG = (const bf16_t*)(ws + WS_WG) + (size_t)L * 16 * 16384;
    const int ch = 16 * w + fr, chg = blk * 128 + ch;
    for (int dir = 0; dir < 2; ++dir) {
        const bf16_t* Wr = WG + (size_t)((dir * 2 + 0) * 4 + blk) * 16384 + (size_t)ch * 128 + 8 * fq;
        const bf16_t* Wi = WG + (size_t)((dir * 2 + 1) * 4 + blk) * 16384 + (size_t)ch * 128 + 8 * fq;
        f32x4 ar[4], ai[4];
#pragma unroll
        for (int m = 0; m < 4; ++m) { ar[m] = (f32x4){0.f, 0.f, 0.f, 0.f}; ai[m] = (f32x4){0.f, 0.f, 0.f, 0.f}; }
#pragma unroll
        for (int ks = 0; ks < 4; ++ks) { const bf16x8 br = *(const bf16x8*)(Wr + 32 * ks), bi = *(const bf16x8*)(Wi + 32 * ks);
#pragma unroll
            for (int m = 0; m < 4; ++m) { ar[m] = MFMA16(af[m][ks], br, ar[m]); ai[m] = MFMA16(af[m][ks], bi, ai[m]); } }
        const float bgr = A.inp(17)[((size_t)(L * 2 + dir) * 2 + 0) * 512 + chg], bgi = A.inp(17)[((size_t)(L * 2 + dir) * 2 + 1) * 512 + chg];
        const float lam = A.inp(18)[(size_t)(L * 2 + dir) * 512 + chg];
        const float lsg = fminf(lam, 0.f) - log1pf(__expf(-fabsf(lam)));
#pragma unroll
        for (int m = 0; m < 4; ++m)
#pragma unroll
            for (int rg = 0; rg < 4; ++rg) { const int tok = 16 * m + 4 * fq + rg;
                const float rr = sigmf(ar[m][rg] + bgr), ii = sigmf(ai[m][rg] + bgi);
                const float log_a = 8.0f * rr * lsg, a = __expf(log_a), beta = sqrtf(fmaxf(-expm1f(2.f * log_a), 0.f));
                AU[tok * 128 + ch] = (f32x2){a, beta * (ii * XCv[tok * 132 + ch])}; }
        __syncthreads();
        if (tid < 128) {
            float* Hb = (float*)(ws + (dir ? WS_HB : WS_HF)); float* Pb = (float*)(ws + (dir ? WS_PB : WS_PF));
            float h = 0.f, pr = 1.f;
            for (int s = 0; s < 64; ++s) { const int tok = dir ? 63 - s : s; const f32x2 au = AU[tok * 128 + tid];
                h = au.x * h + au.y; pr *= au.x;
                const size_t o = (size_t)(r0 + tok) * 512 + blk * 128 + tid; Hb[o] = h; Pb[o] = pr; }
            float* LS = (float*)(ws + WS_LSUM) + ((size_t)(dir * 132 + c64) * 2) * 512 + blk * 128 + tid;
            LS[0] = pr; LS[512] = h;
        }
        __syncthreads();
    }
}

constexpr int SLD = 136, XLD = 72;
typedef short v4i16_t __attribute__((ext_vector_type(4)));
__device__ __forceinline__ bf16x8 lds_tr_frag(const LAS bf16_t* img, int ld, int r0, int c0, int fr, int fq) {
    const LAS bf16_t* p = img + (r0 + 8 * fq + (fr >> 2)) * ld + c0 + 4 * (fr & 3);
    const v4i16_t lo = __builtin_amdgcn_ds_read_tr16_b64_v4i16((LAS v4i16_t*)p), hi = __builtin_amdgcn_ds_read_tr16_b64_v4i16((LAS v4i16_t*)(p + 4 * ld));
    return (bf16x8){lo[0], lo[1], lo[2], lo[3], hi[0], hi[1], hi[2], hi[3]};
}
__device__ __forceinline__ void prep_ssd_unit(const Fr& F, const PArgs& A, int L, int unit) {
    unsigned char* ws = A.wsp(); const int lane = F.lane, tid = F.tid, c = unit >> 3, h = unit & 7, g = h >> 2, r0 = c * 128;
    const int seg_lo = (r0 < TC) ? 0 : TC, seg_hi = (r0 < TC) ? TC : TA;
    const bf16_t* P = (const bf16_t*)(ws + WS_P);
    LAS bf16_t* CG = (LAS bf16_t*)F.lds;
    LAS bf16_t* BG = CG + 128 * SLD;
    LAS bf16_t* XS = BG + 128 * SLD;
    LAS float* VEC = (LAS float*)(XS + 128 * XLD);
    LAS float* AFv = VEC, *ABv = VEC + 128, *DTF = VEC + 256, *DTB = VEC + 384, *WFv = VEC + 512, *WBv = VEC + 640;
    if (F.wave == 0) {
        const float* DT = (const float*)(ws + WS_DT);
        const float a_f = -__expf(A.inp(22)[(L * 2 + 0) * 8 + h]), a_b = -__expf(A.inp(22)[(L * 2 + 1) * 8 + h]);
        const int t0 = 2 * lane;
        const float df0 = DT[(size_t)(r0 + t0) * 16 + h], df1 = DT[(size_t)(r0 + t0 + 1) * 16 + h], db0 = DT[(size_t)(r0 + t0) * 16 + 8 + h], db1 = DT[(size_t)(r0 + t0 + 1) * 16 + 8 + h];
        const float xf0 = df0 * a_f, xf1 = df1 * a_f, xb0 = db0 * a_b, xb1 = db1 * a_b;
        float sf = xf0 + xf1, sb = xb0 + xb1;
#pragma unroll
        for (int o = 1; o < 64; o <<= 1) { const float uf = shup(sf, o), ub = shdn(sb, o); if (lane >= o) sf += uf; if (lane + o < 64) sb += ub; }
        const float af1 = sf, af0 = sf - xf1;
        const float ab0 = sb, ab1 = sb - xb0;
        const float aft = shidx(sf, 63), abt = shidx(sb, 0);
        AFv[t0] = af0; AFv[t0 + 1] = af1; ABv[t0] = ab0; ABv[t0 + 1] = ab1; DTF[t0] = df0; DTF[t0 + 1] = df1; DTB[t0] = db0; DTB[t0 + 1] = db1;
        WFv[t0] = __expf(aft - af0) * df0; WFv[t0 + 1] = __expf(aft - af1) * df1; WBv[t0] = __expf(abt - ab0) * db0; WBv[t0 + 1] = __expf(abt - ab1) * db1;
        float* AC = (float*)(ws + WS_ACUM);
        AC[(size_t)(r0 + t0) * 16 + h] = af0; AC[(size_t)(r0 + t0 + 1) * 16 + h] = af1; AC[(size_t)(r0 + t0) * 16 + 8 + h] = ab0; AC[(size_t)(r0 + t0 + 1) * 16 + 8 + h] = ab1;
        if (lane == 0) { float* CH = (float*)(ws + WS_CHA); CH[(c * 2 + 0) * 8 + h] = aft; CH[(c * 2 + 1) * 8 + h] = abt; }
    }
    const float* cw = A.inp(19) + (size_t)L * 4 * 1024; const float* cb = A.inp(20) + (size_t)L * 1024;
    bf16_t* XCg = (bf16_t*)(ws + WS_XC);
    for (int id = tid; id < 640; id += 512) {
        const int cgp = id % 40, t0 = (id / 40) * 8;
        int ccol, off, ld; LAS bf16_t* img;
        if (cgp < 8) { off = cgp * 8; ccol = 64 * h + off; img = XS; ld = XLD; } else if (cgp < 24) { off = (cgp - 8) * 8; ccol = 512 + 128 * g + off; img = BG; ld = SLD; } else { off = (cgp - 24) * 8; ccol = 768 + 128 * g + off; img = CG; ld = SLD; }
        const bool cglob = (cgp >= 24) && ((h & 3) == 0);
        float wk[4][8], bb[8];
#pragma unroll
        for (int e = 0; e < 8; ++e) { bb[e] = cb[ccol + e];
#pragma unroll
            for (int k = 0; k < 4; ++k) wk[k][e] = cw[k * 1024 + ccol + e]; }
        const bf16_t* src = P + (size_t)(r0 + t0) * NP + C_SX + ccol;
        float wn[4][8];
#pragma unroll
        for (int j = 0; j < 3; ++j) { const int rr = r0 + t0 + j - 2;
            if (rr >= seg_lo && rr < seg_hi) unpack8(*(const v4u*)(src + (ptrdiff_t)(j - 2) * NP), wn[j]);
            else {
#pragma unroll
                for (int e = 0; e < 8; ++e) wn[j][e] = 0.f; } }
#pragma unroll
        for (int t = 0; t < 8; ++t) { const int rr = r0 + t0 + t + 1;
            if (rr < seg_hi) unpack8(*(const v4u*)(src + (ptrdiff_t)(t + 1) * NP), wn[3]);
            else {
#pragma unroll
                for (int e = 0; e < 8; ++e) wn[3][e] = 0.f; }
            float o8[8];
#pragma unroll
            for (int e = 0; e < 8; ++e) { const float sv = bb[e] + wk[0][e] * wn[0][e] + wk[1][e] * wn[1][e] + wk[2][e] * wn[2][e] + wk[3][e] * wn[3][e];
                o8[e] = siluf(sv); wn[0][e] = wn[1][e]; wn[1][e] = wn[2][e]; wn[2][e] = wn[3][e]; }
            const v4u pv = pack8(o8);
            *(LAS v4u*)(img + (t0 + t) * ld + off) = pv;
            if (cglob) *(v4u*)(XCg + (size_t)(r0 + t0 + t) * 256 + 128 * g + off) = pv; }
    }
    __syncthreads();
    const int w = F.wave, fr = lane & 15, fq = lane >> 4;
    {
        bf16x8 ca[4];
#pragma unroll
        for (int ks = 0; ks < 4; ++ks) ca[ks] = *(const LAS bf16x8*)(CG + (16 * w + fr) * SLD + 32 * ks + 8 * fq);
        float afl[4], abl[4];
#pragma unroll
        for (int rg = 0; rg < 4; ++rg) { afl[rg] = AFv[16 * w + 4 * fq + rg]; abl[rg] = ABv[16 * w + 4 * fq + rg]; }
#pragma unroll 2
        for (int st = 0; st < 8; ++st) { f32x4 gacc = {0.f, 0.f, 0.f, 0.f};
#pragma unroll
            for (int ks = 0; ks < 4; ++ks) { const bf16x8 bfr = *(const LAS bf16x8*)(BG + (16 * st + fr) * SLD + 32 * ks + 8 * fq); gacc = MFMA16(ca[ks], bfr, gacc); }
            const int s = 16 * st + fr; const float afs = AFv[s], abs_ = ABv[s], dfs = DTF[s], dbs = DTB[s];
#pragma unroll
            for (int rg = 0; rg < 4; ++rg) { const int l = 16 * w + 4 * fq + rg; float f;
                if (s < l) f = __expf(afl[rg] - afs) * dfs; else if (s > l) f = __expf(abl[rg] - abs_) * dbs; else f = dfs + dbs;
                CG[l * SLD + s] = (bf16_t)f2bf(gacc[rg] * f); } }
    }
    __syncthreads();
    {
        bf16x8 ma[4];
#pragma unroll
        for (int ks = 0; ks < 4; ++ks) ma[ks] = *(const LAS bf16x8*)(CG + (16 * w + fr) * SLD + 32 * ks + 8 * fq);
        const float Dh = A.inp(23)[L * 8 + h]; float* YD = (float*)(ws + WS_YD);
#pragma unroll
        for (int pt = 0; pt < 4; ++pt) { f32x4 acc = {0.f, 0.f, 0.f, 0.f};
#pragma unroll
            for (int ks = 0; ks < 4; ++ks) { const bf16x8 xb = lds_tr_frag(XS, XLD, 32 * ks, 16 * pt, fr, fq); acc = MFMA16(ma[ks], xb, acc); }
#pragma unroll
            for (int rg = 0; rg < 4; ++rg) { const int l = 16 * w + 4 * fq + rg, p = 16 * pt + fr;
                YD[(size_t)(r0 + l) * 512 + 64 * h + p] = acc[rg] + Dh * bf1(XS[l * XLD + p]); } }
    }
    {
        const int d = w >> 2, ptile = w & 3; const LAS float* Wv = d ? WBv : WFv;
        bf16x8 xa[4];
#pragma unroll
        for (int ks = 0; ks < 4; ++ks) { float x8[8]; unpack8(__builtin_bit_cast(v4u, lds_tr_frag(XS, XLD, 32 * ks, 16 * ptile, fr, fq)), x8);
            const f32x4 w0 = *(const LAS f32x4*)(Wv + 32 * ks + 8 * fq), w1 = *(const LAS f32x4*)(Wv + 32 * ks + 8 * fq + 4);
            x8[0] *= w0.x; x8[1] *= w0.y; x8[2] *= w0.z; x8[3] *= w0.w; x8[4] *= w1.x; x8[5] *= w1.y; x8[6] *= w1.z; x8[7] *= w1.w;
            xa[ks] = __builtin_bit_cast(bf16x8, pack8(x8)); }
        float* ST = (float*)(ws + WS_ST) + ((size_t)((c * 2 + d) * 8 + h)) * 8192;
#pragma unroll 2
        for (int nt = 0; nt < 8; ++nt) { f32x4 acc = {0.f, 0.f, 0.f, 0.f};
#pragma unroll
            for (int ks = 0; ks < 4; ++ks) { const bf16x8 bb2 = lds_tr_frag(BG, SLD, 32 * ks, 16 * nt, fr, fq); acc = MFMA16(xa[ks], bb2, acc); }
#pragma unroll
            for (int rg = 0; rg < 4; ++rg) ST[(16 * ptile + 4 * fq + rg) * 128 + 16 * nt + fr] = acc[rg]; }
    }
    __syncthreads();
}

__device__ __forceinline__ void ph_prep(const Fr& F0, const PArgs& A, int L) {
    const Fr F = fr_refresh(F0);
    constexpr int N_SSD = 66 * 8, N_LRU = 132 * 4, N_ROPE = TA / 64;
    for (int u = F.vcu; u < N_SSD + N_LRU + N_ROPE; u += F.G) {
        if (u < N_SSD) { if (SUBM & 1) prep_ssd_unit(F, A, L, u); }
        else if (u < N_SSD + N_LRU) { if (SUBM & 2) prep_lru_unit(F, A, L, u - N_SSD); }
        else { if (SUBM & 4) prep_rope_unit(F, A, L, u - N_SSD - N_LRU); }
    }
}

__device__ __forceinline__ void ph_state_scan(const Fr& F0, const PArgs& A) {
    const Fr F = fr_refresh(F0);
    unsigned char* ws = A.wsp(); const float* ST = (const float*)(ws + WS_ST); bf16_t* SIN = (bf16_t*)(ws + WS_SIN); unsigned* CH = (unsigned*)(ws + WS_CHA);
    for (int e = F.bid * 512 + F.tid; e < 2 * 65536; e += F.G * 512) {
        const int d = e >> 16, rest = e & 65535, h = rest >> 13;
        float run = 0.f;
#pragma unroll 6
        for (int i = 0; i < 66; ++i) { const int c = d ? (i == 0 ? 1 : (i == 1 ? 0 : 67 - i)) : i; const size_t o = ((size_t)(c * 2 + d) << 16) + rest;
            SIN[o] = (bf16_t)f2bf(run);
            const float dec = __expf(__uint_as_float(__hip_atomic_load(CH + (c * 2 + d) * 8 + h, RLX_AGENT)));
            run = dec * run + ST[o]; }
    }
}
__device__ __forceinline__ void ph_attn(const Fr& F0, const PArgs& A, int L) {
    const Fr F = fr_refresh(F0);
    unsigned char* ws = A.wsp();
    const att::bf16* QB = (const att::bf16*)(ws + WS_QB); const att::bf16* KB = (const att::bf16*)(ws + WS_KB); const att::bf16* P = (const att::bf16*)(ws + WS_P);
    const int nunits = 768 + (L < DEPTH - 1 ? 12 : 0);
    for (int u = F.vcu; u < nunits; u += F.G) {
        int vh, row0, seq, kh, k0;
        if (u < 768) { const int v = (u < 512) ? u : u - 512; vh = ((u < 512) ? 0 : 8) + (v >> 6); row0 = TC + 256 * ((v & 63) >> 1); kh = v & 1; seq = TA / 2; k0 = kh * (TA / 2); }
        else { vh = u - 768; row0 = 0; seq = TC; kh = 0; k0 = 0; }
        const int kvh = vh >> 1;
        const att::bf16* Vh = P + (size_t)k0 * NP + (kvh < 4 ? C_DAV + 128 * kvh : C_GV + 128 * (kvh - 4));
        const att::bf16* Kh = KB + (size_t)k0 * KLD + kvh * 128;
        float* Ob = (float*)(ws + (kh ? WS_OP1 : WS_O)) + (size_t)row0 * QLD + vh * 128;
        float* ML = (float*)(ws + WS_ML) + ((size_t)(kh * TA + row0) * 12 + vh) * 2;
        if (vh < 8) { const int m = vh & 1; att::attn_dense_body<att::bf16, 4, true>(QB + (size_t)row0 * QLD + vh * 128 + 64 * m, Kh, Vh, Ob, seq, F.ldsg, 128 * m, ML); }
        else att::attn_dense_body<att::bf16, 8, true>(QB + (size_t)row0 * QLD + vh * 128, Kh, Vh, Ob, seq, F.ldsg, 0, ML);
        __syncthreads();
    }
}

__device__ __forceinline__ void attn_combine8(const float* O0, const float* O1, const float* ML0, const float* ML1, size_t r, int vh, int c0, bool split, float (&o8)[8]) {
    const f32x4 a0 = *(const f32x4*)(O0 + r * QLD + vh * 128 + c0), a1 = *(const f32x4*)(O0 + r * QLD + vh * 128 + c0 + 4);
    const f32x2 mla = *(const f32x2*)(ML0 + (r * 12 + vh) * 2);
    if (split) {
        const f32x4 b0 = *(const f32x4*)(O1 + r * QLD + vh * 128 + c0), b1 = *(const f32x4*)(O1 + r * QLD + vh * 128 + c0 + 4);
        const f32x2 mlb = *(const f32x2*)(ML1 + (r * 12 + vh) * 2);
        const float m = fmaxf(mla.x, mlb.x), wa = __builtin_amdgcn_exp2f(mla.x - m), wb = __builtin_amdgcn_exp2f(mlb.x - m), inv = 1.0f / (mla.y * wa + mlb.y * wb), ka = wa * inv, kb = wb * inv;
        o8[0] = a0.x * ka + b0.x * kb; o8[1] = a0.y * ka + b0.y * kb; o8[2] = a0.z * ka + b0.z * kb; o8[3] = a0.w * ka + b0.w * kb;
        o8[4] = a1.x * ka + b1.x * kb; o8[5] = a1.y * ka + b1.y * kb; o8[6] = a1.z * ka + b1.z * kb; o8[7] = a1.w * ka + b1.w * kb;
    } else { const float inv = 1.0f / mla.y;
        o8[0] = a0.x * inv; o8[1] = a0.y * inv; o8[2] = a0.z * inv; o8[3] = a0.w * inv; o8[4] = a1.x * inv; o8[5] = a1.y * inv; o8[6] = a1.z * inv; o8[7] = a1.w * inv; }
}
__device__ __forceinline__ void fin_attn_unit(const Fr& F, const PArgs& A, int L, int unit, float lam, float lam_init) {
    unsigned char* ws = A.wsp(); const int lane = F.lane; bf16_t* Y = (bf16_t*)(ws + WS_YCAT);
    const float* O0 = (const float*)(ws + WS_O); const float* O1 = (const float*)(ws + WS_OP1); const float* ML0 = (const float*)(ws + WS_ML); const float* ML1 = ML0 + (size_t)TA * 24;
    const float* sub = A.inp(11) + L * 128;
    const bool split = unit >= TC / 64;
#pragma unroll 2
    for (int i = 0; i < 8; ++i) {
        const size_t r = (size_t)unit * 64 + F.wave * 8 + i;
        {   const int hh = lane >> 4, d0 = (lane & 15) * 8;
            float x1[8], x2[8], o8[8];
            attn_combine8(O0, O1, ML0, ML1, r, 2 * hh, d0, split, x1); attn_combine8(O0, O1, ML0, ML1, r, 2 * hh + 1, d0, split, x2);
            float ss = 0.f;
#pragma unroll
            for (int e = 0; e < 8; ++e) { o8[e] = x1[e] - lam * x2[e]; ss += o8[e] * o8[e]; }
#pragma unroll
            for (int s = 1; s < 16; s <<= 1) ss += shx(ss, s);
            const float rs = (1.0f / sqrtf(ss * (1.f / 128.f) + NEPS)) * (1.f - lam_init);
#pragma unroll
            for (int e = 0; e < 8; ++e) o8[e] = o8[e] * rs * sub[d0 + e];
            *(v4u*)(Y + r * DM + 128 * hh + d0) = pack8(o8); }
        {   float o8[8]; attn_combine8(O0, O1, ML0, ML1, r, 8 + (lane >> 4), (lane & 15) * 8, split, o8);
            *(v4u*)(Y + r * DM + 512 + 8 * lane) = pack8(o8); }
    }
}
__device__ __forceinline__ void fin_lru_unit(const Fr& F, const PArgs& A, int c64) {
    unsigned char* ws = A.wsp(); const int ch = F.tid;
    const float* LS = (const float*)(ws + WS_LSUM);
    float cf = 0.f, cbk = 0.f;
    for (int j0 = 0; j0 < c64; j0 += 8) { float a[8], hh[8];
#pragma unroll
        for (int k = 0; k < 8; ++k) { const int j = min(j0 + k, c64 - 1); a[k] = LS[((size_t)(0 * 132 + j) * 2) * 512 + ch]; hh[k] = LS[((size_t)(0 * 132 + j) * 2 + 1) * 512 + ch]; }
#pragma unroll
        for (int k = 0; k < 8; ++k) { const bool ok = j0 + k < c64; cf = ok ? a[k] * cf + hh[k] : cf; } }
    const int pos = (c64 < 4) ? 3 - c64 : 135 - c64;
    for (int i0 = 0; i0 < pos; i0 += 8) { float a[8], hh[8];
#pragma unroll
        for (int k = 0; k < 8; ++k) { const int i = min(i0 + k, pos - 1), j = (i < 4) ? 3 - i : 135 - i; a[k] = LS[((size_t)(1 * 132 + j) * 2) * 512 + ch]; hh[k] = LS[((size_t)(1 * 132 + j) * 2 + 1) * 512 + ch]; }
#pragma unroll
        for (int k = 0; k < 8; ++k) { const bool ok = i0 + k < pos; cbk = ok ? a[k] * cbk + hh[k] : cbk; } }
    const float* HF = (const float*)(ws + WS_HF); const float* PF = (const float*)(ws + WS_PF); const float* HB = (const float*)(ws + WS_HB); const float* PB = (const float*)(ws + WS_PB);
    const bf16_t* P = (const bf16_t*)(ws + WS_P); bf16_t* Y = (bf16_t*)(ws + WS_YCAT);
#pragma unroll 8
    for (int t = 0; t < 64; ++t) { const size_t r = (size_t)c64 * 64 + t, o = r * 512 + ch;
        const float hf = HF[o] + PF[o] * cf, hb = HB[o] + PB[o] * cbk, gg = bf1(P[r * NP + C_LG + ch]);
        Y[r * DM + 1024 + ch] = (bf16_t)f2bf((hf + hb) * gelu_tanh(gg)); }
}
constexpr int CLD = 264;
__device__ __forceinline__ void fin_ssd_unit(const Fr& F, const PArgs& A, int L, int c) {
    unsigned char* ws = A.wsp(); const int lane = F.lane, tid = F.tid, w = F.wave, fr = lane & 15, fq = lane >> 4, r0 = c * 128;
    LAS bf16_t* CI = (LAS bf16_t*)F.lds;
    LAS float* EF = (LAS float*)(CI + 128 * CLD);
    const bf16_t* XCg = (const bf16_t*)(ws + WS_XC); const float* AC = (const float*)(ws + WS_ACUM);
    for (int id = tid; id < 128 * 32; id += 512) { const int t = id >> 5, q = id & 31; *(LAS v4u*)(CI + t * CLD + 8 * q) = *(const v4u*)(XCg + (size_t)(r0 + t) * 256 + 8 * q); }
    for (int id = tid; id < 128 * 16; id += 512) { const int t = id >> 4, j = id & 15; EF[j * 128 + t] = __expf(AC[(size_t)(r0 + t) * 16 + j]); }
    __syncthreads();
    const bf16_t* SIN = (const bf16_t*)(ws + WS_SIN); const float* YD = (const float*)(ws + WS_YD); float* YDw = (float*)(ws + (FIN_INPLACE ? WS_YD : WS_YD2)); const bf16_t* P = (const bf16_t*)(ws + WS_P);
    float ss[4] = {0.f, 0.f, 0.f, 0.f};
    for (int h = 0; h < 8; ++h) { const int g = h >> 2;
        bf16x8 ca[4];
#pragma unroll
        for (int ks = 0; ks < 4; ++ks) ca[ks] = *(const LAS bf16x8*)(CI + (16 * w + fr) * CLD + 128 * g + 32 * ks + 8 * fq);
        const bf16_t* S0 = SIN + ((size_t)((c * 2 + 0) * 8 + h)) * 8192; const bf16_t* S1 = SIN + ((size_t)((c * 2 + 1) * 8 + h)) * 8192;
        float ef[4], eb[4];
#pragma unroll
        for (int rg = 0; rg < 4; ++rg) { ef[rg] = EF[h * 128 + 16 * w + 4 * fq + rg]; eb[rg] = EF[(8 + h) * 128 + 16 * w + 4 * fq + rg]; }
#pragma unroll 2
        for (int pt = 0; pt < 4; ++pt) { f32x4 a0 = {0.f, 0.f, 0.f, 0.f}, a1 = {0.f, 0.f, 0.f, 0.f};
#pragma unroll
            for (int ks = 0; ks < 4; ++ks) { const bf16x8 b0 = *(const bf16x8*)(S0 + (16 * pt + fr) * 128 + 32 * ks + 8 * fq), b1 = *(const bf16x8*)(S1 + (16 * pt + fr) * 128 + 32 * ks + 8 * fq);
                a0 = MFMA16(ca[ks], b0, a0); a1 = MFMA16(ca[ks], b1, a1); }
#pragma unroll
            for (int rg = 0; rg < 4; ++rg) { const int l = 16 * w + 4 * fq + rg, col = 64 * h + 16 * pt + fr; const size_t r = (size_t)(r0 + l);
                float y = YD[r * 512 + col] + ef[rg] * a0[rg] + eb[rg] * a1[rg];
                y *= siluf(bf1(P[r * NP + C_SZ + col])); YDw[r * 512 + col] = y; ss[rg] += y * y; } }
    }
    const float* nw = A.inp(24) + L * 512; bf16_t* Y = (bf16_t*)(ws + WS_YCAT);
#pragma unroll
    for (int rg = 0; rg < 4; ++rg) {
#pragma unroll
        for (int s = 1; s < 16; s <<= 1) ss[rg] += shx(ss[rg], s);
        ss[rg] = 1.0f / sqrtf(ss[rg] * (1.f / 512.f) + NEPS); }
#pragma unroll 4
    for (int ct = 0; ct < 32; ++ct) { const int col = 16 * ct + fr; const float wv = nw[col];
#pragma unroll
        for (int rg = 0; rg < 4; ++rg) { const size_t r = (size_t)(r0 + 16 * w + 4 * fq + rg); Y[r * DM + 1536 + col] = (bf16_t)f2bf(YDw[r * 512 + col] * ss[rg] * wv); } }
    __syncthreads();
}
__device__ __forceinline__ void ph_finish(const Fr& F0, const PArgs& A, int L) {
    const Fr F = fr_refresh(F0);
    const float lam_init = 0.8f - 0.6f * expf(-0.3f * (float)L);
    const float* lv = A.inp(10) + L * 256;
    const float s1 = wave_sum(lv[F.lane] * lv[64 + F.lane]), s2 = wave_sum(lv[128 + F.lane] * lv[192 + F.lane]);
    const float lam = expf(s1) - expf(s2) + lam_init;
    const bool need_ctx = L < DEPTH - 1;
    constexpr int N_SSD = 66, N_LRU = 132, N_ATT = TA / 64;
    for (int u = F.vcu; u < N_SSD + N_LRU + N_ATT; u += F.G) {
        if (u < N_SSD) { if ((SUBM & 1) && (need_ctx || u >= 2)) fin_ssd_unit(F, A, L, u); }
        else if (u < N_SSD + N_LRU) { const int c64 = u - N_SSD; if ((SUBM & 2) && (need_ctx || c64 >= 4)) fin_lru_unit(F, A, c64); }
        else { const int un = u - N_SSD - N_LRU; if ((SUBM & 4) && (need_ctx || un >= 4)) fin_attn_unit(F, A, L, un, lam, lam_init); }
    }
}

__device__ __forceinline__ void ph_act(const Fr& F0, const PArgs& A, int L, int row_lo) {
    const Fr F = fr_refresh(F0);
    unsigned char* ws = A.wsp(); const bf16_t* GU = (const bf16_t*)(ws + WS_GU); bf16_t* H = (bf16_t*)(ws + WS_H);
    const float* cw = A.inp(26) + (size_t)L * 3 * DFF; const float* cb = A.inp(27) + (size_t)L * DFF;
    constexpr int NCG = DFF / 8;
    const int ntb = (TA - row_lo) / 8;
    for (int it = F.bid * 512 + F.tid; it < ntb * NCG; it += F.G * 512) {
        const int tb = it / NCG, cg = it % NCG, r0 = row_lo + tb * 8, c0 = cg * 8;
        const int seg_lo = (r0 < TC) ? 0 : TC, seg_hi = (r0 < TC) ? TC : TA;
        float w0[8], w1[8], w2[8], bb[8];
#pragma unroll
        for (int e = 0; e < 8; ++e) { w0[e] = cw[c0 + e]; w1[e] = cw[DFF + c0 + e]; w2[e] = cw[2 * DFF + c0 + e]; bb[e] = cb[c0 + e]; }
        float prev[8], cur[8], nxt[8];
        if (r0 - 1 >= seg_lo) unpack8(*(const v4u*)(GU + (size_t)(r0 - 1) * (2 * DFF) + c0), prev); else {
#pragma unroll
            for (int e = 0; e < 8; ++e) prev[e] = 0.f; }
        unpack8(*(const v4u*)(GU + (size_t)r0 * (2 * DFF) + c0), cur);
#pragma unroll
        for (int t = 0; t < 8; ++t) { const int r = r0 + t;
            if (r + 1 < seg_hi) unpack8(*(const v4u*)(GU + (size_t)(r + 1) * (2 * DFF) + c0), nxt); else {
#pragma unroll
                for (int e = 0; e < 8; ++e) nxt[e] = 0.f; }
            float up[8], o8[8]; unpack8(*(const v4u*)(GU + (size_t)r * (2 * DFF) + DFF + c0), up);
#pragma unroll
            for (int e = 0; e < 8; ++e) { const float gt = bb[e] + w0[e] * prev[e] + w1[e] * cur[e] + w2[e] * nxt[e]; o8[e] = siluf(gt) * up[e]; }
            *(v4u*)(H + (size_t)r * DFF + c0) = pack8(o8);
#pragma unroll
            for (int e = 0; e < 8; ++e) { prev[e] = cur[e]; cur[e] = nxt[e]; } }
    }
}

__device__ __forceinline__ void ph_final(const Fr& F0, const PArgs& A) {
    const Fr F = fr_refresh(F0);
    const float* X = (const float*)(A.wsp() + WS_X) + (size_t)TC * DM; const float* nw = A.inp(29);
    const int gw = F.bid * NWAVES + F.wave, NGW = F.G * NWAVES, lane = F.lane;
    for (int row = gw; row < TL; row += NGW) {
        const f32x4* xr = (const f32x4*)(X + (size_t)row * DM) + lane; f32x4* orow = (f32x4*)(A.outp() + (size_t)row * DM) + lane;
        f32x4 v[8]; float ss = 0.f;
#pragma unroll
        for (int j = 0; j < 8; ++j) { v[j] = xr[64 * j]; ss += (v[j].x * v[j].x + v[j].y * v[j].y) + (v[j].z * v[j].z + v[j].w * v[j].w); }
        const float rs = 1.0f / sqrtf(wave_sum(ss) * (1.f / DM) + NEPS);
#pragma unroll
        for (int j = 0; j < 8; ++j) { const f32x4 w4 = *(const f32x4*)(nw + 4 * lane + 256 * j); orow[64 * j] = v[j] * rs * w4; }
    }
}

constexpr int N_STEPS = 2 + 10 * DEPTH + 1;
#ifndef PH_MASK
#define PH_MASK 0xFFFF
#endif
#define PHE(b) ((PH_MASK >> (b)) & 1)
#ifndef DBL_MASK
#define DBL_MASK 0
#endif
#define NREP(b) (((DBL_MASK >> (b)) & 1) ? 2 : 1)
#ifndef SPLIT_OUT
#define SPLIT_OUT 8
#define SPLIT_DN 11
#endif
#ifndef MK_ONE_LAUNCH
#define MK_ONE_LAUNCH 1
#endif
__global__ void __launch_bounds__(NWAVES * 64, 2) mk_fwd(Args args) {
    extern __shared__ __attribute__((aligned(16))) unsigned char lds[];
    Fr F;
    F.lds = (LAS unsigned char*)lds; F.ldsg = (char*)lds;
    F.tid = 0; F.lane = 0; F.wave = 0;
    F.G = gridDim.x; F.bid = blockIdx.x; F.vcu = (F.G % 8 == 0) ? (F.bid % 8) * (F.G / 8) + F.bid / 8 : F.bid;
    volatile LAS unsigned* MISC = (volatile LAS unsigned*)(F.lds + MISC_OFF);
    for (int u = threadIdx.x; u < (LDS_BYTES - MISC_OFF) / 4; u += NWAVES * 64) ((LAS unsigned*)(F.lds + MISC_OFF))[u] = 0u;
    __syncthreads();
    if (threadIdx.x == 0) { LAS unsigned long long* tb = (LAS unsigned long long*)(F.lds + TBL_OFF);
#pragma unroll
        for (int i = 0; i < 30; ++i) tb[i] = (unsigned long long)args.in[i];
        tb[30] = (unsigned long long)args.out; tb[31] = (unsigned long long)args.ws; }
    if ((threadIdx.x & 63) == 0) { const unsigned h = (unsigned)__builtin_amdgcn_s_getreg((5 << 11) | 4) & 63u; ((LAS int*)(F.lds + WMAP_OFF))[h] = (int)(threadIdx.x >> 6); }
    __syncthreads();
    PArgs PA; PA.tbl = (LAS unsigned long long*)(F.lds + TBL_OFF);
    unsigned char* ws = args.ws;
    const int lo = args.s_lo, hi = args.s_hi;
    if (hi - lo > 1) (void)xcd_barrier_post((unsigned*)(ws + WS_CTL) + CW_BAR, MISC + 8);
#define IN(k) (lo <= (k) && (k) < hi)
#define SEAM(k) do { if (IN(k) && IN((k) + 1)) { XcdBarrier b2; b2.bar = (unsigned*)(PA.wsp() + WS_CTL) + CW_BAR; b2.x = xb_xcc_id(); b2.st = MISC + 8; xcd_barrier(b2); } } while (0)

    if (PHE(0) && IN(0)) for (int rep = 0; rep < NREP(0); ++rep) { ph_prologue(F, PA); } SEAM(0);
    if (PHE(1) && IN(1)) { ph_modf(F, PA); } SEAM(1);

    for (int L = 0; L < DEPTH; ++L) {
        const int s0 = 2 + 10 * L;
        { int z = 0; asm volatile("" : "+s"(z)); F.lds = (LAS unsigned char*)lds + z; F.ldsg = (char*)lds + z; PA.tbl = (LAS unsigned long long*)(F.lds + TBL_OFF); MISC = (volatile LAS unsigned*)(F.lds + MISC_OFF); }
        ws = PA.wsp();
        const float* modf = (const float*)(ws + WS_MODF); float* X = (float*)(ws + WS_X); bf16_t* XN = (bf16_t*)(ws + WS_XN);
        const float* mod_lat = modf + (size_t)(L * 2 + 0) * 6 * DM; const float* mod_ctx = modf + (size_t)(L * 2 + 1) * 6 * DM;
        const bool need_ctx = L < DEPTH - 1;
        const int rlo = need_ctx ? 0 : TC;
        if (PHE(2) && IN(s0 + 0)) for (int rep = 0; rep < NREP(2); ++rep) { ph_norm<true>(F, X, XN, PA.inp(6) + L * DM, mod_lat, mod_ctx, 0, DM, PA.inp(8) + (size_t)L * DM * NIN, PA.inp(21) + L * 16, (float*)(ws + WS_DT), (const float*)(ws + WS_PART), L > 0 ? SPLIT_DN : 0, modf + (size_t)((L > 0 ? L - 1 : 0) * 2 + 1) * 6 * DM + 5 * DM); }
        SEAM(s0 + 0);
        if (PHE(3) && IN(s0 + 1)) for (int rep = 0; rep < NREP(3); ++rep) {
            pg8::Gemm g{XN, (const bf16_t*)(ws + WS_WIN) + (size_t)L * NP * DM, TA, NP, DM, DM}; pg8::StaticOrder S; { const Fr Fg = fr_refresh(F); S.init(TA, NP, Fg.G, Fg.bid); }
            pg8::EpiBf16 E{(bf16_t*)(ws + WS_P), NP};
            pg8::gemm_phase<pg8::EpiBf16, pg8::StaticOrder, true, true>(F.lds, g, S, E); }
        SEAM(s0 + 1);
        if (PHE(4) && IN(s0 + 2)) for (int rep = 0; rep < NREP(4); ++rep) { ph_prep(F, PA, L); }
        SEAM(s0 + 2);
        if (PHE(5) && IN(s0 + 3)) for (int rep = 0; rep < NREP(5); ++rep) { ph_state_scan(F, PA); ph_attn(F, PA, L); }
        SEAM(s0 + 3);
        if (PHE(6) && IN(s0 + 4)) for (int rep = 0; rep < NREP(6); ++rep) { ph_finish(F, PA, L); }
        SEAM(s0 + 4);
        if (PHE(7) && IN(s0 + 5)) {
            { pg8::Gemm g{(const bf16_t*)(ws + WS_YCAT) + (size_t)TC * DM, (const bf16_t*)(ws + WS_WOUT) + (size_t)L * DM * DM, TL, DM, DM, DM}; pg8::StaticOrder S; { const Fr Fg = fr_refresh(F); S.init(TL, DM, Fg.G, Fg.bid); }
              pg8::EpiResid E{X + (size_t)TC * DM, DM, mod_lat + 2 * DM, mod_lat + 2 * DM, 0};
              pg8::gemm_phase<pg8::EpiResid, pg8::StaticOrder, true, true>(F.lds, g, S, E); }
            if (need_ctx) { pg8::Gemm g{(const bf16_t*)(ws + WS_YCAT), (const bf16_t*)(ws + WS_WOUT) + (size_t)L * DM * DM, TC, DM, DM / SPLIT_OUT, DM}; const Fr Fg = fr_refresh(F); pg8::SplitKOrder S{DM / 256, SPLIT_OUT, DM / SPLIT_OUT, Fg.G, Fg.bid, 0};
              pg8::EpiPart E{(float*)(ws + WS_PART), DM, DM / SPLIT_OUT, TC};
              pg8::gemm_phase<pg8::EpiPart, pg8::SplitKOrder, true, true>(F.lds, g, S, E); } }
        SEAM(s0 + 5);
        if (PHE(8) && IN(s0 + 6)) for (int rep = 0; rep < NREP(8); ++rep) { ph_norm<false>(F, X, XN, PA.inp(7) + L * DM, mod_lat, mod_ctx, 3 * DM, 4 * DM, nullptr, nullptr, nullptr, (const float*)(ws + WS_PART), need_ctx ? SPLIT_OUT : 0, mod_ctx + 2 * DM); }
        SEAM(s0 + 6);
        if (PHE(9) && IN(s0 + 7)) for (int rep = 0; rep < NREP(9); ++rep) {
            pg8::Gemm g{XN + (size_t)rlo * DM, (const bf16_t*)(ws + WS_WUP) + (size_t)L * 2 * DFF * DM, TA - rlo, 2 * DFF, DM, DM}; pg8::StaticOrder S; { const Fr Fg = fr_refresh(F); S.init(TA - rlo, 2 * DFF, Fg.G, Fg.bid); }
            pg8::EpiBf16 E{(bf16_t*)(ws + WS_GU) + (size_t)rlo * 2 * DFF, 2 * DFF};
            pg8::gemm_phase<pg8::EpiBf16, pg8::StaticOrder, true, true>(F.lds, g, S, E); }
        SEAM(s0 + 7);
        if (PHE(10) && IN(s0 + 8)) for (int rep = 0; rep < NREP(10); ++rep) { ph_act(F, PA, L, rlo); }
        SEAM(s0 + 8);
        if (PHE(11) && IN(s0 + 9)) {
            { pg8::Gemm g{(const bf16_t*)(ws + WS_H) + (size_t)TC * DFF, (const bf16_t*)(ws + WS_WDN) + (size_t)L * DM * DFF, TL, DM, DFF, DFF}; pg8::StaticOrder S; { const Fr Fg = fr_refresh(F); S.init(TL, DM, Fg.G, Fg.bid); }
              pg8::EpiResid E{X + (size_t)TC * DM, DM, mod_lat + 5 * DM, mod_lat + 5 * DM, 0};
              pg8::gemm_phase<pg8::EpiResid, pg8::StaticOrder, true, true>(F.lds, g, S, E); }
            if (need_ctx) { pg8::Gemm g{(const bf16_t*)(ws + WS_H), (const bf16_t*)(ws + WS_WDN) + (size_t)L * DM * DFF, TC, DM, DFF / SPLIT_DN, DFF}; const Fr Fg = fr_refresh(F); pg8::SplitKOrder S{DM / 256, SPLIT_DN, DFF / SPLIT_DN, Fg.G, Fg.bid, 0};
              pg8::EpiPart E{(float*)(ws + WS_PART), DM, DFF / SPLIT_DN, TC};
              pg8::gemm_phase<pg8::EpiPart, pg8::SplitKOrder, true, true>(F.lds, g, S, E); } }
        SEAM(s0 + 9);
    }
    if (PHE(12) && IN(N_STEPS - 1)) { ph_final(F, PA); }
#undef IN
#undef SEAM
}

extern "C" void kernel_launch(void* const* d_in, const int* in_sizes, int n_in, void* d_out, int out_size, void* d_ws, size_t ws_size, hipStream_t stream) {
    static int grid = 0;
    if (grid == 0) {
        if (n_in != 30 || out_size != TL * DM || ws_size < WS_END) { fprintf(stderr, "kernel_launch: unexpected shapes: n_in %d out %d ws %zu (need %zu)\n", n_in, out_size, ws_size, (size_t)WS_END); grid = -1; return; }
        int dev = 0, cus = 0, per_cu = 0;
        if (hipGetDevice(&dev) != hipSuccess || hipDeviceGetAttribute(&cus, hipDeviceAttributeMultiprocessorCount, dev) != hipSuccess) { fprintf(stderr, "kernel_launch: device query failed\n"); grid = -1; return; }
        if (hipFuncSetAttribute((const void*)mk_fwd, hipFuncAttributeMaxDynamicSharedMemorySize, LDS_BYTES) != hipSuccess) { fprintf(stderr, "kernel_launch: hipFuncSetAttribute(%d) failed\n", LDS_BYTES); grid = -1; return; }
        if (hipOccupancyMaxActiveBlocksPerMultiprocessor(&per_cu, (const void*)mk_fwd, NWAVES * 64, LDS_BYTES) != hipSuccess || per_cu < 1) { fprintf(stderr, "kernel_launch: occupancy query says %d blocks per CU\n", per_cu); }
        (void)hipGetLastError();
        grid = cus;
    }
    if (grid < 0) return;
    if (hipMemsetAsync((char*)d_ws + WS_CTL, 0, CTL_ZERO_BYTES, stream) != hipSuccess) { fprintf(stderr, "kernel_launch: memset failed\n"); return; }
    Args a{};
    for (int i = 0; i < 30; ++i) a.in[i] = (const float*)d_in[i];
    a.out = (float*)d_out; a.ws = (unsigned char*)d_ws;
#if MK_ONE_LAUNCH
    a.s_lo = 0; a.s_hi = N_STEPS;
    hipLaunchKernelGGL(mk_fwd, dim3(grid), dim3(NWAVES * 64), LDS_BYTES, stream, a);
#else
    for (int s = 0; s < N_STEPS; ++s) { a.s_lo = s; a.s_hi = s + 1; hipLaunchKernelGGL(mk_fwd, dim3(grid), dim3(NWAVES * 64), LDS_BYTES, stream, a); }
#endif
    const hipError_t le = hipPeekAtLastError();
    if (le != hipSuccess) fprintf(stderr, "kernel_launch: launch failed: %s\n", hipGetErrorName(le));
}
```

```cpp
#include <hip/hip_runtime.h>
#include <hip/hip_bf16.h>
#include <cstdio>
#include <cstdint>

constexpr int WMAP_OFF = 147456 + 512;
__device__ __forceinline__ int lane_now() { int l; asm volatile("v_mbcnt_lo_u32_b32 %0, -1, 0\n\tv_mbcnt_hi_u32_b32 %0, -1, %0" : "=v"(l)); return l; }
__device__ __forceinline__ int wave_now() { const unsigned h = (unsigned)__builtin_amdgcn_s_getreg((5 << 11) | 4) & 63u;
    return __builtin_amdgcn_readfirstlane(((volatile __attribute__((address_space(3))) int*)(unsigned long)WMAP_OFF)[h]); }
__device__ __forceinline__ int tid_opaque() { int t = wave_now() * 64 + lane_now(); asm volatile("" : "+v"(t)); return t; }
__device__ __forceinline__ float shx(float v, int o) { return __builtin_bit_cast(float, __builtin_amdgcn_ds_bpermute((lane_now() ^ o) << 2, __builtin_bit_cast(int, v))); }
__device__ __forceinline__ float shup(float v, int o) { return __builtin_bit_cast(float, __builtin_amdgcn_ds_bpermute(((lane_now() - o) & 63) << 2, __builtin_bit_cast(int, v))); }
__device__ __forceinline__ float shdn(float v, int o) { return __builtin_bit_cast(float, __builtin_amdgcn_ds_bpermute(((lane_now() + o) & 63) << 2, __builtin_bit_cast(int, v))); }
__device__ __forceinline__ float shidx(float v, int src) { return __builtin_bit_cast(float, __builtin_amdgcn_ds_bpermute(src << 2, __builtin_bit_cast(int, v))); }

namespace pg8 {
#define PG8_LAS __attribute__((address_space(3)))
typedef unsigned short bf16_t;
typedef short bf16x8 __attribute__((ext_vector_type(8)));
typedef float f32x4 __attribute__((ext_vector_type(4)));
typedef unsigned u32x4 __attribute__((ext_vector_type(4)));
constexpr int BM = 256, BK = 64, HALF = 128, HTB = HALF * BK * 2  , STAGE_BYTES = 8 * HTB, NXCD = 8, WGM = 8;

__host__ __device__ __forceinline__ int lds_byte(int r, int c) { const int st = (r >> 4) * 2 + (c >> 5), rr = r & 15, cc = c & 31, ob = rr * 64 + cc * 2; return st * 1024 + (ob ^ (((ob >> 9) & 1) << 5)); }
__host__ __device__ __forceinline__ void stage_rc(int b, int& R, int& C) { const int st = b / 1024, sb = b % 1024, swz = sb ^ (((sb >> 9) & 1) << 5); R = (st >> 1) * 16 + swz / 64; C = (st & 1) * 32 + (swz % 64) / 2; }
__host__ __device__ __forceinline__ int perm32(int rho) { const int n = rho >> 4, i = rho & 15; return 8 * (i >> 2) + 4 * n + (i & 3); }

struct Unit { int pm, pn, k0; };
struct Gemm { const bf16_t* A; const bf16_t* Bt; int M, N, K, ld; };

struct StaticOrder {
    int nM, nN, nwg, G, c;
    __host__ __device__ void init(int M, int N, int G_, int c_) { nM = M / BM; nN = N / BM; nwg = nM * nN; G = G_; c = c_; }
    __host__ __device__ bool next(int i, Unit& u) const {
        const long L = (long)i * G + c; if (L >= nwg) return false;
        int wgid = (int)L; { const int q = nwg / NXCD, r = nwg % NXCD, xcd = wgid % NXCD, off = wgid / NXCD; wgid = (xcd < r ? xcd * (q + 1) : r * (q + 1) + (xcd - r) * q) + off; }
        const int nig = WGM * nN, gid = wgid / nig, fm = gid * WGM, gsz = (nM - fm) < WGM ? (nM - fm) : WGM;
        u.pm = fm + ((wgid % nig) % gsz); u.pn = (wgid % nig) / gsz; u.k0 = 0; return true;
    }
    __device__ __forceinline__ void a_ready(const Unit&) const {}
    __device__ __forceinline__ void done(const Unit&) const {}
};

struct SplitKOrder {
    int nN, S, kslice, G, c, pm;
    __host__ __device__ bool next(int i, Unit& u) const { const long L = (long)i * G + c; if (L >= (long)nN * S) return false; u.pm = pm; u.pn = (int)L / S; u.k0 = ((int)L % S) * kslice; return true; }
    __device__ __forceinline__ void a_ready(const Unit&) const {}
    __device__ __forceinline__ void done(const Unit&) const {}
};

__device__ __forceinline__ unsigned cvt_pk_bf16(float lo, float hi) { unsigned r; asm volatile("v_cvt_pk_bf16_f32 %0, %1, %2" : "=v"(r) : "v"(lo), "v"(hi)); return r; }

struct EpiBf16 {
    static constexpr bool PERM = true, AFTER_DRAIN = false;
    bf16_t* O; int ldc;
    __device__ __forceinline__ void operator()(const f32x4 (&acc)[2][2][4][2], const Unit& u, int wr, int wc, int fr, int fq) const {
        const int row0 = u.pm * BM + wr * 64 + fr; const int col0 = u.pn * BM + wc * 32 + 8 * fq;
#pragma unroll
        for (int ai = 0; ai < 2; ++ai)
#pragma unroll
            for (int m = 0; m < 4; ++m) { bf16_t* rowp = O + (size_t)(row0 + ai * HALF + m * 16) * ldc + col0;
#pragma unroll
                for (int bj = 0; bj < 2; ++bj) { const f32x4 v0 = acc[ai][bj][m][0], v1 = acc[ai][bj][m][1];
                    u32x4 w; w.x = cvt_pk_bf16(v0[0], v0[1]); w.y = cvt_pk_bf16(v0[2], v0[3]); w.z = cvt_pk_bf16(v1[0], v1[1]); w.w = cvt_pk_bf16(v1[2], v1[3]);
                    *(u32x4*)(rowp + bj * HALF) = w; } }
    }
};
struct EpiResid {
    static constexpr bool PERM = false, AFTER_DRAIN = false;
    float* X; int ldc; const float* gate_ctx; const float* gate_lat; int ctx_panels;
    __device__ __forceinline__ void operator()(const f32x4 (&acc)[2][2][4][2], const Unit& u, int wr, int wc, int fr, int fq) const {
        const int row0 = u.pm * BM + wr * 64 + fr, col0 = u.pn * BM + wc * 32 + 4 * fq;
        const float* gate = (u.pm < ctx_panels) ? gate_ctx : gate_lat;
        f32x4 gv[2][2];
#pragma unroll
        for (int bj = 0; bj < 2; ++bj)
#pragma unroll
            for (int n = 0; n < 2; ++n) gv[bj][n] = *(const f32x4*)(gate + col0 + bj * HALF + n * 16);
#pragma unroll
        for (int ai = 0; ai < 2; ++ai)
#pragma unroll
            for (int m = 0; m < 4; ++m) { float* rowp = X + (size_t)(row0 + ai * HALF + m * 16) * ldc + col0;
#pragma unroll
                for (int bj = 0; bj < 2; ++bj)
#pragma unroll
                    for (int n = 0; n < 2; ++n) { float* p = rowp + bj * HALF + n * 16; const f32x4 xv = *(const f32x4*)p; *(f32x4*)p = xv + gv[bj][n] * acc[ai][bj][m][n]; }
                asm volatile("" ::: "memory"); }
    }
};
struct EpiPart {
    static constexpr bool PERM = false, AFTER_DRAIN = false;
    float* part; int ldc, kslice, rows;
    __device__ __forceinline__ void operator()(const f32x4 (&acc)[2][2][4][2], const Unit& u, int wr, int wc, int fr, int fq) const {
        const int row0 = u.pm * BM + wr * 64 + fr, col0 = u.pn * BM + wc * 32 + 4 * fq;
        float* base = part + (size_t)(u.k0 / kslice) * rows * ldc;
#pragma unroll
        for (int ai = 0; ai < 2; ++ai)
#pragma unroll
            for (int m = 0; m < 4; ++m) { float* rowp = base + (size_t)(row0 + ai * HALF + m * 16) * ldc + col0;
#pragma unroll
                for (int bj = 0; bj < 2; ++bj)
#pragma unroll
                    for (int n = 0; n < 2; ++n) *(f32x4*)(rowp + bj * HALF + n * 16) = acc[ai][bj][m][n]; }
    }
};
struct EpiAct {
    static constexpr bool PERM = false, AFTER_DRAIN = false;
    bf16_t* H; int ldh; const float* cw; const float* cb; float* gbnd; float* ubnd; int panel_off; PG8_LAS float* xr;
    template <int CTRL> static __device__ __forceinline__ f32x4 rot4(const f32x4 v) { f32x4 r;
#pragma unroll
        for (int j = 0; j < 4; ++j) { const float t = v[j]; r[j] = __int_as_float(__builtin_amdgcn_update_dpp(0, __float_as_int(t), CTRL, 0xF, 0xF, false)); }
        return r; }
    __device__ __forceinline__ void operator()(const f32x4 (&acc)[2][2][4][2], const Unit& u, int wr, int wc, int fr, int fq) const {
        const int pabs = u.pm + panel_off, ch0 = u.pn * HALF + wc * 32 + 4 * fq, NCH = ldh;
#pragma unroll
        for (int ai = 0; ai < 2; ++ai)
#pragma unroll
            for (int n = 0; n < 2; ++n) { const int xo = (ai * 2 + wr) * 256 + wc * 32 + n * 16 + 4 * fq;
                if (fr == 0) *(PG8_LAS f32x4*)(xr + xo) = acc[ai][0][0][n];
                if (fr == 15) *(PG8_LAS f32x4*)(xr + xo + 128) = acc[ai][0][3][n]; }
#pragma unroll
        for (int n = 0; n < 2; ++n) { const int c = ch0 + 16 * n;
            if (wr == 0 && fr < 2) *(f32x4*)(gbnd + ((size_t)pabs * 4 + fr) * NCH + c) = acc[0][0][0][n];
            if (wr == 0 && fr == 0) *(f32x4*)(ubnd + ((size_t)pabs * 2 + 0) * NCH + c) = acc[0][1][0][n];
            if (wr == 1 && fr >= 14) *(f32x4*)(gbnd + ((size_t)pabs * 4 + 2 + (fr - 14)) * NCH + c) = acc[1][0][3][n];
            if (wr == 1 && fr == 15) *(f32x4*)(ubnd + ((size_t)pabs * 2 + 1) * NCH + c) = acc[1][1][3][n]; }
        asm volatile("s_waitcnt lgkmcnt(0)" ::: "memory"); __builtin_amdgcn_s_barrier(); asm volatile("" ::: "memory");
        const int row0 = u.pm * BM + wr * 64 + fr;
#pragma unroll
        for (int n = 0; n < 2; ++n) { const int c = ch0 + 16 * n;
            const f32x4 w0 = *(const f32x4*)(cw + c), w1 = *(const f32x4*)(cw + NCH + c), w2 = *(const f32x4*)(cw + 2 * NCH + c), bb = *(const f32x4*)(cb + c);
#pragma unroll
            for (int ai = 0; ai < 2; ++ai) { const int blk = ai * 2 + wr, xo = wc * 32 + n * 16 + 4 * fq;
                const f32x4 zero = {0.f, 0.f, 0.f, 0.f};
                const f32x4 bprev = (blk > 0) ? *(const PG8_LAS f32x4*)(xr + (blk - 1) * 256 + 128 + xo) : zero;
                const f32x4 bnext = (blk < 3) ? *(const PG8_LAS f32x4*)(xr + (blk + 1) * 256 + xo) : zero;
                f32x4 up1[4], dn1[4];
#pragma unroll
                for (int m = 0; m < 4; ++m) { up1[m] = rot4<0x121>(acc[ai][0][m][n]); dn1[m] = rot4<0x12F>(acc[ai][0][m][n]); }
#pragma unroll
                for (int m = 0; m < 4; ++m) {
                    const f32x4 pv = (fr == 0) ? (m > 0 ? up1[m - 1] : bprev) : up1[m];
                    const f32x4 nv = (fr == 15) ? (m < 3 ? dn1[m + 1] : bnext) : dn1[m];
                    const f32x4 gsum = bb + w0 * pv + w1 * acc[ai][0][m][n] + w2 * nv, uu = acc[ai][1][m][n];
                    float h[4];
#pragma unroll
                    for (int j = 0; j < 4; ++j) h[j] = gsum[j] / (1.f + __expf(-gsum[j])) * uu[j];
                    typedef unsigned u32x2 __attribute__((ext_vector_type(2)));
                    u32x2 o; o.x = cvt_pk_bf16(h[0], h[1]); o.y = cvt_pk_bf16(h[2], h[3]);
                    *(u32x2*)(H + (size_t)(row0 + ai * HALF + m * 16) * ldh + c) = o; } } }
    }
};

template <class Epi, class Sched, bool ALIGN_EPI = false, bool SP2 = false>
__device__ __forceinline__ void gemm_phase(PG8_LAS unsigned char* lds, const Gemm g, const Sched& S, const Epi& E) {
    const int tid = tid_opaque(), wid = __builtin_amdgcn_readfirstlane(tid >> 6), lane = tid & 63, wr = wid >> 2, wc = wid & 3, fr = lane & 15, fq = lane >> 4;
    const int K = g.K, nt = K / BK, ld = g.ld;
    unsigned voffA[2], voffB[2];
#pragma unroll
    for (int i = 0; i < 2; ++i) { int R, C; stage_rc(tid * 16 + i * 8192, R, C); const int Rb = Epi::PERM ? ((R & ~31) + perm32(R & 31)) : R;
        voffA[i] = (unsigned)(R * ld + C) * 2u; voffB[i] = (unsigned)(Rb * ld + C) * 2u; }
    const size_t kstep = (size_t)(BK * 2);
    const size_t hstep = (size_t)HALF * ld * 2;
    const size_t tstep = 2 * hstep;
    const unsigned ldsw = (unsigned)wid * 1024u;
    const int aoff = lds_byte(wr * 64 + fr, fq * 8), boff = lds_byte(wc * 32 + fr, fq * 8);
#define PG8_SA(b, h) (((b) * 2 + (h)) * HTB)
#define PG8_SB(b, h) ((4 + (b) * 2 + (h)) * HTB)
#define PG8_STAGE(bufoff, gbase, voff) do { _Pragma("unroll") for (int _i = 0; _i < 2; ++_i) \
        __builtin_amdgcn_global_load_lds((const unsigned*)((const char*)(gbase) + (voff)[_i]), (PG8_LAS unsigned*)(lds + (bufoff) + ldsw + _i * 8192), 16, 0, 0); } while (0)
#define PG8_LDA(dst, b, h) do { _Pragma("unroll") for (int m = 0; m < 4; ++m) _Pragma("unroll") for (int k = 0; k < 2; ++k) dst[m][k] = *(const PG8_LAS bf16x8*)(lds + PG8_SA(b, h) + aoff + m * 2048 + k * 1024); } while (0)
#define PG8_LDB(dst, b, h) do { _Pragma("unroll") for (int n = 0; n < 2; ++n) _Pragma("unroll") for (int k = 0; k < 2; ++k) dst[n][k] = *(const PG8_LAS bf16x8*)(lds + PG8_SB(b, h) + boff + n * 2048 + k * 1024); } while (0)
#define PG8_MMA(ai, bj, At, Bt) do { __builtin_amdgcn_s_setprio(1); _Pragma("unroll") for (int m = 0; m < 4; ++m) _Pragma("unroll") for (int n = 0; n < 2; ++n) _Pragma("unroll") for (int k = 0; k < 2; ++k) \
        acc[ai][bj][m][n] = __builtin_amdgcn_mfma_f32_16x16x32_bf16(Bt[n][k], At[m][k], acc[ai][bj][m][n], 0, 0, 0); __builtin_amdgcn_s_setprio(0); } while (0)
#define PG8_WAIT_V(n) asm volatile("s_waitcnt vmcnt(" #n ")" ::: "memory")
#define PG8_WAIT_L(n) asm volatile("s_waitcnt lgkmcnt(" #n ")" ::: "memory")
#define PG8_BAR __builtin_amdgcn_s_barrier()
#define PG8_SCHED __builtin_amdgcn_sched_barrier(0)
    Unit cur, nxt; int ui = 0;
    if (!S.next(0, cur)) return;
    f32x4 acc[2][2][4][2];
#pragma unroll
    for (int a = 0; a < 2; ++a)
#pragma unroll
        for (int b = 0; b < 2; ++b)
#pragma unroll
            for (int m = 0; m < 4; ++m)
#pragma unroll
                for (int n = 0; n < 2; ++n) acc[a][b][m][n] = (f32x4){0.f, 0.f, 0.f, 0.f};
    bf16x8 At[4][2], B0[2][2], B1[2][2];
    const char* cA = (const char*)g.A + (size_t)cur.pm * tstep + (size_t)cur.k0 * 2; const char* cB = (const char*)g.Bt + (size_t)cur.pn * tstep + (size_t)cur.k0 * 2;
    S.a_ready(cur);
    if constexpr (SP2) {
        PG8_STAGE(PG8_SB(0, 0), cB, voffB); PG8_STAGE(PG8_SB(0, 1), cB + hstep, voffB); PG8_STAGE(PG8_SA(0, 0), cA, voffA); PG8_STAGE(PG8_SA(0, 1), cA + hstep, voffA);
        if (wr == 1) PG8_BAR;
        PG8_WAIT_V(2); PG8_BAR;
        PG8_STAGE(PG8_SB(1, 0), cB + kstep, voffB); PG8_STAGE(PG8_SA(1, 0), cA + kstep, voffA); PG8_STAGE(PG8_SB(1, 1), cB + hstep + kstep, voffB);
        PG8_WAIT_V(6); PG8_BAR;
    } else {
        PG8_STAGE(PG8_SB(0, 0), cB, voffB); PG8_STAGE(PG8_SA(0, 0), cA, voffA); PG8_STAGE(PG8_SB(0, 1), cB + hstep, voffB); PG8_STAGE(PG8_SA(0, 1), cA + hstep, voffA);
        if (wr == 1) PG8_BAR;
        PG8_WAIT_V(4); PG8_BAR;
        PG8_STAGE(PG8_SB(1, 0), cB + kstep, voffB); PG8_STAGE(PG8_SA(1, 0), cA + kstep, voffA); PG8_STAGE(PG8_SB(1, 1), cB + hstep + kstep, voffB);
        PG8_WAIT_V(6); PG8_BAR;
    }
    for (;;) {
        const bool has_next = S.next(ui + 1, nxt);
        const char* nA = has_next ? (const char*)g.A + (size_t)nxt.pm * tstep + (size_t)nxt.k0 * 2 : cA; const char* nB = has_next ? (const char*)g.Bt + (size_t)nxt.pn * tstep + (size_t)nxt.k0 * 2 : cB;
        asm volatile(".p2align 8");
        for (int t = 0; t < nt; t += 2) {
            const bool last = (t == nt - 2);
            const char* a1 = cA + (size_t)(t + 1) * kstep;
            const char* a2 = last ? nA : cA + (size_t)(t + 2) * kstep; const char* b2 = last ? nB : cB + (size_t)(t + 2) * kstep;
            const char* a3 = a2 + kstep; const char* b3 = b2 + kstep;
            if (last && has_next) S.a_ready(nxt);
            if constexpr (SP2) {
            PG8_LDB(B0, 0, 0); PG8_LDB(B1, 0, 1); PG8_SCHED; PG8_LDA(At, 0, 0); PG8_STAGE(PG8_SA(1, 1), a1 + hstep, voffA);
            PG8_WAIT_V(8); PG8_WAIT_L(0); PG8_BAR; PG8_MMA(0, 0, At, B0); PG8_MMA(0, 1, At, B1); PG8_BAR; PG8_SCHED;
            PG8_LDA(At, 0, 1); PG8_STAGE(PG8_SB(0, 0), b2, voffB); PG8_STAGE(PG8_SB(0, 1), b2 + hstep, voffB); PG8_STAGE(PG8_SA(0, 0), a2, voffA);
            PG8_WAIT_V(8); PG8_WAIT_L(0); PG8_BAR; PG8_MMA(1, 0, At, B0); PG8_MMA(1, 1, At, B1); PG8_BAR; PG8_SCHED;
            PG8_LDB(B0, 1, 0); PG8_LDB(B1, 1, 1); PG8_SCHED; PG8_LDA(At, 1, 0); PG8_STAGE(PG8_SA(0, 1), a2 + hstep, voffA);
            PG8_WAIT_V(8); PG8_WAIT_L(0); PG8_BAR; PG8_MMA(0, 0, At, B0); PG8_MMA(0, 1, At, B1); PG8_BAR; PG8_SCHED;
            PG8_LDA(At, 1, 1); PG8_STAGE(PG8_SB(1, 0), b3, voffB); PG8_STAGE(PG8_SB(1, 1), b3 + hstep, voffB); PG8_STAGE(PG8_SA(1, 0), a3, voffA);
            PG8_WAIT_V(8); PG8_WAIT_L(0); PG8_BAR; PG8_MMA(1, 0, At, B0); PG8_MMA(1, 1, At, B1); PG8_BAR; PG8_SCHED;
            } else {
            PG8_LDB(B0, 0, 0); PG8_SCHED; PG8_LDA(At, 0, 0); PG8_STAGE(PG8_SA(1, 1), a1 + hstep, voffA);
            PG8_WAIT_L(8); PG8_BAR; PG8_WAIT_L(0); PG8_MMA(0, 0, At, B0); PG8_BAR; PG8_SCHED;
            PG8_LDB(B1, 0, 1); PG8_STAGE(PG8_SB(0, 0), b2, voffB);
            PG8_BAR; PG8_WAIT_L(0); PG8_MMA(0, 1, At, B1); PG8_BAR;
            PG8_LDA(At, 0, 1); PG8_STAGE(PG8_SA(0, 0), a2, voffA);
            PG8_BAR; PG8_WAIT_L(0); PG8_MMA(1, 0, At, B0); PG8_BAR; PG8_SCHED;
            PG8_STAGE(PG8_SB(0, 1), b2 + hstep, voffB);
            PG8_WAIT_V(6); PG8_BAR; PG8_MMA(1, 1, At, B1); PG8_BAR;
            PG8_LDB(B0, 1, 0); PG8_SCHED; PG8_LDA(At, 1, 0); PG8_STAGE(PG8_SA(0, 1), a2 + hstep, voffA);
            PG8_WAIT_L(8); PG8_BAR; PG8_WAIT_L(0); PG8_MMA(0, 0, At, B0); PG8_BAR; PG8_SCHED;
            PG8_LDB(B1, 1, 1); PG8_STAGE(PG8_SB(1, 0), b3, voffB);
            PG8_BAR; PG8_WAIT_L(0); PG8_MMA(0, 1, At, B1); PG8_BAR;
            PG8_LDA(At, 1, 1); PG8_STAGE(PG8_SA(1, 0), a3, voffA);
            PG8_BAR; PG8_WAIT_L(0); PG8_MMA(1, 0, At, B0); PG8_BAR; PG8_SCHED;
            PG8_STAGE(PG8_SB(1, 1), b3 + hstep, voffB);
            PG8_WAIT_V(6); PG8_BAR; PG8_MMA(1, 1, At, B1); PG8_BAR;
            }
        }
        if constexpr (ALIGN_EPI) { if (wr == 0) PG8_BAR; }
        if constexpr (!Epi::AFTER_DRAIN) { E(acc, cur, wr, wc, fr, fq); S.done(cur); }
        if (!has_next) break;
#pragma unroll
        for (int a = 0; a < 2; ++a)
#pragma unroll
            for (int b = 0; b < 2; ++b)
#pragma unroll
                for (int m = 0; m < 4; ++m)
#pragma unroll
                    for (int n = 0; n < 2; ++n) acc[a][b][m][n] = (f32x4){0.f, 0.f, 0.f, 0.f};
        cur = nxt; cA = nA; cB = nB; ++ui;
        if constexpr (ALIGN_EPI) { if (wr == 1) PG8_BAR; }
    }
    PG8_WAIT_V(0);
    if constexpr (!ALIGN_EPI) { if (wr == 0) PG8_BAR; }
    PG8_BAR;
    if constexpr (Epi::AFTER_DRAIN) { E.fused(acc, cur, wr, wc, fr, fq, lds, wid, lane); S.done(cur); }
#undef PG8_SA
#undef PG8_SB
#undef PG8_STAGE
#undef PG8_LDA
#undef PG8_LDB
#undef PG8_MMA
#undef PG8_WAIT_V
#undef PG8_WAIT_L
#undef PG8_BAR
#undef PG8_SCHED
}
}

namespace att {
using bf16 = __hip_bfloat16;
constexpr int   D = 128, NW = 8, QBLK = 32, KVBLK = 64;
constexpr float SCALE = 0.088388347648318440f;
constexpr float THR = 8.f;
constexpr int SDEPTH = 2;
constexpr int LDQ = 1536, LDK = 768, LDV = 5120, LDO = 1536;
constexpr size_t SHM_V = KVBLK * D * 2, SHM_K = KVBLK * D * 2, SHM_ATTN = 2 * SHM_V + 2 * SHM_K + NW * 64 * 4;
using bf16x8 = __attribute__((ext_vector_type(8))) short;
using s16x4  = __attribute__((ext_vector_type(4))) short;
using f32x16 = __attribute__((ext_vector_type(16))) float;
using f32x8  = __attribute__((ext_vector_type(8))) float;
using u32x4  = __attribute__((ext_vector_type(4))) unsigned;
#define KSWZ(row, colB) ((row) * 256 + ((colB) ^ (((row) & 7) << 4)))
#define SBAR() __builtin_amdgcn_sched_barrier(0)
__device__ __forceinline__ int crow(int r, int hi) { return (r & 3) + 8 * (r >> 2) + 4 * hi; }
__device__ __forceinline__ unsigned cvtpk(float lo, float hi) {
  unsigned r; asm volatile("v_cvt_pk_bf16_f32 %0, %1, %2" : "=v"(r) : "v"(lo), "v"(hi)); return r;
}
template <typename TIn> struct Stage;
template <> struct Stage<bf16>  { using T = bf16x8;
  __device__ static __forceinline__ T ld8(const bf16* p) { return *reinterpret_cast<const bf16x8*>(p); }
  __device__ static __forceinline__ bf16x8 tobf(T x) { return x; } };
template <> struct Stage<float> { using T = f32x8;
  __device__ static __forceinline__ T ld8(const float* p) { return *reinterpret_cast<const f32x8*>(p); }
  __device__ static __forceinline__ bf16x8 tobf(T x) {
    u32x4 w = {cvtpk(x[0], x[1]), cvtpk(x[2], x[3]), cvtpk(x[4], x[5]), cvtpk(x[6], x[7])}; return *reinterpret_cast<bf16x8*>(&w); } };

__device__ __forceinline__ void partialSM(f32x16& p0, f32x16& p1, float& m_reg, float& mn, float& alpha) {
  constexpr float C = SCALE * 1.4426950408889634f;
  float pmax = p0[0]; for (int r = 1; r < 16; ++r) pmax = fmaxf(pmax, p0[r]); for (int r = 0; r < 16; ++r) pmax = fmaxf(pmax, p1[r]);
  { auto rr = __builtin_amdgcn_permlane32_swap(__float_as_uint(pmax), __float_as_uint(pmax), false, false);
    pmax = fmaxf(__uint_as_float(rr[0]), __uint_as_float(rr[1])); }
  if (__builtin_expect(__all(pmax - m_reg <= THR / SCALE), 1)) { mn = m_reg; alpha = 1.f; }
  else { mn = fmaxf(m_reg, pmax); alpha = __builtin_amdgcn_exp2f((m_reg - mn) * C); m_reg = mn; }
  float mnC = -mn * C;
  for (int r = 0; r < 16; ++r) p0[r] = fmaf(p0[r], C, mnC); for (int r = 0; r < 16; ++r) p1[r] = fmaf(p1[r], C, mnC);
  for (int r = 0; r < 16; ++r) p0[r] = __builtin_amdgcn_exp2f(p0[r]);
}
__device__ __forceinline__ void finishSM(f32x16& p0, f32x16& p1, float alpha, float& l_reg, bf16x8& pa0, bf16x8& pa1, bf16x8& pa2, bf16x8& pa3) {
  for (int r = 0; r < 16; ++r) p1[r] = __builtin_amdgcn_exp2f(p1[r]);
  float ps = 0; for (int r = 0; r < 16; ++r) ps += p0[r]; for (int r = 0; r < 16; ++r) ps += p1[r];
  { auto rr = __builtin_amdgcn_permlane32_swap(__float_as_uint(ps), __float_as_uint(ps), false, false);
    ps = __uint_as_float(rr[0]) + __uint_as_float(rr[1]); }
  l_reg = l_reg * alpha + ps;
#define PK4(P, BASE, OUT) do { unsigned a0 = cvtpk(P[BASE + 0], P[BASE + 1]), a1 = cvtpk(P[BASE + 2], P[BASE + 3]);   \
    unsigned b0 = cvtpk(P[BASE + 4], P[BASE + 5]), b1 = cvtpk(P[BASE + 6], P[BASE + 7]);                              \
    auto r0 = __builtin_amdgcn_permlane32_swap(a0, b0, false, false); auto r1 = __builtin_amdgcn_permlane32_swap(a1, b1, false, false); \
    u32x4 w = {r0[0], r1[0], r0[1], r1[1]}; OUT = *reinterpret_cast<bf16x8*>(&w); } while (0)
  PK4(p0, 0, pa0); PK4(p0, 8, pa1); PK4(p1, 0, pa2); PK4(p1, 8, pa3);
#undef PK4
}
template <int ND0> __device__ __forceinline__ void qkt(f32x16& p0, f32x16& p1, const bf16* Ks, const bf16x8* qr, int r32, int hi, int kcb) {
  p0 = f32x16{}; p1 = f32x16{};
#pragma unroll
  for (int d0 = 0; d0 < ND0; ++d0) { int cb = (d0 * 16 + hi * 8) * 2 + kcb;
    bf16x8 b0 = *reinterpret_cast<const bf16x8*>((const char*)Ks + KSWZ(r32, cb));
    bf16x8 b1 = *reinterpret_cast<const bf16x8*>((const char*)Ks + KSWZ(32 + r32, cb));
    p0 = __builtin_amdgcn_mfma_f32_32x32x16_bf16(b0, qr[d0], p0, 0, 0, 0);
    p1 = __builtin_amdgcn_mfma_f32_32x32x16_bf16(b1, qr[d0], p1, 0, 0, 0); }
}
__device__ __forceinline__ int v_st(int k, int c) { const int kk = (k & ~0xC) | ((k & 4) << 1) | ((k & 8) >> 1); return ((kk >> 3) * 4 + (c >> 5)) * 512 + ((kk & 7) * 32 + (c & 31)) * 2; }
__device__ __forceinline__ int v_rd_base(int lane) { return ((lane & 3) << 3) | (((lane >> 2) & 3) << 6) | (((lane >> 4) & 1) << 5) | (((lane >> 5) & 1) << 8); }
constexpr int v_rd_off(int d0, int ks, int half) { return d0 * 512 + ks * 4096 + half * 2048; }
template <int OFF> __device__ __forceinline__ s16x4 tr_read(int vb) {
  s16x4 r; asm volatile("ds_read_b64_tr_b16 %0, %1 offset:%2" : "=&v"(r) : "v"(vb), "i"(OFF) : "memory"); return r;
}
template <int D0> __device__ __forceinline__ void pv_one(f32x16& od, int vb, bf16x8 pa0, bf16x8 pa1, bf16x8 pa2, bf16x8 pa3) {
  const s16x4 l0 = tr_read<v_rd_off(D0, 0, 0)>(vb), h0 = tr_read<v_rd_off(D0, 0, 1)>(vb), l1 = tr_read<v_rd_off(D0, 1, 0)>(vb), h1 = tr_read<v_rd_off(D0, 1, 1)>(vb);
  const s16x4 l2 = tr_read<v_rd_off(D0, 2, 0)>(vb), h2 = tr_read<v_rd_off(D0, 2, 1)>(vb), l3 = tr_read<v_rd_off(D0, 3, 0)>(vb), h3 = tr_read<v_rd_off(D0, 3, 1)>(vb);
  asm volatile("s_waitcnt lgkmcnt(0)" ::: "memory"); SBAR();
#define PK(L, H) (bf16x8){L[0], L[1], L[2], L[3], H[0], H[1], H[2], H[3]}
  od = __builtin_amdgcn_mfma_f32_32x32x16_bf16(pa0, PK(l0, h0), od, 0, 0, 0);
  od = __builtin_amdgcn_mfma_f32_32x32x16_bf16(pa1, PK(l1, h1), od, 0, 0, 0);
  od = __builtin_amdgcn_mfma_f32_32x32x16_bf16(pa2, PK(l2, h2), od, 0, 0, 0);
  od = __builtin_amdgcn_mfma_f32_32x32x16_bf16(pa3, PK(l3, h3), od, 0, 0, 0);
#undef PK
}
__device__ __forceinline__ void pv_d0(f32x16* o, int vb, bf16x8 pa0, bf16x8 pa1, bf16x8 pa2, bf16x8 pa3) {
  pv_one<0>(o[0], vb, pa0, pa1, pa2, pa3); pv_one<1>(o[1], vb, pa0, pa1, pa2, pa3); pv_one<2>(o[2], vb, pa0, pa1, pa2, pa3); pv_one<3>(o[3], vb, pa0, pa1, pa2, pa3);
}

template <typename TQ, int ND0, bool PARTIAL>
__device__ __forceinline__ void attn_dense_body(const TQ* __restrict__ Qb, const bf16* __restrict__ Kh, const bf16* __restrict__ Vh,
                                                float* __restrict__ Ob, int seq, char* lds, int kcb, float* __restrict__ ML) {
  using St = Stage<bf16>; using SQ = Stage<TQ>;
  const int tid = tid_opaque(), wid = tid >> 6, lane = tid & 63, r32 = lane & 31, hi = lane >> 5;
  bf16* V_lds = (bf16*)lds; bf16* K_lds = (bf16*)(lds + 2 * SHM_V);
  float* ws = (float*)(lds + 2 * SHM_V + 2 * SHM_K) + wid * 64; float* li_l = ws; float* al_l = ws + 32;
  float m_reg = -1e30f, l_reg = 0; f32x16 o[4] = {}; bf16x8 qr[8];
  const TQ* Qw = Qb + (long)(wid * QBLK + r32) * LDQ + hi * 8;
#pragma unroll
  for (int d0 = 0; d0 < ND0; ++d0) qr[d0] = SQ::tobf(SQ::ld8(Qw + d0 * 16));
  const int sr = tid >> 4, sc = (tid & 15) * 8, vst0 = v_st(sr, sc), vst1 = v_st(32 + sr, sc);
  const int vb0 = (int)(uintptr_t)V_lds + v_rd_base(lane);
  struct { typename St::T vs0, vs1, ks0, ks1; } sr_[SDEPTH];
#define SLOAD(i, k0) do { sr_[i].vs0 = St::ld8(&Vh[(long)((k0) + sr) * LDV + sc]); sr_[i].vs1 = St::ld8(&Vh[(long)((k0) + 32 + sr) * LDV + sc]); \
    sr_[i].ks0 = St::ld8(&Kh[(long)((k0) + sr) * LDK + sc]); sr_[i].ks1 = St::ld8(&Kh[(long)((k0) + 32 + sr) * LDK + sc]); } while (0)
#define SWRITE(b, i) do { *(bf16x8*)((char*)V_lds + (b) * SHM_V + vst0) = St::tobf(sr_[i].vs0);          \
    *(bf16x8*)((char*)V_lds + (b) * SHM_V + vst1) = St::tobf(sr_[i].vs1); int kc = sc * 2;               \
    *(bf16x8*)((char*)K_lds + (b) * SHM_K + KSWZ(sr, kc)) = St::tobf(sr_[i].ks0);                       \
    *(bf16x8*)((char*)K_lds + (b) * SHM_K + KSWZ(32 + sr, kc)) = St::tobf(sr_[i].ks1); } while (0)
#define SWAIT() do { if constexpr (SDEPTH == 2) asm volatile("s_waitcnt vmcnt(4)" ::: "memory"); else asm volatile("s_waitcnt vmcnt(0)" ::: "memory"); } while (0)
#define RESC(a) do { if (__any((a) < 1.f)) { if (hi == 0) al_l[r32] = (a); asm volatile("s_waitcnt lgkmcnt(0)" ::: "memory"); \
    for (int d = 0; d < 4; ++d) for (int r = 0; r < 16; ++r) o[d][r] *= al_l[crow(r, hi)]; } } while (0)
  f32x16 pA0, pA1, pB0, pB1; float mnA, mnB, alA, alB; bf16x8 pa0, pa1, pa2, pa3; const int NT = seq / KVBLK;
  constexpr int SE = 0, SO = SDEPTH - 1;
  SLOAD(SE, 0); asm volatile("s_waitcnt vmcnt(0)" ::: "memory"); SWRITE(0, SE); __syncthreads();
  qkt<ND0>(pA0, pA1, K_lds, qr, r32, hi, kcb); partialSM(pA0, pA1, m_reg, mnA, alA);
  SLOAD(SO, KVBLK); if constexpr (SDEPTH == 2) { if (2 < NT) SLOAD(SE, 2 * KVBLK); }
  SWAIT(); SWRITE(1, SO); __syncthreads();
  asm volatile(".p2align 8");
  for (int j = 1; j + 1 < NT; j += 2) {
    SBAR(); qkt<ND0>(pB0, pB1, (bf16*)((char*)K_lds + SHM_K), qr, r32, hi, kcb);
    finishSM(pA0, pA1, alA, l_reg, pa0, pa1, pa2, pa3); SBAR();
    SLOAD(SO, (j + SDEPTH) * KVBLK); SBAR();
    pv_d0(o, vb0, pa0, pa1, pa2, pa3); partialSM(pB0, pB1, m_reg, mnB, alB);
    __syncthreads(); SWAIT(); SWRITE(0, SE);
    RESC(alB); __syncthreads();
    SBAR(); qkt<ND0>(pA0, pA1, K_lds, qr, r32, hi, kcb);
    finishSM(pB0, pB1, alB, l_reg, pa0, pa1, pa2, pa3); SBAR();
    if (SDEPTH == 1 || j + 3 < NT) SLOAD(SE, (j + 1 + SDEPTH) * KVBLK); SBAR();
    pv_d0(o, vb0 + (int)SHM_V, pa0, pa1, pa2, pa3); partialSM(pA0, pA1, m_reg, mnA, alA);
    __syncthreads(); SWAIT(); SWRITE(1, SO);
    RESC(alA); __syncthreads();
  }
  SBAR(); qkt<ND0>(pB0, pB1, (bf16*)((char*)K_lds + SHM_K), qr, r32, hi, kcb);
  finishSM(pA0, pA1, alA, l_reg, pa0, pa1, pa2, pa3); SBAR();
  pv_d0(o, vb0, pa0, pa1, pa2, pa3); partialSM(pB0, pB1, m_reg, mnB, alB);
  __syncthreads(); RESC(alB);
  finishSM(pB0, pB1, alB, l_reg, pa0, pa1, pa2, pa3); SBAR();
  pv_d0(o, vb0 + (int)SHM_V, pa0, pa1, pa2, pa3);
  if (hi == 0) li_l[r32] = l_reg; asm volatile("s_waitcnt lgkmcnt(0)" ::: "memory");
  float rli[16];
#pragma unroll
  for (int r = 0; r < 16; ++r) rli[r] = PARTIAL ? 1.f : __builtin_amdgcn_rcpf(li_l[crow(r, hi)]);
  if (PARTIAL) { if (hi == 0) { float* mp = ML + (long)(wid * QBLK + r32) * 24; mp[0] = m_reg * (SCALE * 1.4426950408889634f); mp[1] = l_reg; } }
  float* Ow = Ob + (long)(wid * QBLK) * LDO;
#pragma unroll
  for (int r = 0; r < 16; ++r) { int orow = crow(r, hi);
    for (int d0 = 0; d0 < 4; ++d0) Ow[(long)orow * LDO + d0 * 32 + r32] = o[d0][r] * rli[r]; }
#undef SLOAD
#undef SWRITE
#undef SWAIT
#undef RESC
}
}

#define GAS __attribute__((address_space(1)))
typedef unsigned short bf16_t;
typedef unsigned v4u __attribute__((ext_vector_type(4)));
typedef unsigned v2u __attribute__((ext_vector_type(2)));
typedef float f32x4 __attribute__((ext_vector_type(4)));
typedef float f32x2 __attribute__((ext_vector_type(2)));
typedef short bf16x8 __attribute__((ext_vector_type(8)));

constexpr int DM = 2048, TL = 8192, TC = 256, TA = TL + TC, DEPTH = 4, DFF = 5632;
constexpr int NP = 5120, NIN = 5136;
constexpr int C_DAQ = 0, C_DAK = 512, C_DAV = 1024, C_GQ = 1536, C_GK = 2048, C_GV = 2304, C_LX = 2560, C_LG = 3072, C_SZ = 3584, C_SX = 4096, C_SB = 4608, C_SC = 4864, C_DT = 5120;
constexpr int QLD = 1536, KLD = 768;
constexpr float NEPS = 1e-6f;
constexpr int NWAVES = 8;
#ifndef FIN_INPLACE
#define FIN_INPLACE 1
#endif
#ifndef SUBM
#define SUBM 7
#endif

constexpr size_t MiB = 1u << 20;
constexpr size_t WS_CTL = 0, CTL_ZERO_BYTES = 1 * MiB;
constexpr size_t WS_WIN = 2 * MiB, WS_WOUT = 82 * MiB, WS_WUP = 114 * MiB, WS_WDN = 290 * MiB, WS_WG = 378 * MiB;
constexpr size_t WS_MODP = 380 * MiB, WS_MODF = 383 * MiB, WS_ROPE = 384 * MiB;
constexpr size_t WS_X = 385 * MiB, WS_XN = 451 * MiB, WS_P = 484 * MiB, WS_QB = 567 * MiB, WS_KB = 592 * MiB, WS_O = 605 * MiB;
constexpr size_t WS_DT = 655 * MiB, WS_ACUM = 656 * MiB, WS_HF = 657 * MiB, WS_PF = 674 * MiB, WS_HB = 691 * MiB, WS_PB = 708 * MiB, WS_LSUM = 725 * MiB;
constexpr size_t WS_YD = 727 * MiB, WS_XC = 744 * MiB, WS_ST = 749 * MiB, WS_SIN = 782 * MiB, WS_CHA = 799 * MiB;
constexpr size_t WS_YCAT = 800 * MiB, WS_GU = 833 * MiB, WS_H = 1015 * MiB, WS_OP1 = 1106 * MiB, WS_ML = 1156 * MiB, WS_YD2 = 1158 * MiB, WS_PART = 1175 * MiB, WS_GBND = 1197 * MiB, WS_UBND = 1200 * MiB, WS_END = 1202 * MiB;
static_assert(WS_WIN + 4ull * NP * DM * 2 <= WS_WOUT && WS_WOUT + 4ull * DM * DM * 2 <= WS_WUP && WS_WUP + 4ull * 2 * DFF * DM * 2 <= WS_WDN && WS_WDN + 4ull * DM * DFF * 2 <= WS_WG, "weights map");
static_assert(WS_X + (size_t)TA * DM * 4 <= WS_XN && WS_XN + (size_t)TA * DM * 2 <= WS_P && WS_P + (size_t)TA * NP * 2 <= WS_QB && WS_QB + (size_t)TA * QLD * 2 <= WS_KB && WS_KB + (size_t)TA * KLD * 2 <= WS_O && WS_O + (size_t)TA * QLD * 4 <= WS_DT, "act map 1");
static_assert(WS_HF + (size_t)TA * 512 * 4 <= WS_PF && WS_LSUM + 132ull * 2 * 2 * 512 * 4 <= WS_YD && WS_YD + (size_t)TA * 512 * 4 <= WS_XC && WS_XC + (size_t)TA * 256 * 2 <= WS_ST && WS_ST + 66ull * 2 * 65536 * 4 <= WS_SIN && WS_SIN + 66ull * 2 * 65536 * 2 <= WS_CHA, "act map 2");
static_assert(WS_YCAT + (size_t)TA * DM * 2 <= WS_GU && WS_GU + (size_t)TA * 2 * DFF * 2 <= WS_H && WS_H + (size_t)TA * DFF * 2 <= WS_END, "act map 3");
constexpr int CW_BAR = 4096;

constexpr int PH_LDS = 147456;
constexpr int MISC_OFF = PH_LDS;
constexpr int LDS_BYTES = PH_LDS + 1024;
static_assert(WMAP_OFF == MISC_OFF + 512 && WMAP_OFF + 256 <= LDS_BYTES, "wave map inside the LDS control area");

#define LAS __attribute__((address_space(3)))
#define LDS_WAIT() asm volatile("s_waitcnt lgkmcnt(0)" ::: "memory")
#define VM_WAIT() asm volatile("s_waitcnt vmcnt(0)" ::: "memory")
#define RLX_AGENT __ATOMIC_RELAXED, __HIP_MEMORY_SCOPE_AGENT

__device__ __forceinline__ unsigned f2bf(float f) { unsigned u = __builtin_bit_cast(unsigned, f); return (u + 0x7fffu + ((u >> 16) & 1u)) >> 16; }
__device__ __forceinline__ unsigned pk2(float lo, float hi) { unsigned r; asm volatile("v_cvt_pk_bf16_f32 %0, %1, %2" : "=v"(r) : "v"(lo), "v"(hi)); return r; }
__device__ __forceinline__ float bflo(unsigned w) { return __uint_as_float(w << 16); }
__device__ __forceinline__ float bfhi(unsigned w) { return __uint_as_float(w & 0xffff0000u); }
__device__ __forceinline__ float bf1(bf16_t b) { return __uint_as_float(((unsigned)b) << 16); }
__device__ __forceinline__ void unpack8(const v4u w, float (&x)[8]) { x[0] = bflo(w.x); x[1] = bfhi(w.x); x[2] = bflo(w.y); x[3] = bfhi(w.y); x[4] = bflo(w.z); x[5] = bfhi(w.z); x[6] = bflo(w.w); x[7] = bfhi(w.w); }
__device__ __forceinline__ v4u pack8(const float (&x)[8]) { v4u w; w.x = pk2(x[0], x[1]); w.y = pk2(x[2], x[3]); w.z = pk2(x[4], x[5]); w.w = pk2(x[6], x[7]); return w; }
__device__ __forceinline__ float wave_sum(float v) {
#pragma unroll
    for (int o = 1; o < 64; o <<= 1) v += shx(v, o);
    return v;
}
__device__ __forceinline__ float siluf(float x) { return x / (1.f + __expf(-x)); }
__device__ __forceinline__ float sigmf(float x) { return 1.f / (1.f + __expf(-x)); }
__device__ __forceinline__ float softplusf(float x) { return fmaxf(x, 0.f) + log1pf(__expf(-fabsf(x))); }
__device__ __forceinline__ float gelu_tanh(float x) { const float u = 0.7978845608028654f * (x + 0.044715f * x * x * x); return 0.5f * x * (1.f + tanhf(u)); }
#define MFMA16(a, b, c) __builtin_amdgcn_mfma_f32_16x16x32_bf16((a), (b), (c), 0, 0, 0)

struct Fr { LAS unsigned char* lds; char* ldsg; int tid, lane, wave, G, bid, vcu; };
__device__ __forceinline__ Fr fr_refresh(const Fr& F0) { Fr F = F0; F.tid = tid_opaque(); F.lane = F.tid & 63; F.wave = __builtin_amdgcn_readfirstlane(F.tid >> 6);
    asm volatile("" : "+s"(F.bid), "+s"(F.vcu), "+s"(F.G)); return F; }

struct Args { const float* in[30]; float* out; unsigned char* ws; int s_lo, s_hi; };
constexpr int TBL_OFF = PH_LDS + 256;
struct PArgs { LAS unsigned long long* tbl;
    __device__ __forceinline__ unsigned long long get(int k) const { const unsigned long long v = tbl[k];
        const unsigned lo = __builtin_amdgcn_readfirstlane((unsigned)v), hi = __builtin_amdgcn_readfirstlane((unsigned)(v >> 32)); return ((unsigned long long)hi << 32) | lo; }
    __device__ __forceinline__ const float* inp(int k) const { return (const float*)(const GAS float*)get(k); }
    __device__ __forceinline__ float* outp() const { return (float*)(GAS float*)get(30); }
    __device__ __forceinline__ unsigned char* wsp() const { return (unsigned char*)(GAS unsigned char*)get(31); }
};


#define XB_TMO      128
#define XB_XCNT(j)  (256  + 64 * (j))
#define XB_XSUB(j)  (1280 + 64 * (j))
#define XB_XGEN(j)  (2304 + 64 * (j))
#define XB_TOP      3328
#define XB_TOPGEN   3392
#define XCD_BAR_WORDS 3456
#define XB_SPIN_CAP (1u << 18)

__device__ __forceinline__ unsigned xb_ld(unsigned* p)              { return __hip_atomic_load(p, __ATOMIC_RELAXED, __HIP_MEMORY_SCOPE_AGENT); }
__device__ __forceinline__ unsigned xb_add(unsigned* p, unsigned v) { return __hip_atomic_fetch_add(p, v, __ATOMIC_RELAXED, __HIP_MEMORY_SCOPE_AGENT); }
__device__ __forceinline__ unsigned xb_xcc_id() { return (unsigned)__builtin_amdgcn_s_getreg((3 << 11) | 20) & 0xFu; }
#define XB_SPIN(cond, bar) do { unsigned _sp = 0; while (cond) { __builtin_amdgcn_s_sleep(1); \
    if ((++_sp & 255u) == 0u) { if (xb_ld(&(bar)[XB_TMO])) break; if (_sp > XB_SPIN_CAP) { atomicAdd(&(bar)[XB_TMO], 1u); break; } } } } while (0)

struct XcdBarrier {
    unsigned* bar; unsigned x;
    volatile LAS unsigned* st;
};

__device__ __forceinline__ XcdBarrier xcd_barrier_post(unsigned* bar, volatile LAS unsigned* st) {
    XcdBarrier b; b.bar = bar; b.x = xb_xcc_id(); b.st = st;
    if (tid_opaque() == 0) (void)xb_add(&bar[XB_XCNT(b.x)], 1u);
    return b;
}
__device__ __forceinline__ void xcd_barrier_complete(unsigned* bar, unsigned x, unsigned& nloc, unsigned& nx) {
    const unsigned G = gridDim.x * gridDim.y * gridDim.z;
    unsigned sum, cnt, mine, sp = 0u;
    for (;;) {
        sum = 0u; cnt = 0u; mine = 0u;
#pragma unroll
        for (unsigned j = 0; j < 16; ++j) { const unsigned c = xb_ld(&bar[XB_XCNT(j)]); sum += c; cnt += (c > 0u) ? 1u : 0u; mine = (j == x) ? c : mine; }
        if (sum == G) break;
        __builtin_amdgcn_s_sleep(1);
        if ((++sp & 255u) == 0u) { if (xb_ld(&bar[XB_TMO])) break; if (sp > XB_SPIN_CAP) { atomicAdd(&bar[XB_TMO], 1u); break; } }
    }
    nloc = mine > 0u ? mine : 1u; nx = cnt > 0u ? cnt : 1u;
}

__device__ __forceinline__ void xcd_barrier(const XcdBarrier& b) {
    asm volatile("s_waitcnt vmcnt(0)" ::: "memory");
    __syncthreads();
    if (tid_opaque() == 0) {
        unsigned* bar = b.bar;
        __builtin_amdgcn_s_waitcnt(0);
        unsigned nloc = b.st[0], nx = b.st[1];
        if (nloc == 0u) { xcd_barrier_complete(bar, b.x, nloc, nx); b.st[0] = nloc; b.st[1] = nx; }
        const unsigned old = xb_add(&bar[XB_XSUB(b.x)], 1u);
        const unsigned gen = old / nloc;
        if (old + 1u == (gen + 1u) * nloc) {
            __builtin_amdgcn_fence(__ATOMIC_RELEASE, "agent");
            asm volatile("s_waitcnt vmcnt(0)" ::: "memory");
            const unsigned og = xb_add(&bar[XB_TOP], 1u);
            const unsigned tg = og / nx;
            if (og + 1u == (tg + 1u) * nx) xb_add(&bar[XB_TOPGEN], 1u);
            else XB_SPIN(xb_ld(&bar[XB_TOPGEN]) == tg, bar);
            __builtin_amdgcn_fence(__ATOMIC_ACQUIRE, "agent");
            xb_add(&bar[XB_XGEN(b.x)], 1u);
            asm volatile("s_waitcnt vmcnt(0)" ::: "memory");
        } else {
            XB_SPIN(xb_ld(&bar[XB_XGEN(b.x)]) == gen, bar);
            __builtin_amdgcn_fence(__ATOMIC_ACQUIRE, "agent");
            asm volatile("s_waitcnt vmcnt(0)" ::: "memory");
        }
    }
    __syncthreads();
}

constexpr int TR_SCR = 64 * 65 * 4;
template <bool ILV = false>
__device__ __forceinline__ void tr_item(const float* W, int ldW, int Nuse, bf16_t* WT, int K, LAS float* scr, int item, int lane) {
    const int nblk = Nuse / 64, kb = item / nblk, nb = item % nblk, k0 = 64 * kb, n0 = 64 * nb;
    const int sn0 = ILV ? ((n0 & 128) ? Nuse / 2 : 0) + (n0 >> 8) * 128 + (n0 & 127) : n0;
    float tv[64];
    const float* wp = W + (size_t)k0 * ldW + sn0 + lane;
#pragma unroll
    for (int i = 0; i < 64; ++i) tv[i] = wp[(size_t)i * ldW];
#pragma unroll
    for (int i = 0; i < 64; ++i) scr[i * 65 + lane] = tv[i];
    LDS_WAIT(); asm volatile("" ::: "memory");
    const int c = lane & 7;
#pragma unroll
    for (int j = 0; j < 8; ++j) { const int n = (lane >> 3) + 8 * j; const LAS float* s = scr + (8 * c) * 65 + n;
        v4u o; o.x = pk2(s[0 * 65], s[1 * 65]); o.y = pk2(s[2 * 65], s[3 * 65]); o.z = pk2(s[4 * 65], s[5 * 65]); o.w = pk2(s[6 * 65], s[7 * 65]);
        *(v4u*)(WT + (size_t)(n0 + n) * K + k0 + 8 * c) = o; }
    LDS_WAIT(); asm volatile("" ::: "memory");
}
__device__ __forceinline__ void sincos_small(float x, float& s, float& c) {
    const float q = rintf(x * 0.6366197723675814f); const int n = (int)q;
    float r = fmaf(q, -1.5703125f, x); r = fmaf(q, -4.837512969970703125e-4f, r); r = fmaf(q, -7.54978995489188216e-8f, r);
    const float z = r * r;
    const float sp = r + r * z * (-1.6666654611e-1f + z * (8.3321608736e-3f + z * (-1.9515295891e-4f)));
    const float cp = 1.f - 0.5f * z + z * z * (4.166664568298827e-2f + z * (-1.388731625493765e-3f + z * 2.443315711809948e-5f));
    switch (n & 3) { case 0: s = sp; c = cp; break; case 1: s = cp; c = -sp; break; case 2: s = -sp; c = -cp; break; default: s = -cp; c = sp; break; }
}
constexpr int I_IN = 32 * 80, I_OUT = 32 * 32, I_UP = 32 * 176, I_DN = 88 * 32, I_WG = 16 * 4, I_L = I_IN + I_OUT + I_UP + I_DN + I_WG;
__device__ __forceinline__ void conv_item(const PArgs& A, unsigned char* ws, int L, int r, LAS float* scr, int lane) {
    if (r < I_IN) { tr_item(A.inp(8) + (size_t)L * DM * NIN, NIN, NP, (bf16_t*)(ws + WS_WIN) + (size_t)L * NP * DM, DM, scr, r, lane); return; } r -= I_IN;
    if (r < I_OUT) { tr_item(A.inp(9) + (size_t)L * DM * DM, DM, DM, (bf16_t*)(ws + WS_WOUT) + (size_t)L * DM * DM, DM, scr, r, lane); return; } r -= I_OUT;
    if (r < I_UP) { tr_item<true>(A.inp(25) + (size_t)L * DM * 2 * DFF, 2 * DFF, 2 * DFF, (bf16_t*)(ws + WS_WUP) + (size_t)L * 2 * DFF * DM, DM, scr, r, lane); return; } r -= I_UP;
    if (r < I_DN) { tr_item(A.inp(28) + (size_t)L * DFF * DM, DM, DM, (bf16_t*)(ws + WS_WDN) + (size_t)L * DM * DFF, DFF, scr, r, lane); return; } r -= I_DN;
    { const int mi = r / 4; tr_item(A.inp(16) + (size_t)(L * 16 + mi) * 16384, 128, 128, (bf16_t*)(ws + WS_WG) + (size_t)(L * 16 + mi) * 16384, 128, scr, r % 4, lane); }
}
constexpr int BG_Q1 = 4, BG_Q2 = 4;
__device__ __forceinline__ void bg_convert(const Fr& F0, const PArgs& A, int Ln, int lo, int hi, int rank, int per) {
    const Fr F = fr_refresh(F0); unsigned char* ws = A.wsp();
    LAS float* scr = (LAS float*)(F.lds + F.wave * TR_SCR);
    const int b = lo + rank * per, e = min(b + per, hi);
    for (int it = b; it < e; ++it) conv_item(A, ws, Ln, it, scr, F.lane);
    __syncthreads();
}
__device__ __forceinline__ void ph_prologue(const Fr& F0, const PArgs& A) {
    const Fr F = fr_refresh(F0);
    unsigned char* ws = A.wsp();
    const int gw = F.bid * NWAVES + F.wave, NGW = F.G * NWAVES;
    LAS float* scr = (LAS float*)(F.lds + F.wave * TR_SCR);
    for (int it = gw; it < I_L; it += NGW) conv_item(A, ws, 0, it, scr, F.lane);
    float* modp = (float*)(ws + WS_MODP);
    for (int it = gw; it < DEPTH * 48 * 8; it += NGW) {
        const int L = it / 384, r = it % 384, nb = r / 8, ks = r % 8, k0 = ks * 256;
        f32x4 c0 = *(const f32x4*)(A.inp(1) + k0 + 4 * F.lane), c1 = *(const f32x4*)(A.inp(3) + k0 + 4 * F.lane);
#pragma unroll
        for (int i = 0; i < 4; ++i) { c0[i] = siluf(c0[i]); c1[i] = siluf(c1[i]); }
        f32x4 a0 = {0.f, 0.f, 0.f, 0.f}, a1 = {0.f, 0.f, 0.f, 0.f};
        const float* wp = A.inp(4) + ((size_t)(L * DM + k0)) * (6 * DM) + nb * 256 + 4 * F.lane;
#pragma unroll 2
        for (int q = 0; q < 64; ++q) {
#pragma unroll
            for (int i = 0; i < 4; ++i) {
                const float s0 = __uint_as_float(__builtin_amdgcn_readlane(__float_as_uint(c0[i]), q)), s1 = __uint_as_float(__builtin_amdgcn_readlane(__float_as_uint(c1[i]), q));
                const f32x4 w = *(const f32x4*)(wp + (size_t)(4 * q + i) * (6 * DM));
                a0 += s0 * w; a1 += s1 * w; }
        }
        *(f32x4*)(modp + ((size_t)((L * 8 + ks) * 2 + 0)) * (6 * DM) + nb * 256 + 4 * F.lane) = a0;
        *(f32x4*)(modp + ((size_t)((L * 8 + ks) * 2 + 1)) * (6 * DM) + nb * 256 + 4 * F.lane) = a1;
    }
    { const int gt = F.bid * 512 + F.tid, NT = F.G * 512; f32x4* X4 = (f32x4*)(ws + WS_X);
      const f32x4* c4 = (const f32x4*)A.inp(2); const f32x4* x4 = (const f32x4*)A.inp(0);
      constexpr int NC4 = TC * DM / 4, NA4 = TA * DM / 4;
      for (int i = gt; i < NA4; i += NT) X4[i] = (i < NC4) ? c4[i] : x4[i - NC4]; }
    { const int gt = F.bid * 512 + F.tid; if (gt < 128 * 48) { const int pos = gt / 48, f = gt % 48;
        const float fr = (f < 16) ? powf(10000.f, -(float)f / 16.f) : powf(10000.f, -(float)(f - 16) / 32.f);
        float s, c; sincos_small((float)pos * fr, s, c); ((f32x2*)(ws + WS_ROPE))[gt] = (f32x2){c, s}; } }
}
__device__ __forceinline__ void ph_modf(const Fr& F0, const PArgs& A) {
    const Fr F = fr_refresh(F0);
    const float* modp = (const float*)(A.wsp() + WS_MODP); float* modf = (float*)(A.wsp() + WS_MODF);
    for (int i = F.bid * 512 + F.tid; i < DEPTH * 2 * 6 * DM; i += F.G * 512) {
        const int L = i / (2 * 6 * DM), r = i % (2 * 6 * DM), cd = r / (6 * DM), n = r % (6 * DM);
        float s = A.inp(5)[L * 6 * DM + n];
#pragma unroll
        for (int ks = 0; ks < 8; ++ks) s += modp[((size_t)((L * 8 + ks) * 2 + cd)) * (6 * DM) + n];
        modf[i] = s; }
}

template <bool DTP>
__device__ __forceinline__ void ph_norm(const Fr& F0, float* X, bf16_t* XN, const float* nw, const float* mod_lat, const float* mod_ctx, int sh_off, int sc_off,
                                        const float* win_layer, const float* dt_bias, float* DT, const float* part, int nsl, const float* gate_ctx) {
    const Fr F = fr_refresh(F0);
    LAS float* AL = (LAS float*)F.lds; LAS float* BL = AL + DM; LAS float* WDT = BL + DM;
    for (int k = F.tid; k < DM; k += 512) { AL[k] = nw[k] * (1.f + mod_lat[sc_off + k]); BL[k] = mod_lat[sh_off + k]; }
    if (DTP) for (int idx = F.tid; idx < DM * 16; idx += 512) { const int k = idx >> 4, j = idx & 15; WDT[j * DM + k] = win_layer[(size_t)k * NIN + C_DT + j]; }
    __syncthreads();
    const int gw = F.bid * NWAVES + F.wave, NGW = F.G * NWAVES, lane = F.lane;
    for (int row = gw; row < TA; row += NGW) {
        const f32x4* xr = (const f32x4*)(X + (size_t)row * DM) + lane;
        f32x4 v[8]; float ss = 0.f;
        const bool isctx = row < TC;
#pragma unroll
        for (int j = 0; j < 8; ++j) v[j] = xr[64 * j];
        if (isctx && nsl > 0) {
            f32x4* xw = (f32x4*)(X + (size_t)row * DM) + lane;
#pragma unroll
            for (int hf = 0; hf < 2; ++hf) { f32x4 acc4[4];
#pragma unroll
                for (int j = 0; j < 4; ++j) acc4[j] = (f32x4){0.f, 0.f, 0.f, 0.f};
                for (int s = 0; s < nsl; ++s) { const f32x4* pr = (const f32x4*)(part + ((size_t)s * TC + row) * DM) + lane + 256 * hf; f32x4 t[4];
#pragma unroll
                    for (int j = 0; j < 4; ++j) t[j] = pr[64 * j];
#pragma unroll
                    for (int j = 0; j < 4; ++j) acc4[j] += t[j]; }
#pragma unroll
                for (int j = 0; j < 4; ++j) { v[4 * hf + j] += *(const f32x4*)(gate_ctx + 4 * lane + 256 * (4 * hf + j)) * acc4[j]; xw[64 * (4 * hf + j)] = v[4 * hf + j]; } } }
#pragma unroll
        for (int j = 0; j < 8; ++j) ss += (v[j].x * v[j].x + v[j].y * v[j].y) + (v[j].z * v[j].z + v[j].w * v[j].w);
        const float rs = 1.0f / sqrtf(wave_sum(ss) * (1.f / DM) + NEPS);
        v2u* o8 = (v2u*)(XN + (size_t)row * DM) + lane;
#pragma unroll
        for (int j = 0; j < 8; ++j) { const int k = 4 * lane + 256 * j; f32x4 a4, b4;
            if (isctx) { const f32x4 w4 = *(const f32x4*)(nw + k), s4 = *(const f32x4*)(mod_ctx + sc_off + k); a4 = w4 * (1.f + s4); b4 = *(const f32x4*)(mod_ctx + sh_off + k); }
            else { a4 = *(const LAS f32x4*)(AL + k); b4 = *(const LAS f32x4*)(BL + k); }
            v[j] = v[j] * rs * a4 + b4;
            v2u o; o.x = pk2(v[j].x, v[j].y); o.y = pk2(v[j].z, v[j].w); o8[64 * j] = o; }
        if (DTP) {
            float acc[16];
#pragma unroll
            for (int jj = 0; jj < 16; ++jj) acc[jj] = 0.f;
            const LAS float* W0 = WDT + 4 * lane; const LAS float* W1 = W0 + 8 * DM; asm volatile("" : "+v"(W1));
#pragma unroll
            for (int j = 0; j < 8; ++j)
#pragma unroll
                for (int jj = 0; jj < 16; ++jj) { const f32x4 w4 = *(const LAS f32x4*)((jj < 8 ? W0 : W1) + (jj & 7) * DM + 256 * j);
                    acc[jj] += (v[j].x * w4.x + v[j].y * w4.y) + (v[j].z * w4.z + v[j].w * w4.w); }
            float r8[8], r4[4], r2[2], r1;
#pragma unroll
            for (int i = 0; i < 8; ++i) { const bool up = (lane & 32) != 0; const float keep = up ? acc[i + 8] : acc[i], send = up ? acc[i] : acc[i + 8]; r8[i] = keep + shx(send, 32); }
#pragma unroll
            for (int i = 0; i < 4; ++i) { const bool up = (lane & 16) != 0; const float keep = up ? r8[i + 4] : r8[i], send = up ? r8[i] : r8[i + 4]; r4[i] = keep + shx(send, 16); }
#pragma unroll
            for (int i = 0; i < 2; ++i) { const bool up = (lane & 8) != 0; const float keep = up ? r4[i + 2] : r4[i], send = up ? r4[i] : r4[i + 2]; r2[i] = keep + shx(send, 8); }
            { const bool up = (lane & 4) != 0; const float keep = up ? r2[1] : r2[0], send = up ? r2[0] : r2[1]; r1 = keep + shx(send, 4); }
            r1 += shx(r1, 2); r1 += shx(r1, 1);
            const int col = ((lane >> 5) & 1) * 8 + ((lane >> 4) & 1) * 4 + ((lane >> 3) & 1) * 2 + ((lane >> 2) & 1);
            if ((lane & 3) == 0) DT[(size_t)row * 16 + col] = softplusf(r1 + dt_bias[col]);
        }
    }
    __syncthreads();
}

__device__ __forceinline__ void prep_rope_unit(const Fr& F, const PArgs& A, int L, int unit) {
    unsigned char* ws = A.wsp(); const int lane = F.lane;
    const bf16_t* P = (const bf16_t*)(ws + WS_P); bf16_t* QB = (bf16_t*)(ws + WS_QB); bf16_t* KB = (bf16_t*)(ws + WS_KB);
    const f32x2* RT = (const f32x2*)(ws + WS_ROPE);
    const float* qn = A.inp(12) + L * 128; const float* kn = A.inp(13) + L * 128;
    for (int i = 0; i < 8; ++i) {
        const int r = unit * 64 + F.wave * 8 + i; const bool lat = r >= TC; const int t = r - TC, prow = lat ? (t >> 6) : 0, pcol = lat ? (t & 63) : 0;
        const bf16_t* pr = P + (size_t)r * NP;
        {   const int hd = lane >> 3, o = (lane & 7) * 8, axis = o >> 5, p = o & 31, fi = p & 15; const bool first = p < 16; const int pos = axis ? pcol : prow;
            float xq[8], xk[8], yq[8], yk[8];
            unpack8(*(const v4u*)(pr + C_DAQ + 8 * lane), xq); unpack8(*(const v4u*)(pr + C_DAK + 8 * lane), xk);
#pragma unroll
            for (int e = 0; e < 8; ++e) { const float pq = shx(xq[e], 2), pk = shx(xk[e], 2);
                f32x2 cs = lat ? RT[pos * 48 + fi + e] : (f32x2){1.f, 0.f};
                const float sg = first ? -cs.y : cs.y;
                yq[e] = (xq[e] * cs.x + pq * sg) * 1.41421356237f; yk[e] = xk[e] * cs.x + pk * sg; }
            bf16_t* qd = QB + (size_t)r * QLD + hd * 128; const int m = hd & 1;
            *(v4u*)(qd + m * 64 + o) = pack8(yq); { unsigned zz = 0u; asm volatile("" : "+v"(zz)); *(v4u*)(qd + (1 - m) * 64 + o) = (v4u){zz, zz, zz, zz}; }
            *(v4u*)(KB + (size_t)r * KLD + 8 * lane) = pack8(yk);
        }
        {   const int o = (lane & 15) * 8, axis = o >> 6, p = o & 63, fi = p & 31; const bool first = p < 32; const int pos = axis ? pcol : prow;
            const int lk = lane & 31;
            float xq[8], xk[8], yq[8], yk[8];
            unpack8(*(const v4u*)(pr + C_GQ + 8 * lane), xq); unpack8(*(const v4u*)(pr + C_GK + 8 * lk), xk);
            float sq = 0.f, sk = 0.f;
#pragma unroll
            for (int e = 0; e < 8; ++e) { sq += xq[e] * xq[e]; sk += xk[e] * xk[e]; }
#pragma unroll
            for (int s = 1; s < 16; s <<= 1) { sq += shx(sq, s); sk += shx(sk, s); }
            const float rq = 1.0f / sqrtf(sq * (1.f / 128.f) + NEPS), rk = 1.0f / sqrtf(sk * (1.f / 128.f) + NEPS);
#pragma unroll
            for (int e = 0; e < 8; ++e) { xq[e] = xq[e] * rq * qn[o + e]; xk[e] = xk[e] * rk * kn[o + e]; }
#pragma unroll
            for (int e = 0; e < 8; ++e) { const float pq = shx(xq[e], 4), pk = shx(xk[e], 4);
                f32x2 cs = lat ? RT[pos * 48 + 16 + fi + e] : (f32x2){1.f, 0.f};
                const float sg = first ? -cs.y : cs.y;
                yq[e] = xq[e] * cs.x + pq * sg; yk[e] = xk[e] * cs.x + pk * sg; }
            *(v4u*)(QB + (size_t)r * QLD + 1024 + 8 * lane) = pack8(yq);
            if (lane < 32) *(v4u*)(KB + (size_t)r * KLD + 512 + 8 * lane) = pack8(yk);
        }
    }
}

__device__ __forceinline__ void prep_lru_unit(const Fr& F, const PArgs& A, int L, int unit) {
    unsigned char* ws = A.wsp(); const int lane = F.lane, tid = F.tid, c64 = unit >> 2, blk = unit & 3, r0 = c64 * 64;
    const int seg_lo = (r0 < TC) ? 0 : TC, seg_hi = (r0 < TC) ? TC : TA;
    const bf16_t* P = (const bf16_t*)(ws + WS_P);
    LAS float* XCv = (LAS float*)F.lds;
    LAS f32x2* AU = (LAS f32x2*)(F.lds + 64 * 132 * 4);
    const float* cw = A.inp(14) + (size_t)L * 4 * 512 + blk * 128; const float* cb = A.inp(15) + L * 512 + blk * 128;
    {
        const int tk = tid >> 3, c0 = (tid & 7) * 16, r = r0 + tk;
        float acc[16];
#pragma unroll
        for (int e = 0; e < 16; ++e) acc[e] = cb[c0 + e];
#pragma unroll
        for (int k = 0; k < 4; ++k) { const int rr = r + k - 2; if (rr >= seg_lo && rr < seg_hi) {
            const bf16_t* src = P + (size_t)rr * NP + C_LX + blk * 128 + c0; float x0[8], x1[8]; unpack8(*(const v4u*)src, x0); unpack8(*(const v4u*)(src + 8), x1);
#pragma unroll
            for (int e = 0; e < 8; ++e) { acc[e] += cw[k * 512 + c0 + e] * x0[e]; acc[8 + e] += cw[k * 512 + c0 + 8 + e] * x1[e]; } } }
#pragma unroll
        for (int e = 0; e < 16; e += 4) *(LAS f32x4*)(XCv + tk * 132 + c0 + e) = (f32x4){acc[e], acc[e + 1], acc[e + 2], acc[e + 3]};
    }
    __syncthreads();
    const int w = F.wave, fr = lane & 15, fq = lane >> 4;
    bf16x8 af[4][4];
#pragma unroll
    for (int m = 0; m < 4; ++m)
#pragma unroll
        for (int ks = 0; ks < 4; ++ks) { const LAS float* s = XCv + (16 * m + fr) * 132 + 32 * ks + 8 * fq; const f32x4 a = *(const LAS f32x4*)s, b = *(const LAS f32x4*)(s + 4);
            v4u wv; wv.x = pk2(a.x, a.y); wv.y = pk2(a.z, a.w); wv.z = pk2(b.x, b.y); wv.w = pk2(b.z, b.w); af[m][ks] = __builtin_bit_cast(bf16x8, wv); }
    const bf16_t* WG = (const bf16_t*)(ws + WS_WG) + (size_t)L * 16 * 16384;
    const int ch = 16 * w + fr, chg = blk * 128 + ch;
    for (int dir = 0; dir < 2; ++dir) {
        const bf16_t* Wr = WG + (size_t)((dir * 2 + 0) * 4 + blk) * 16384 + (size_t)ch * 128 + 8 * fq;
        const bf16_t* Wi = WG + (size_t)((dir * 2 + 1) * 4 + blk) * 16384 + (size_t)ch * 128 + 8 * fq;
        f32x4 ar[4], ai[4];
#pragma unroll
        for (int m = 0; m < 4; ++m) { ar[m] = (f32x4){0.f, 0.f, 0.f, 0.f}; ai[m] = (f32x4){0.f, 0.f, 0.f, 0.f}; }
#pragma unroll
        for (int ks = 0; ks < 4; ++ks) { const bf16x8 br = *(const bf16x8*)(Wr + 32 * ks), bi = *(const bf16x8*)(Wi + 32 * ks);
#pragma unroll
            for (int m = 0; m < 4; ++m) { ar[m] = MFMA16(af[m][ks], br, ar[m]); ai[m] = MFMA16(af[m][ks], bi, ai[m]); } }
        const float bgr = A.inp(17)[((size_t)(L * 2 + dir) * 2 + 0) * 512 + chg], bgi = A.inp(17)[((size_t)(L * 2 + dir) * 2 + 1) * 512 + chg];
        const float lam = A.inp(18)[(size_t)(L * 2 + dir) * 512 + chg];
        const float lsg = fminf(lam, 0.f) - log1pf(__expf(-fabsf(lam)));
#pragma unroll
        for (int m = 0; m < 4; ++m)
#pragma unroll
            for (int rg = 0; rg < 4; ++rg) { const int tok = 16 * m + 4 * fq + rg;
                const float rr = sigmf(ar[m][rg] + bgr), ii = sigmf(ai[m][rg] + bgi);
                const float log_a = 8.0f * rr * lsg, a = __expf(log_a), beta = sqrtf(fmaxf(-expm1f(2.f * log_a), 0.f));
                AU[tok * 128 + ch] = (f32x2){a, beta * (ii * XCv[tok * 132 + ch])}; }
        __syncthreads();
        if (tid < 128) {
            float* Hb = (float*)(ws + (dir ? WS_HB : WS_HF)); float* Pb = (float*)(ws + (dir ? WS_PB : WS_PF));
            float h = 0.f, pr = 1.f;
            for (int s = 0; s < 64; ++s) { const int tok = dir ? 63 - s : s; const f32x2 au = AU[tok * 128 + tid];
                h = au.x * h + au.y; pr *= au.x;
                const size_t o = (size_t)(r0 + tok) * 512 + blk * 128 + tid; Hb[o] = h; Pb[o] = pr; }
            float* LS = (float*)(ws + WS_LSUM) + ((size_t)(dir * 132 + c64) * 2) * 512 + blk * 128 + tid;
            LS[0] = pr; LS[512] = h;
        }
        __syncthreads();
    }
}

constexpr int SLD = 136, XLD = 72;
typedef short v4i16_t __attribute__((ext_vector_type(4)));
__device__ __forceinline__ bf16x8 lds_tr_frag(const LAS bf16_t* img, int ld, int r0, int c0, int fr, int fq) {
    const LAS bf16_t* p = img + (r0 + 8 * fq + (fr >> 2)) * ld + c0 + 4 * (fr & 3);
    const v4i16_t lo = __builtin_amdgcn_ds_read_tr16_b64_v4i16((LAS v4i16_t*)p), hi = __builtin_amdgcn_ds_read_tr16_b64_v4i16((LAS v4i16_t*)(p + 4 * ld));
    return (bf16x8){lo[0], lo[1], lo[2], lo[3], hi[0], hi[1], hi[2], hi[3]};
}
__device__ __forceinline__ void prep_ssd_unit(const Fr& F, const PArgs& A, int L, int unit) {
    unsigned char* ws = A.wsp(); const int lane = F.lane, tid = F.tid, c = unit >> 3, h = unit & 7, g = h >> 2, r0 = c * 128;
    const int seg_lo = (r0 < TC) ? 0 : TC, seg_hi = (r0 < TC) ? TC : TA;
    const bf16_t* P = (const bf16_t*)(ws + WS_P);
    LAS bf16_t* CG = (LAS bf16_t*)F.lds;
    LAS bf16_t* BG = CG + 128 * SLD;
    LAS bf16_t* XS = BG + 128 * SLD;
    LAS float* VEC = (LAS float*)(XS + 128 * XLD);
    LAS float* AFv = VEC, *ABv = VEC + 128, *DTF = VEC + 256, *DTB = VEC + 384, *WFv = VEC + 512, *WBv = VEC + 640;
    if (F.wave == 0) {
        const float* DT = (const float*)(ws + WS_DT);
        const float a_f = -__expf(A.inp(22)[(L * 2 + 0) * 8 + h]), a_b = -__expf(A.inp(22)[(L * 2 + 1) * 8 + h]);
        const int t0 = 2 * lane;
        const float df0 = DT[(size_t)(r0 + t0) * 16 + h], df1 = DT[(size_t)(r0 + t0 + 1) * 16 + h], db0 = DT[(size_t)(r0 + t0) * 16 + 8 + h], db1 = DT[(size_t)(r0 + t0 + 1) * 16 + 8 + h];
        const float xf0 = df0 * a_f, xf1 = df1 * a_f, xb0 = db0 * a_b, xb1 = db1 * a_b;
        float sf = xf0 + xf1, sb = xb0 + xb1;
#pragma unroll
        for (int o = 1; o < 64; o <<= 1) { const float uf = shup(sf, o), ub = shdn(sb, o); if (lane >= o) sf += uf; if (lane + o < 64) sb += ub; }
        const float af1 = sf, af0 = sf - xf1;
        const float ab0 = sb, ab1 = sb - xb0;
        const float aft = shidx(sf, 63), abt = shidx(sb, 0);
        AFv[t0] = af0; AFv[t0 + 1] = af1; ABv[t0] = ab0; ABv[t0 + 1] = ab1; DTF[t0] = df0; DTF[t0 + 1] = df1; DTB[t0] = db0; DTB[t0 + 1] = db1;
        WFv[t0] = __expf(aft - af0) * df0; WFv[t0 + 1] = __expf(aft - af1) * df1; WBv[t0] = __expf(abt - ab0) * db0; WBv[t0 + 1] = __expf(abt - ab1) * db1;
        float* AC = (float*)(ws + WS_ACUM);
        AC[(size_t)(r0 + t0) * 16 + h] = af0; AC[(size_t)(r0 + t0 + 1) * 16 + h] = af1; AC[(size_t)(r0 + t0) * 16 + 8 + h] = ab0; AC[(size_t)(r0 + t0 + 1) * 16 + 8 + h] = ab1;
        if (lane == 0) { float* CH = (float*)(ws + WS_CHA); CH[(c * 2 + 0) * 8 + h] = aft; CH[(c * 2 + 1) * 8 + h] = abt; }
    }
    const float* cw = A.inp(19) + (size_t)L * 4 * 1024; const float* cb = A.inp(20) + (size_t)L * 1024;
    bf16_t* XCg = (bf16_t*)(ws + WS_XC);
    for (int id = tid; id < 640; id += 512) {
        const int cgp = id % 40, t0 = (id / 40) * 8;
        int ccol, off, ld; LAS bf16_t* img;
        if (cgp < 8) { off = cgp * 8; ccol = 64 * h + off; img = XS; ld = XLD; } else if (cgp < 24) { off = (cgp - 8) * 8; ccol = 512 + 128 * g + off; img = BG; ld = SLD; } else { off = (cgp - 24) * 8; ccol = 768 + 128 * g + off; img = CG; ld = SLD; }
        const bool cglob = (cgp >= 24) && ((h & 3) == 0);
        float wk[4][8], bb[8];
#pragma unroll
        for (int e = 0; e < 8; ++e) { bb[e] = cb[ccol + e];
#pragma unroll
            for (int k = 0; k < 4; ++k) wk[k][e] = cw[k * 1024 + ccol + e]; }
        const bf16_t* src = P + (size_t)(r0 + t0) * NP + C_SX + ccol;
        float wn[4][8];
#pragma unroll
        for (int j = 0; j < 3; ++j) { const int rr = r0 + t0 + j - 2;
            if (rr >= seg_lo && rr < seg_hi) unpack8(*(const v4u*)(src + (ptrdiff_t)(j - 2) * NP), wn[j]);
            else {
#pragma unroll
                for (int e = 0; e < 8; ++e) wn[j][e] = 0.f; } }
#pragma unroll
        for (int t = 0; t < 8; ++t) { const int rr = r0 + t0 + t + 1;
            if (rr < seg_hi) unpack8(*(const v4u*)(src + (ptrdiff_t)(t + 1) * NP), wn[3]);
            else {
#pragma unroll
                for (int e = 0; e < 8; ++e) wn[3][e] = 0.f; }
            float o8[8];
#pragma unroll
            for (int e = 0; e < 8; ++e) { const float sv = bb[e] + wk[0][e] * wn[0][e] + wk[1][e] * wn[1][e] + wk[2][e] * wn[2][e] + wk[3][e] * wn[3][e];
                o8[e] = siluf(sv); wn[0][e] = wn[1][e]; wn[1][e] = wn[2][e]; wn[2][e] = wn[3][e]; }
            const v4u pv = pack8(o8);
            *(LAS v4u*)(img + (t0 + t) * ld + off) = pv;
            if (cglob) *(v4u*)(XCg + (size_t)(r0 + t0 + t) * 256 + 128 * g + off) = pv; }
    }
    __syncthreads();
    const int w = F.wave, fr = lane & 15, fq = lane >> 4;
    {
        bf16x8 ca[4];
#pragma unroll
        for (int ks = 0; ks < 4; ++ks) ca[ks] = *(const LAS bf16x8*)(CG + (16 * w + fr) * SLD + 32 * ks + 8 * fq);
        float afl[4], abl[4];
#pragma unroll
        for (int rg = 0; rg < 4; ++rg) { afl[rg] = AFv[16 * w + 4 * fq + rg]; abl[rg] = ABv[16 * w + 4 * fq + rg]; }
#pragma unroll 2
        for (int st = 0; st < 8; ++st) { f32x4 gacc = {0.f, 0.f, 0.f, 0.f};
#pragma unroll
            for (int ks = 0; ks < 4; ++ks) { const bf16x8 bfr = *(const LAS bf16x8*)(BG + (16 * st + fr) * SLD + 32 * ks + 8 * fq); gacc = MFMA16(ca[ks], bfr, gacc); }
            const int s = 16 * st + fr; const float afs = AFv[s], abs_ = ABv[s], dfs = DTF[s], dbs = DTB[s];
#pragma unroll
            for (int rg = 0; rg < 4; ++rg) { const int l = 16 * w + 4 * fq + rg; float f;
                if (s < l) f = __expf(afl[rg] - afs) * dfs; else if (s > l) f = __expf(abl[rg] - abs_) * dbs; else f = dfs + dbs;
                CG[l * SLD + s] = (bf16_t)f2bf(gacc[rg] * f); } }
    }
    __syncthreads();
    {
        bf16x8 ma[4];
#pragma unroll
        for (int ks = 0; ks < 4; ++ks) ma[ks] = *(const LAS bf16x8*)(CG + (16 * w + fr) * SLD + 32 * ks + 8 * fq);
        const float Dh = A.inp(23)[L * 8 + h]; float* YD = (float*)(ws + WS_YD);
#pragma unroll
        for (int pt = 0; pt < 4; ++pt) { f32x4 acc = {0.f, 0.f, 0.f, 0.f};
#pragma unroll
            for (int ks = 0; ks < 4; ++ks) { const bf16x8 xb = lds_tr_frag(XS, XLD, 32 * ks, 16 * pt, fr, fq); acc = MFMA16(ma[ks], xb, acc); }
#pragma unroll
            for (int rg = 0; rg < 4; ++rg) { const int l = 16 * w + 4 * fq + rg, p = 16 * pt + fr;
                YD[(size_t)(r0 + l) * 512 + 64 * h + p] = acc[rg] + Dh * bf1(XS[l * XLD + p]); } }
    }
    {
        const int d = w >> 2, ptile = w & 3; const LAS float* Wv = d ? WBv : WFv;
        bf16x8 xa[4];
#pragma unroll
        for (int ks = 0; ks < 4; ++ks) { float x8[8]; unpack8(__builtin_bit_cast(v4u, lds_tr_frag(XS, XLD, 32 * ks, 16 * ptile, fr, fq)), x8);
            const f32x4 w0 = *(const LAS f32x4*)(Wv + 32 * ks + 8 * fq), w1 = *(const LAS f32x4*)(Wv + 32 * ks + 8 * fq + 4);
            x8[0] *= w0.x; x8[1] *= w0.y; x8[2] *= w0.z; x8[3] *= w0.w; x8[4] *= w1.x; x8[5] *= w1.y; x8[6] *= w1.z; x8[7] *= w1.w;
            xa[ks] = __builtin_bit_cast(bf16x8, pack8(x8)); }
        float* ST = (float*)(ws + WS_ST) + ((size_t)((c * 2 + d) * 8 + h)) * 8192;
#pragma unroll 2
        for (int nt = 0; nt < 8; ++nt) { f32x4 acc = {0.f, 0.f, 0.f, 0.f};
#pragma unroll
            for (int ks = 0; ks < 4; ++ks) { const bf16x8 bb2 = lds_tr_frag(BG, SLD, 32 * ks, 16 * nt, fr, fq); acc = MFMA16(xa[ks], bb2, acc); }
#pragma unroll
            for (int rg = 0; rg < 4; ++rg) ST[(16 * ptile + 4 * fq + rg) * 128 + 16 * nt + fr] = acc[rg]; }
    }
    __syncthreads();
}

__device__ __forceinline__ void ph_prep(const Fr& F0, const PArgs& A, int L) {
    const Fr F = fr_refresh(F0);
    constexpr int N_SSD = 66 * 8, N_LRU = 132 * 4, N_ROPE = TA / 64;
    for (int u = F.vcu; u < N_SSD + N_LRU + N_ROPE; u += F.G) {
        if (u < N_SSD) { if (SUBM & 1) prep_ssd_unit(F, A, L, u); }
        else if (u < N_SSD + N_LRU) { if (SUBM & 2) prep_lru_unit(F, A, L, u - N_SSD); }
        else { if (SUBM & 4) prep_rope_unit(F, A, L, u - N_SSD - N_LRU); }
    }
}

__device__ __forceinline__ void ph_state_scan(const Fr& F0, const PArgs& A) {
    const Fr F = fr_refresh(F0);
    unsigned char* ws = A.wsp(); const float* ST = (const float*)(ws + WS_ST); bf16_t* SIN = (bf16_t*)(ws + WS_SIN); unsigned* CH = (unsigned*)(ws + WS_CHA);
    for (int e = F.bid * 512 + F.tid; e < 2 * 65536; e += F.G * 512) {
        const int d = e >> 16, rest = e & 65535, h = rest >> 13;
        float run = 0.f;
#pragma unroll 6
        for (int i = 0; i < 66; ++i) { const int c = d ? (i == 0 ? 1 : (i == 1 ? 0 : 67 - i)) : i; const size_t o = ((size_t)(c * 2 + d) << 16) + rest;
            SIN[o] = (bf16_t)f2bf(run);
            const float dec = __expf(__uint_as_float(__hip_atomic_load(CH + (c * 2 + d) * 8 + h, RLX_AGENT)));
            run = dec * run + ST[o]; }
    }
}
__device__ __forceinline__ void ph_attn(const Fr& F0, const PArgs& A, int L) {
    const Fr F = fr_refresh(F0);
    unsigned char* ws = A.wsp();
    const att::bf16* QB = (const att::bf16*)(ws + WS_QB); const att::bf16* KB = (const att::bf16*)(ws + WS_KB); const att::bf16* P = (const att::bf16*)(ws + WS_P);
    const int nunits = 768 + (L < DEPTH - 1 ? 12 : 0);
    for (int u = F.vcu; u < nunits; u += F.G) {
        int vh, row0, seq, kh, k0;
        if (u < 768) { const int v = (u < 512) ? u : u - 512; vh = ((u < 512) ? 0 : 8) + (v >> 6); row0 = TC + 256 * ((v & 63) >> 1); kh = v & 1; seq = TA / 2; k0 = kh * (TA / 2); }
        else { vh = u - 768; row0 = 0; seq = TC; kh = 0; k0 = 0; }
        const int kvh = vh >> 1;
        const att::bf16* Vh = P + (size_t)k0 * NP + (kvh < 4 ? C_DAV + 128 * kvh : C_GV + 128 * (kvh - 4));
        const att::bf16* Kh = KB + (size_t)k0 * KLD + kvh * 128;
        float* Ob = (float*)(ws + (kh ? WS_OP1 : WS_O)) + (size_t)row0 * QLD + vh * 128;
        float* ML = (float*)(ws + WS_ML) + ((size_t)(kh * TA + row0) * 12 + vh) * 2;
        if (vh < 8) { const int m = vh & 1; att::attn_dense_body<att::bf16, 4, true>(QB + (size_t)row0 * QLD + vh * 128 + 64 * m, Kh, Vh, Ob, seq, F.ldsg, 128 * m, ML); }
        else att::attn_dense_body<att::bf16, 8, true>(QB + (size_t)row0 * QLD + vh * 128, Kh, Vh, Ob, seq, F.ldsg, 0, ML);
        __syncthreads();
    }
}

__device__ __forceinline__ void attn_combine8(const float* O0, const float* O1, const float* ML0, const float* ML1, size_t r, int vh, int c0, bool split, float (&o8)[8]) {
    const f32x4 a0 = *(const f32x4*)(O0 + r * QLD + vh * 128 + c0), a1 = *(const f32x4*)(O0 + r * QLD + vh * 128 + c0 + 4);
    const f32x2 mla = *(const f32x2*)(ML0 + (r * 12 + vh) * 2);
    if (split) {
        const f32x4 b0 = *(const f32x4*)(O1 + r * QLD + vh * 128 + c0), b1 = *(const f32x4*)(O1 + r * QLD + vh * 128 + c0 + 4);
        const f32x2 mlb = *(const f32x2*)(ML1 + (r * 12 + vh) * 2);
        const float m = fmaxf(mla.x, mlb.x), wa = __builtin_amdgcn_exp2f(mla.x - m), wb = __builtin_amdgcn_exp2f(mlb.x - m), inv = 1.0f / (mla.y * wa + mlb.y * wb), ka = wa * inv, kb = wb * inv;
        o8[0] = a0.x * ka + b0.x * kb; o8[1] = a0.y * ka + b0.y * kb; o8[2] = a0.z * ka + b0.z * kb; o8[3] = a0.w * ka + b0.w * kb;
        o8[4] = a1.x * ka + b1.x * kb; o8[5] = a1.y * ka + b1.y * kb; o8[6] = a1.z * ka + b1.z * kb; o8[7] = a1.w * ka + b1.w * kb;
    } else { const float inv = 1.0f / mla.y;
        o8[0] = a0.x * inv; o8[1] = a0.y * inv; o8[2] = a0.z * inv; o8[3] = a0.w * inv; o8[4] = a1.x * inv; o8[5] = a1.y * inv; o8[6] = a1.z * inv; o8[7] = a1.w * inv; }
}
__device__ __forceinline__ void fin_attn_unit(const Fr& F, const PArgs& A, int L, int unit, float lam, float lam_init) {
    unsigned char* ws = A.wsp(); const int lane = F.lane; bf16_t* Y = (bf16_t*)(ws + WS_YCAT);
    const float* O0 = (const float*)(ws + WS_O); const float* O1 = (const float*)(ws + WS_OP1); const float* ML0 = (const float*)(ws + WS_ML); const float* ML1 = ML0 + (size_t)TA * 24;
    const float* sub = A.inp(11) + L * 128;
    const bool split = unit >= TC / 64;
#pragma unroll 2
    for (int i = 0; i < 8; ++i) {
        const size_t r = (size_t)unit * 64 + F.wave * 8 + i;
        {   const int hh = lane >> 4, d0 = (lane & 15) * 8;
            float x1[8], x2[8], o8[8];
            attn_combine8(O0, O1, ML0, ML1, r, 2 * hh, d0, split, x1); attn_combine8(O0, O1, ML0, ML1, r, 2 * hh + 1, d0, split, x2);
            float ss = 0.f;
#pragma unroll
            for (int e = 0; e < 8; ++e) { o8[e] = x1[e] - lam * x2[e]; ss += o8[e] * o8[e]; }
#pragma unroll
            for (int s = 1; s < 16; s <<= 1) ss += shx(ss, s);
            const float rs = (1.0f / sqrtf(ss * (1.f / 128.f) + NEPS)) * (1.f - lam_init);
#pragma unroll
            for (int e = 0; e < 8; ++e) o8[e] = o8[e] * rs * sub[d0 + e];
            *(v4u*)(Y + r * DM + 128 * hh + d0) = pack8(o8); }
        {   float o8[8]; attn_combine8(O0, O1, ML0, ML1, r, 8 + (lane >> 4), (lane & 15) * 8, split, o8);
            *(v4u*)(Y + r * DM + 512 + 8 * lane) = pack8(o8); }
    }
}
__device__ __forceinline__ void fin_lru_unit(const Fr& F, const PArgs& A, int c64) {
    unsigned char* ws = A.wsp(); const int ch = F.tid;
    const float* LS = (const float*)(ws + WS_LSUM);
    float cf = 0.f, cbk = 0.f;
    for (int j0 = 0; j0 < c64; j0 += 8) { float a[8], hh[8];
#pragma unroll
        for (int k = 0; k < 8; ++k) { const int j = min(j0 + k, c64 - 1); a[k] = LS[((size_t)(0 * 132 + j) * 2) * 512 + ch]; hh[k] = LS[((size_t)(0 * 132 + j) * 2 + 1) * 512 + ch]; }
#pragma unroll
        for (int k = 0; k < 8; ++k) { const bool ok = j0 + k < c64; cf = ok ? a[k] * cf + hh[k] : cf; } }
    const int pos = (c64 < 4) ? 3 - c64 : 135 - c64;
    for (int i0 = 0; i0 < pos; i0 += 8) { float a[8], hh[8];
#pragma unroll
        for (int k = 0; k < 8; ++k) { const int i = min(i0 + k, pos - 1), j = (i < 4) ? 3 - i : 135 - i; a[k] = LS[((size_t)(1 * 132 + j) * 2) * 512 + ch]; hh[k] = LS[((size_t)(1 * 132 + j) * 2 + 1) * 512 + ch]; }
#pragma unroll
        for (int k = 0; k < 8; ++k) { const bool ok = i0 + k < pos; cbk = ok ? a[k] * cbk + hh[k] : cbk; } }
    const float* HF = (const float*)(ws + WS_HF); const float* PF = (const float*)(ws + WS_PF); const float* HB = (const float*)(ws + WS_HB); const float* PB = (const float*)(ws + WS_PB);
    const bf16_t* P = (const bf16_t*)(ws + WS_P); bf16_t* Y = (bf16_t*)(ws + WS_YCAT);
#pragma unroll 8
    for (int t = 0; t < 64; ++t) { const size_t r = (size_t)c64 * 64 + t, o = r * 512 + ch;
        const float hf = HF[o] + PF[o] * cf, hb = HB[o] + PB[o] * cbk, gg = bf1(P[r * NP + C_LG + ch]);
        Y[r * DM + 1024 + ch] = (bf16_t)f2bf((hf + hb) * gelu_tanh(gg)); }
}
constexpr int CLD = 264;
__device__ __forceinline__ void fin_ssd_unit(const Fr& F, const PArgs& A, int L, int c) {
    unsigned char* ws = A.wsp(); const int lane = F.lane, tid = F.tid, w = F.wave, fr = lane & 15, fq = lane >> 4, r0 = c * 128;
    LAS bf16_t* CI = (LAS bf16_t*)F.lds;
    LAS float* EF = (LAS float*)(CI + 128 * CLD);
    LAS bf16_t* SB = (LAS bf16_t*)(EF + 16 * 128);
    const bf16_t* XCg = (const bf16_t*)(ws + WS_XC); const float* AC = (const float*)(ws + WS_ACUM);
    const bf16_t* SIN = (const bf16_t*)(ws + WS_SIN) + (size_t)c * 2 * 65536; const float* YD = (const float*)(ws + WS_YD); const bf16_t* P = (const bf16_t*)(ws + WS_P);
    v4u sreg[4];
#define FIN_SLOAD(h) do { _Pragma("unroll") for (int i = 0; i < 4; ++i) { const int q = tid + 512 * i; sreg[i] = *(const v4u*)(SIN + ((size_t)(q >> 10) * 8 + (h)) * 8192 + (q & 1023) * 8); } } while (0)
#define FIN_SWRITE(buf) do { _Pragma("unroll") for (int i = 0; i < 4; ++i) { const int q = tid + 512 * i; *(LAS v4u*)(SB + (((buf) * 2 + (q >> 10)) * 64 + ((q >> 4) & 63)) * SLD + (q & 15) * 8) = sreg[i]; } } while (0)
    FIN_SLOAD(0);
    for (int id = tid; id < 128 * 32; id += 512) { const int t = id >> 5, q = id & 31; *(LAS v4u*)(CI + t * CLD + 8 * q) = *(const v4u*)(XCg + (size_t)(r0 + t) * 256 + 8 * q); }
    for (int id = tid; id < 128 * 16; id += 512) { const int t = id >> 4, j = id & 15; EF[j * 128 + t] = __expf(AC[(size_t)(r0 + t) * 16 + j]); }
    float ss[4] = {0.f, 0.f, 0.f, 0.f};
    const size_t rbase = (size_t)(r0 + 16 * w + 4 * fq);
    float* YDw = (float*)(ws + (FIN_INPLACE ? WS_YD : WS_YD2));
    const float* ydp[4]; const bf16_t* zp[4]; bf16_t* yp[4]; float* ywp[4];
#pragma unroll
    for (int rg = 0; rg < 4; ++rg) { ydp[rg] = YD + (rbase + rg) * 512 + fr; ywp[rg] = YDw + (rbase + rg) * 512 + fr; zp[rg] = P + (rbase + rg) * NP + C_SZ + fr; yp[rg] = (bf16_t*)(ws + WS_YCAT) + (rbase + rg) * DM + 1536 + fr; }
#pragma unroll 1
    for (int h = 0; h < 8; ++h) { const int g = h >> 2, buf = h & 1;
        FIN_SWRITE(buf);
        __syncthreads();
        if (h < 7) FIN_SLOAD(h + 1);
        float ydv[4][4]; bf16_t zv[4][4];
#pragma unroll
        for (int pt = 0; pt < 4; ++pt)
#pragma unroll
            for (int rg = 0; rg < 4; ++rg) { ydv[pt][rg] = ydp[rg][64 * h + 16 * pt]; zv[pt][rg] = zp[rg][64 * h + 16 * pt]; }
        bf16x8 ca[4];
#pragma unroll
        for (int ks = 0; ks < 4; ++ks) ca[ks] = *(const LAS bf16x8*)(CI + (16 * w + fr) * CLD + 128 * g + 32 * ks + 8 * fq);
        float ef[4], eb[4];
#pragma unroll
        for (int rg = 0; rg < 4; ++rg) { ef[rg] = EF[h * 128 + 16 * w + 4 * fq + rg]; eb[rg] = EF[(8 + h) * 128 + 16 * w + 4 * fq + rg]; }
        const LAS bf16_t* S0 = SB + ((buf * 2 + 0) * 64) * SLD; const LAS bf16_t* S1 = SB + ((buf * 2 + 1) * 64) * SLD;
#pragma unroll
        for (int pt = 0; pt < 4; ++pt) { f32x4 a0 = {0.f, 0.f, 0.f, 0.f}, a1 = {0.f, 0.f, 0.f, 0.f};
#pragma unroll
            for (int ks = 0; ks < 4; ++ks) { const bf16x8 b0 = *(const LAS bf16x8*)(S0 + (16 * pt + fr) * SLD + 32 * ks + 8 * fq), b1 = *(const LAS bf16x8*)(S1 + (16 * pt + fr) * SLD + 32 * ks + 8 * fq);
                a0 = MFMA16(ca[ks], b0, a0); a1 = MFMA16(ca[ks], b1, a1); }
#pragma unroll
            for (int rg = 0; rg < 4; ++rg) { float y = ydv[pt][rg] + ef[rg] * a0[rg] + eb[rg] * a1[rg]; y *= siluf(bf1(zv[pt][rg])); ywp[rg][64 * h + 16 * pt] = y; ss[rg] += y * y; } }
    }
#undef FIN_SLOAD
#undef FIN_SWRITE
    const float* nwp = A.inp(24) + L * 512 + fr;
#pragma unroll
    for (int rg = 0; rg < 4; ++rg) {
#pragma unroll
        for (int s = 1; s < 16; s <<= 1) ss[rg] += shx(ss[rg], s);
        ss[rg] = 1.0f / sqrtf(ss[rg] * (1.f / 512.f) + NEPS); }
#pragma unroll 1
    for (int c8 = 0; c8 < 4; ++c8) { float t[8][4]; float wv[8];
#pragma unroll
        for (int k = 0; k < 8; ++k) { wv[k] = nwp[16 * (8 * c8 + k)];
#pragma unroll
            for (int rg = 0; rg < 4; ++rg) t[k][rg] = ywp[rg][16 * (8 * c8 + k)]; }
#pragma unroll
        for (int k = 0; k < 8; ++k)
#pragma unroll
            for (int rg = 0; rg < 4; ++rg) yp[rg][16 * (8 * c8 + k)] = (bf16_t)f2bf(t[k][rg] * ss[rg] * wv[k]); }
    __syncthreads();
}
__device__ __forceinline__ void ph_finish(const Fr& F0, const PArgs& A, int L) {
    const Fr F = fr_refresh(F0);
    const float lam_init = 0.8f - 0.6f * expf(-0.3f * (float)L);
    const float* lv = A.inp(10) + L * 256;
    const float s1 = wave_sum(lv[F.lane] * lv[64 + F.lane]), s2 = wave_sum(lv[128 + F.lane] * lv[192 + F.lane]);
    const float lam = expf(s1) - expf(s2) + lam_init;
    const bool need_ctx = L < DEPTH - 1;
    constexpr int N_SSD = 66, N_LRU = 132, N_ATT = TA / 64;
    for (int u = F.vcu; u < N_SSD + N_LRU + N_ATT; u += F.G) {
        if (u < N_SSD) { if ((SUBM & 1) && (need_ctx || u >= 2)) fin_ssd_unit(F, A, L, u); }
        else if (u < N_SSD + N_LRU) { const int c64 = u - N_SSD; if ((SUBM & 2) && (need_ctx || c64 >= 4)) fin_lru_unit(F, A, c64); }
        else { const int un = u - N_SSD - N_LRU; if ((SUBM & 4) && (need_ctx || un >= 4)) fin_attn_unit(F, A, L, un, lam, lam_init); }
    }
}

__device__ __forceinline__ void ph_actfix(const Fr& F0, const PArgs& A, int L) {
    const Fr F = fr_refresh(F0);
    unsigned char* ws = A.wsp(); bf16_t* H = (bf16_t*)(ws + WS_H); const float* GB = (const float*)(ws + WS_GBND); const float* UB = (const float*)(ws + WS_UBND);
    const float* cw = A.inp(26) + (size_t)L * 3 * DFF; const float* cb = A.inp(27) + (size_t)L * DFF;
    constexpr int NCG = DFF / 4;
    for (int it = F.bid * 512 + F.tid; it < 62 * NCG; it += F.G * 512) {
        const int rr = it / NCG, c = (it % NCG) * 4, p = 1 + (rr >> 1), lower = rr & 1;
        const f32x4 w0 = *(const f32x4*)(cw + c), w1 = *(const f32x4*)(cw + DFF + c), w2 = *(const f32x4*)(cw + 2 * DFF + c), bb = *(const f32x4*)(cb + c);
        f32x4 gm, g0, gp, uu; size_t row;
        if (!lower) { gm = *(const f32x4*)(GB + ((size_t)p * 4 + 2) * DFF + c); g0 = *(const f32x4*)(GB + ((size_t)p * 4 + 3) * DFF + c); gp = *(const f32x4*)(GB + ((size_t)(p + 1) * 4 + 0) * DFF + c);
            uu = *(const f32x4*)(UB + ((size_t)p * 2 + 1) * DFF + c); row = (size_t)p * 256 + 255; }
        else { gm = *(const f32x4*)(GB + ((size_t)p * 4 + 3) * DFF + c); g0 = *(const f32x4*)(GB + ((size_t)(p + 1) * 4 + 0) * DFF + c); gp = *(const f32x4*)(GB + ((size_t)(p + 1) * 4 + 1) * DFF + c);
            uu = *(const f32x4*)(UB + ((size_t)(p + 1) * 2 + 0) * DFF + c); row = (size_t)(p + 1) * 256; }
        const f32x4 gs = bb + w0 * gm + w1 * g0 + w2 * gp;
        v2u o; o.x = pk2(siluf(gs[0]) * uu[0], siluf(gs[1]) * uu[1]); o.y = pk2(siluf(gs[2]) * uu[2], siluf(gs[3]) * uu[3]);
        *(v2u*)(H + row * DFF + c) = o; }
}

__device__ __forceinline__ void ph_final(const Fr& F0, const PArgs& A) {
    const Fr F = fr_refresh(F0);
    const float* X = (const float*)(A.wsp() + WS_X) + (size_t)TC * DM; const float* nw = A.inp(29);
    const int gw = F.bid * NWAVES + F.wave, NGW = F.G * NWAVES, lane = F.lane;
    for (int row = gw; row < TL; row += NGW) {
        const f32x4* xr = (const f32x4*)(X + (size_t)row * DM) + lane; f32x4* orow = (f32x4*)(A.outp() + (size_t)row * DM) + lane;
        f32x4 v[8]; float ss = 0.f;
#pragma unroll
        for (int j = 0; j < 8; ++j) { v[j] = xr[64 * j]; ss += (v[j].x * v[j].x + v[j].y * v[j].y) + (v[j].z * v[j].z + v[j].w * v[j].w); }
        const float rs = 1.0f / sqrtf(wave_sum(ss) * (1.f / DM) + NEPS);
#pragma unroll
        for (int j = 0; j < 8; ++j) { const f32x4 w4 = *(const f32x4*)(nw + 4 * lane + 256 * j); orow[64 * j] = v[j] * rs * w4; }
    }
}

constexpr int N_STEPS = 2 + 10 * DEPTH + 1;
#ifndef PH_MASK
#define PH_MASK 0xFFFF
#endif
#define PHE(b) ((PH_MASK >> (b)) & 1)
#ifndef DBL_MASK
#define DBL_MASK 0
#endif
#define NREP(b) (((DBL_MASK >> (b)) & 1) ? 2 : 1)
#ifndef SPLIT_OUT
#define SPLIT_OUT 8
#define SPLIT_DN 11
#endif
#ifndef MK_ONE_LAUNCH
#define MK_ONE_LAUNCH 1
#endif
__global__ void __launch_bounds__(NWAVES * 64, 2) mk_fwd(Args args) {
    extern __shared__ __attribute__((aligned(16))) unsigned char lds[];
    Fr F;
    F.lds = (LAS unsigned char*)lds; F.ldsg = (char*)lds;
    F.tid = 0; F.lane = 0; F.wave = 0;
    F.G = gridDim.x; F.bid = blockIdx.x; F.vcu = (F.G % 8 == 0) ? (F.bid % 8) * (F.G / 8) + F.bid / 8 : F.bid;
    volatile LAS unsigned* MISC = (volatile LAS unsigned*)(F.lds + MISC_OFF);
    for (int u = threadIdx.x; u < (LDS_BYTES - MISC_OFF) / 4; u += NWAVES * 64) ((LAS unsigned*)(F.lds + MISC_OFF))[u] = 0u;
    __syncthreads();
    if (threadIdx.x == 0) { LAS unsigned long long* tb = (LAS unsigned long long*)(F.lds + TBL_OFF);
#pragma unroll
        for (int i = 0; i < 30; ++i) tb[i] = (unsigned long long)args.in[i];
        tb[30] = (unsigned long long)args.out; tb[31] = (unsigned long long)args.ws; }
    if ((threadIdx.x & 63) == 0) { const unsigned h = (unsigned)__builtin_amdgcn_s_getreg((5 << 11) | 4) & 63u; ((LAS int*)(F.lds + WMAP_OFF))[h] = (int)(threadIdx.x >> 6); }
    __syncthreads();
    PArgs PA; PA.tbl = (LAS unsigned long long*)(F.lds + TBL_OFF);
    unsigned char* ws = args.ws;
    const int lo = args.s_lo, hi = args.s_hi;
    if (hi - lo > 1) (void)xcd_barrier_post((unsigned*)(ws + WS_CTL) + CW_BAR, MISC + 8);
#define IN(k) (lo <= (k) && (k) < hi)
#define SEAM(k) do { if (IN(k) && IN((k) + 1)) { XcdBarrier b2; b2.bar = (unsigned*)(PA.wsp() + WS_CTL) + CW_BAR; b2.x = xb_xcc_id(); b2.st = MISC + 8; xcd_barrier(b2); } } while (0)

    if (PHE(0) && IN(0)) for (int rep = 0; rep < NREP(0); ++rep) { ph_prologue(F, PA); } SEAM(0);
    if (PHE(1) && IN(1)) { ph_modf(F, PA); } SEAM(1);

    for (int L = 0; L < DEPTH; ++L) {
        const int s0 = 2 + 10 * L;
        { int z = 0; asm volatile("" : "+s"(z)); F.lds = (LAS unsigned char*)lds + z; F.ldsg = (char*)lds + z; PA.tbl = (LAS unsigned long long*)(F.lds + TBL_OFF); MISC = (volatile LAS unsigned*)(F.lds + MISC_OFF); }
        ws = PA.wsp();
        const float* modf = (const float*)(ws + WS_MODF); float* X = (float*)(ws + WS_X); bf16_t* XN = (bf16_t*)(ws + WS_XN);
        const float* mod_lat = modf + (size_t)(L * 2 + 0) * 6 * DM; const float* mod_ctx = modf + (size_t)(L * 2 + 1) * 6 * DM;
        const bool need_ctx = L < DEPTH - 1;
        const int rlo = need_ctx ? 0 : TC;
        if (PHE(2) && IN(s0 + 0)) for (int rep = 0; rep < NREP(2); ++rep) { ph_norm<true>(F, X, XN, PA.inp(6) + L * DM, mod_lat, mod_ctx, 0, DM, PA.inp(8) + (size_t)L * DM * NIN, PA.inp(21) + L * 16, (float*)(ws + WS_DT), (const float*)(ws + WS_PART), L > 0 ? SPLIT_DN : 0, modf + (size_t)((L > 0 ? L - 1 : 0) * 2 + 1) * 6 * DM + 5 * DM); }
        SEAM(s0 + 0);
        if (PHE(3) && IN(s0 + 1)) for (int rep = 0; rep < NREP(3); ++rep) {
            pg8::Gemm g{XN, (const bf16_t*)(ws + WS_WIN) + (size_t)L * NP * DM, TA, NP, DM, DM}; pg8::StaticOrder S; { const Fr Fg = fr_refresh(F); S.init(TA, NP, Fg.G, Fg.bid); }
            pg8::EpiBf16 E{(bf16_t*)(ws + WS_P), NP};
            pg8::gemm_phase<pg8::EpiBf16, pg8::StaticOrder, true, true>(F.lds, g, S, E);
            if (L < DEPTH - 1) { const Fr Fg = fr_refresh(F); const int rem = ((TA / 256) * (NP / 256)) % Fg.G;
                if (rem > 0 && Fg.bid >= rem) bg_convert(F, PA, L + 1, 0, BG_Q1 * (Fg.G - rem) * NWAVES, (Fg.bid - rem) * NWAVES + wave_now(), BG_Q1); } }
        SEAM(s0 + 1);
        if (PHE(4) && IN(s0 + 2)) for (int rep = 0; rep < NREP(4); ++rep) { ph_prep(F, PA, L); }
        SEAM(s0 + 2);
        if (PHE(5) && IN(s0 + 3)) for (int rep = 0; rep < NREP(5); ++rep) { ph_state_scan(F, PA); ph_attn(F, PA, L); }
        SEAM(s0 + 3);
        if (PHE(6) && IN(s0 + 4)) for (int rep = 0; rep < NREP(6); ++rep) { ph_finish(F, PA, L); }
        SEAM(s0 + 4);
        if (PHE(7) && IN(s0 + 5)) {
            { pg8::Gemm g{(const bf16_t*)(ws + WS_YCAT) + (size_t)TC * DM, (const bf16_t*)(ws + WS_WOUT) + (size_t)L * DM * DM, TL, DM, DM, DM}; pg8::StaticOrder S; { const Fr Fg = fr_refresh(F); S.init(TL, DM, Fg.G, Fg.bid); }
              pg8::EpiResid E{X + (size_t)TC * DM, DM, mod_lat + 2 * DM, mod_lat + 2 * DM, 0};
              pg8::gemm_phase<pg8::EpiResid, pg8::StaticOrder, true, true>(F.lds, g, S, E); }
            if (need_ctx) { pg8::Gemm g{(const bf16_t*)(ws + WS_YCAT), (const bf16_t*)(ws + WS_WOUT) + (size_t)L * DM * DM, TC, DM, DM / SPLIT_OUT, DM}; const Fr Fg = fr_refresh(F); pg8::SplitKOrder S{DM / 256, SPLIT_OUT, DM / SPLIT_OUT, Fg.G, Fg.bid, 0};
              pg8::EpiPart E{(float*)(ws + WS_PART), DM, DM / SPLIT_OUT, TC};
              pg8::gemm_phase<pg8::EpiPart, pg8::SplitKOrder, true, true>(F.lds, g, S, E); } }
        SEAM(s0 + 5);
        if (PHE(8) && IN(s0 + 6)) for (int rep = 0; rep < NREP(8); ++rep) { ph_norm<false>(F, X, XN, PA.inp(7) + L * DM, mod_lat, mod_ctx, 3 * DM, 4 * DM, nullptr, nullptr, nullptr, (const float*)(ws + WS_PART), need_ctx ? SPLIT_OUT : 0, mod_ctx + 2 * DM); }
        SEAM(s0 + 6);
        if (PHE(9) && IN(s0 + 7)) for (int rep = 0; rep < NREP(9); ++rep) {
            pg8::Gemm g{XN + (size_t)rlo * DM, (const bf16_t*)(ws + WS_WUP) + (size_t)L * 2 * DFF * DM, TA - rlo, 2 * DFF, DM, DM}; pg8::StaticOrder S; { const Fr Fg = fr_refresh(F); S.init(TA - rlo, 2 * DFF, Fg.G, Fg.bid); }
            pg8::EpiAct E{(bf16_t*)(ws + WS_H) + (size_t)rlo * DFF, DFF, PA.inp(26) + (size_t)L * 3 * DFF, PA.inp(27) + (size_t)L * DFF, (float*)(ws + WS_GBND), (float*)(ws + WS_UBND), rlo / 256, (PG8_LAS float*)(F.lds + 131072)};
            pg8::gemm_phase<pg8::EpiAct, pg8::StaticOrder, true, true>(F.lds, g, S, E);
            if (L < DEPTH - 1) { const Fr Fg = fr_refresh(F); const int rem = ((TA / 256) * (2 * DFF / 256)) % Fg.G, rem1 = ((TA / 256) * (NP / 256)) % Fg.G; const int lo = rem1 > 0 ? BG_Q1 * (Fg.G - rem1) * NWAVES : 0;
                if (rem > 0 && Fg.bid >= rem) bg_convert(F, PA, L + 1, lo, lo + BG_Q2 * (Fg.G - rem) * NWAVES, (Fg.bid - rem) * NWAVES + wave_now(), BG_Q2); } }
        SEAM(s0 + 7);
        if (PHE(10) && IN(s0 + 8)) for (int rep = 0; rep < NREP(10); ++rep) { ph_actfix(F, PA, L);
            if (L < DEPTH - 1) { const Fr Fg = fr_refresh(F); const int rem = ((TA / 256) * (2 * DFF / 256)) % Fg.G, rem1 = ((TA / 256) * (NP / 256)) % Fg.G;
                const int lo = (rem1 > 0 ? BG_Q1 * (Fg.G - rem1) * NWAVES : 0) + (rem > 0 ? BG_Q2 * (Fg.G - rem) * NWAVES : 0); const int per = (I_L - lo + Fg.G * NWAVES - 1) / (Fg.G * NWAVES);
                if (lo < I_L) bg_convert(F, PA, L + 1, lo, I_L, Fg.bid * NWAVES + wave_now(), per); } }
        SEAM(s0 + 8);
        if (PHE(11) && IN(s0 + 9)) {
            { pg8::Gemm g{(const bf16_t*)(ws + WS_H) + (size_t)TC * DFF, (const bf16_t*)(ws + WS_WDN) + (size_t)L * DM * DFF, TL, DM, DFF, DFF}; pg8::StaticOrder S; { const Fr Fg = fr_refresh(F); S.init(TL, DM, Fg.G, Fg.bid); }
              pg8::EpiResid E{X + (size_t)TC * DM, DM, mod_lat + 5 * DM, mod_lat + 5 * DM, 0};
              pg8::gemm_phase<pg8::EpiResid, pg8::StaticOrder, true, true>(F.lds, g, S, E); }
            if (need_ctx) { pg8::Gemm g{(const bf16_t*)(ws + WS_H), (const bf16_t*)(ws + WS_WDN) + (size_t)L * DM * DFF, TC, DM, DFF / SPLIT_DN, DFF}; const Fr Fg = fr_refresh(F); pg8::SplitKOrder S{DM / 256, SPLIT_DN, DFF / SPLIT_DN, Fg.G, Fg.bid, 0};
              pg8::EpiPart E{(float*)(ws + WS_PART), DM, DFF / SPLIT_DN, TC};
              pg8::gemm_phase<pg8::EpiPart, pg8::SplitKOrder, true, true>(F.lds, g, S, E); } }
        SEAM(s0 + 9);
    }
    if (PHE(12) && IN(N_STEPS - 1)) { ph_final(F, PA); }
#undef IN
#undef SEAM
}

extern "C" void kernel_launch(void* const* d_in, const int* in_sizes, int n_in, void* d_out, int out_size, void* d_ws, size_t ws_size, hipStream_t stream) {
    static int grid = 0;
    if (grid == 0) {
        if (n_in != 30 || out_size != TL * DM || ws_size < WS_END) { fprintf(stderr, "kernel_launch: unexpected shapes: n_in %d out %d ws %zu (need %zu)\n", n_in, out_size, ws_size, (size_t)WS_END); grid = -1; return; }
        int dev = 0, cus = 0, per_cu = 0;
        if (hipGetDevice(&dev) != hipSuccess || hipDeviceGetAttribute(&cus, hipDeviceAttributeMultiprocessorCount, dev) != hipSuccess) { fprintf(stderr, "kernel_launch: device query failed\n"); grid = -1; return; }
        if (hipFuncSetAttribute((const void*)mk_fwd, hipFuncAttributeMaxDynamicSharedMemorySize, LDS_BYTES) != hipSuccess) { fprintf(stderr, "kernel_launch: hipFuncSetAttribute(%d) failed\n", LDS_BYTES); grid = -1; return; }
        if (hipOccupancyMaxActiveBlocksPerMultiprocessor(&per_cu, (const void*)mk_fwd, NWAVES * 64, LDS_BYTES) != hipSuccess || per_cu < 1) { fprintf(stderr, "kernel_launch: occupancy query says %d blocks per CU\n", per_cu); }
        (void)hipGetLastError();
        grid = cus;
    }
    if (grid < 0) return;
    if (hipMemsetAsync((char*)d_ws + WS_CTL, 0, CTL_ZERO_BYTES, stream) != hipSuccess) { fprintf(stderr, "kernel_launch: memset failed\n"); return; }
    Args a{};
    for (int i = 0; i < 30; ++i) a.in[i] = (const float*)d_in[i];
    a.out = (float*)d_out; a.ws = (unsigned char*)d_ws;
#if MK_ONE_LAUNCH
    a.s_lo = 0; a.s_hi = N_STEPS;
    hipLaunchKernelGGL(mk_fwd, dim3(grid), dim3(NWAVES * 64), LDS_BYTES, stream, a);
#else
    for (int s = 0; s < N_STEPS; ++s) { a.s_lo = s; a.s_hi = s + 1; hipLaunchKernelGGL(mk_fwd, dim3(grid), dim3(NWAVES * 64), LDS_BYTES, stream, a); }
#endif
    const hipError_t le = hipPeekAtLastError();
    if (le != hipSuccess) fprintf(stderr, "kernel_launch: launch failed: %s\n", hipGetErrorName(le));
}
```

```cpp
#include <hip/hip_runtime.h>
#include <hip/hip_bf16.h>
#include <cstdio>
#include <cstdint>

constexpr int WMAP_OFF = 147456 + 512;
__device__ __forceinline__ int lane_now() { int l; asm volatile("v_mbcnt_lo_u32_b32 %0, -1, 0\n\tv_mbcnt_hi_u32_b32 %0, -1, %0" : "=v"(l)); return l; }
__device__ __forceinline__ int wave_now() { const unsigned h = (unsigned)__builtin_amdgcn_s_getreg((5 << 11) | 4) & 63u;
    return __builtin_amdgcn_readfirstlane(((volatile __attribute__((address_space(3))) int*)(unsigned long)WMAP_OFF)[h]); }
__device__ __forceinline__ int tid_opaque() { int t = wave_now() * 64 + lane_now(); asm volatile("" : "+v"(t)); return t; }
__device__ __forceinline__ float shx(float v, int o) { return __builtin_bit_cast(float, __builtin_amdgcn_ds_bpermute((lane_now() ^ o) << 2, __builtin_bit_cast(int, v))); }
__device__ __forceinline__ float shup(float v, int o) { return __builtin_bit_cast(float, __builtin_amdgcn_ds_bpermute(((lane_now() - o) & 63) << 2, __builtin_bit_cast(int, v))); }
__device__ __forceinline__ float shdn(float v, int o) { return __builtin_bit_cast(float, __builtin_amdgcn_ds_bpermute(((lane_now() + o) & 63) << 2, __builtin_bit_cast(int, v))); }
__device__ __forceinline__ float shidx(float v, int src) { return __builtin_bit_cast(float, __builtin_amdgcn_ds_bpermute(src << 2, __builtin_bit_cast(int, v))); }

namespace pg8 {
#define PG8_LAS __attribute__((address_space(3)))
typedef unsigned short bf16_t;
typedef short bf16x8 __attribute__((ext_vector_type(8)));
typedef float f32x4 __attribute__((ext_vector_type(4)));
typedef unsigned u32x4 __attribute__((ext_vector_type(4)));
constexpr int BM = 256, BK = 64, HALF = 128, HTB = HALF * BK * 2  , STAGE_BYTES = 8 * HTB, NXCD = 8, WGM = 8;

__host__ __device__ __forceinline__ int lds_byte(int r, int c) { const int st = (r >> 4) * 2 + (c >> 5), rr = r & 15, cc = c & 31, ob = rr * 64 + cc * 2; return st * 1024 + (ob ^ (((ob >> 9) & 1) << 5)); }
__host__ __device__ __forceinline__ void stage_rc(int b, int& R, int& C) { const int st = b / 1024, sb = b % 1024, swz = sb ^ (((sb >> 9) & 1) << 5); R = (st >> 1) * 16 + swz / 64; C = (st & 1) * 32 + (swz % 64) / 2; }
__host__ __device__ __forceinline__ int perm32(int rho) { const int n = rho >> 4, i = rho & 15; return 8 * (i >> 2) + 4 * n + (i & 3); }

struct Unit { int pm, pn, k0; };
struct Gemm { const bf16_t* A; const bf16_t* Bt; int M, N, K, ld; };

struct StaticOrder {
    int nM, nN, nwg, G, c;
    __host__ __device__ __forceinline__ void init(int M, int N, int G_, int c_) { nM = M / BM; nN = N / BM; nwg = nM * nN; G = G_; c = c_; }
    __host__ __device__ __forceinline__ bool next(int i, Unit& u) const {
        const long L = (long)i * G + c; if (L >= nwg) return false;
        int wgid = (int)L; { const int q = nwg / NXCD, r = nwg % NXCD, xcd = wgid % NXCD, off = wgid / NXCD; wgid = (xcd < r ? xcd * (q + 1) : r * (q + 1) + (xcd - r) * q) + off; }
        const int nig = WGM * nN, gid = wgid / nig, fm = gid * WGM, gsz = (nM - fm) < WGM ? (nM - fm) : WGM;
        u.pm = fm + ((wgid % nig) % gsz); u.pn = (wgid % nig) / gsz; u.k0 = 0; return true;
    }
    __device__ __forceinline__ void a_ready(const Unit&) const {}
    __device__ __forceinline__ void done(const Unit&) const {}
};

struct SplitKOrder {
    int nN, S, kslice, G, c, pm;
    __host__ __device__ __forceinline__ bool next(int i, Unit& u) const { const long L = (long)i * G + c; if (L >= (long)nN * S) return false; u.pm = pm; u.pn = (int)L / S; u.k0 = ((int)L % S) * kslice; return true; }
    __device__ __forceinline__ void a_ready(const Unit&) const {}
    __device__ __forceinline__ void done(const Unit&) const {}
};

__device__ __forceinline__ unsigned cvt_pk_bf16(float lo, float hi) { unsigned r; asm volatile("v_cvt_pk_bf16_f32 %0, %1, %2" : "=v"(r) : "v"(lo), "v"(hi)); return r; }

struct EpiBf16 {
    static constexpr bool PERM = true, AFTER_DRAIN = false;
    bf16_t* O; int ldc;
    __device__ __forceinline__ void operator()(const f32x4 (&acc)[2][2][4][2], const Unit& u, int wr, int wc, int fr, int fq) const {
        const int row0 = u.pm * BM + wr * 64 + fr; const int col0 = u.pn * BM + wc * 32 + 8 * fq;
#pragma unroll
        for (int ai = 0; ai < 2; ++ai)
#pragma unroll
            for (int m = 0; m < 4; ++m) { bf16_t* rowp = O + (size_t)(row0 + ai * HALF + m * 16) * ldc + col0;
#pragma unroll
                for (int bj = 0; bj < 2; ++bj) { const f32x4 v0 = acc[ai][bj][m][0], v1 = acc[ai][bj][m][1];
                    u32x4 w; w.x = cvt_pk_bf16(v0[0], v0[1]); w.y = cvt_pk_bf16(v0[2], v0[3]); w.z = cvt_pk_bf16(v1[0], v1[1]); w.w = cvt_pk_bf16(v1[2], v1[3]);
                    *(u32x4*)(rowp + bj * HALF) = w; } }
    }
};
struct EpiResid {
    static constexpr bool PERM = false, AFTER_DRAIN = false;
    float* X; int ldc; const float* gate_ctx; const float* gate_lat; int ctx_panels;
    __device__ __forceinline__ void operator()(const f32x4 (&acc)[2][2][4][2], const Unit& u, int wr, int wc, int fr, int fq) const {
        const int row0 = u.pm * BM + wr * 64 + fr, col0 = u.pn * BM + wc * 32 + 4 * fq;
        const float* gate = (u.pm < ctx_panels) ? gate_ctx : gate_lat;
        f32x4 gv[2][2];
#pragma unroll
        for (int bj = 0; bj < 2; ++bj)
#pragma unroll
            for (int n = 0; n < 2; ++n) gv[bj][n] = *(const f32x4*)(gate + col0 + bj * HALF + n * 16);
#pragma unroll
        for (int ai = 0; ai < 2; ++ai)
#pragma unroll
            for (int m = 0; m < 4; ++m) { float* rowp = X + (size_t)(row0 + ai * HALF + m * 16) * ldc + col0;
#pragma unroll
                for (int bj = 0; bj < 2; ++bj)
#pragma unroll
                    for (int n = 0; n < 2; ++n) { float* p = rowp + bj * HALF + n * 16; const f32x4 xv = *(const f32x4*)p; *(f32x4*)p = xv + gv[bj][n] * acc[ai][bj][m][n]; }
                asm volatile("" ::: "memory"); }
    }
};
struct EpiPart {
    static constexpr bool PERM = false, AFTER_DRAIN = false;
    float* part; int ldc, kslice, rows;
    __device__ __forceinline__ void operator()(const f32x4 (&acc)[2][2][4][2], const Unit& u, int wr, int wc, int fr, int fq) const {
        const int row0 = u.pm * BM + wr * 64 + fr, col0 = u.pn * BM + wc * 32 + 4 * fq;
        float* base = part + (size_t)(u.k0 / kslice) * rows * ldc;
#pragma unroll
        for (int ai = 0; ai < 2; ++ai)
#pragma unroll
            for (int m = 0; m < 4; ++m) { float* rowp = base + (size_t)(row0 + ai * HALF + m * 16) * ldc + col0;
#pragma unroll
                for (int bj = 0; bj < 2; ++bj)
#pragma unroll
                    for (int n = 0; n < 2; ++n) *(f32x4*)(rowp + bj * HALF + n * 16) = acc[ai][bj][m][n]; }
    }
};
struct EpiAct {
    static constexpr bool PERM = false, AFTER_DRAIN = false;
    bf16_t* H; int ldh; const float* cw; const float* cb; float* gbnd; float* ubnd; int panel_off; PG8_LAS float* xr;
    template <int CTRL> static __device__ __forceinline__ f32x4 rot4(const f32x4 v) { f32x4 r;
#pragma unroll
        for (int j = 0; j < 4; ++j) { const float t = v[j]; r[j] = __int_as_float(__builtin_amdgcn_update_dpp(0, __float_as_int(t), CTRL, 0xF, 0xF, false)); }
        return r; }
    __device__ __forceinline__ void operator()(const f32x4 (&acc)[2][2][4][2], const Unit& u, int wr, int wc, int fr, int fq) const {
        const int pabs = u.pm + panel_off, ch0 = u.pn * HALF + wc * 32 + 4 * fq, NCH = ldh;
#pragma unroll
        for (int ai = 0; ai < 2; ++ai)
#pragma unroll
            for (int n = 0; n < 2; ++n) { const int xo = (ai * 2 + wr) * 256 + wc * 32 + n * 16 + 4 * fq;
                if (fr == 0) *(PG8_LAS f32x4*)(xr + xo) = acc[ai][0][0][n];
                if (fr == 15) *(PG8_LAS f32x4*)(xr + xo + 128) = acc[ai][0][3][n]; }
#pragma unroll
        for (int n = 0; n < 2; ++n) { const int c = ch0 + 16 * n;
            if (wr == 0 && fr < 2) *(f32x4*)(gbnd + ((size_t)pabs * 4 + fr) * NCH + c) = acc[0][0][0][n];
            if (wr == 0 && fr == 0) *(f32x4*)(ubnd + ((size_t)pabs * 2 + 0) * NCH + c) = acc[0][1][0][n];
            if (wr == 1 && fr >= 14) *(f32x4*)(gbnd + ((size_t)pabs * 4 + 2 + (fr - 14)) * NCH + c) = acc[1][0][3][n];
            if (wr == 1 && fr == 15) *(f32x4*)(ubnd + ((size_t)pabs * 2 + 1) * NCH + c) = acc[1][1][3][n]; }
        asm volatile("s_waitcnt lgkmcnt(0)" ::: "memory"); __builtin_amdgcn_s_barrier(); asm volatile("" ::: "memory");
        const int row0 = u.pm * BM + wr * 64 + fr;
#pragma unroll
        for (int n = 0; n < 2; ++n) { const int c = ch0 + 16 * n;
            const f32x4 w0 = *(const f32x4*)(cw + c), w1 = *(const f32x4*)(cw + NCH + c), w2 = *(const f32x4*)(cw + 2 * NCH + c), bb = *(const f32x4*)(cb + c);
#pragma unroll
            for (int ai = 0; ai < 2; ++ai) { const int blk = ai * 2 + wr, xo = wc * 32 + n * 16 + 4 * fq;
                const f32x4 zero = {0.f, 0.f, 0.f, 0.f};
                const f32x4 bprev = (blk > 0) ? *(const PG8_LAS f32x4*)(xr + (blk - 1) * 256 + 128 + xo) : zero;
                const f32x4 bnext = (blk < 3) ? *(const PG8_LAS f32x4*)(xr + (blk + 1) * 256 + xo) : zero;
                f32x4 up1[4], dn1[4];
#pragma unroll
                for (int m = 0; m < 4; ++m) { up1[m] = rot4<0x121>(acc[ai][0][m][n]); dn1[m] = rot4<0x12F>(acc[ai][0][m][n]); }
#pragma unroll
                for (int m = 0; m < 4; ++m) {
                    const f32x4 pv = (fr == 0) ? (m > 0 ? up1[m - 1] : bprev) : up1[m];
                    const f32x4 nv = (fr == 15) ? (m < 3 ? dn1[m + 1] : bnext) : dn1[m];
                    const f32x4 gsum = bb + w0 * pv + w1 * acc[ai][0][m][n] + w2 * nv, uu = acc[ai][1][m][n];
                    float h[4];
#pragma unroll
                    for (int j = 0; j < 4; ++j) h[j] = gsum[j] / (1.f + __expf(-gsum[j])) * uu[j];
                    typedef unsigned u32x2 __attribute__((ext_vector_type(2)));
                    u32x2 o; o.x = cvt_pk_bf16(h[0], h[1]); o.y = cvt_pk_bf16(h[2], h[3]);
                    *(u32x2*)(H + (size_t)(row0 + ai * HALF + m * 16) * ldh + c) = o; } } }
    }
};
struct EpiInProj {
    static constexpr bool PERM = true, AFTER_DRAIN = false;
    bf16_t* O; int ldc; float* dtr; int nbf;
    __device__ __forceinline__ void operator()(const f32x4 (&acc)[2][2][4][2], const Unit& u, int wr, int wc, int fr, int fq) const {
        const int row0 = u.pm * BM + wr * 64 + fr;
        if (u.pn < nbf) { const int col0 = u.pn * BM + wc * 32 + 8 * fq;
#pragma unroll
            for (int ai = 0; ai < 2; ++ai)
#pragma unroll
                for (int m = 0; m < 4; ++m) { bf16_t* rowp = O + (size_t)(row0 + ai * HALF + m * 16) * ldc + col0;
#pragma unroll
                    for (int bj = 0; bj < 2; ++bj) { const f32x4 v0 = acc[ai][bj][m][0], v1 = acc[ai][bj][m][1];
                        u32x4 w; w.x = cvt_pk_bf16(v0[0], v0[1]); w.y = cvt_pk_bf16(v0[2], v0[3]); w.z = cvt_pk_bf16(v1[0], v1[1]); w.w = cvt_pk_bf16(v1[2], v1[3]);
                        *(u32x4*)(rowp + bj * HALF) = w; } }
        } else if (wc == 0 && fq < 2) {
#pragma unroll
            for (int ai = 0; ai < 2; ++ai)
#pragma unroll
                for (int m = 0; m < 4; ++m) { float* rowp = dtr + (size_t)(row0 + ai * HALF + m * 16) * 16 + 8 * fq;
                    *(f32x4*)rowp = acc[ai][0][m][0]; *(f32x4*)(rowp + 4) = acc[ai][0][m][1]; }
        }
    }
};

template <class Epi, class Sched, bool ALIGN_EPI = false, bool SP2 = false>
__device__ __forceinline__ void gemm_phase(PG8_LAS unsigned char* lds, const Gemm g, const Sched& S, const Epi& E) {
    const int tid = tid_opaque(), wid = __builtin_amdgcn_readfirstlane(tid >> 6), lane = tid & 63, wr = wid >> 2, wc = wid & 3, fr = lane & 15, fq = lane >> 4;
    const int K = g.K, nt = K / BK, ld = g.ld;
    unsigned voffA[2], voffB[2];
#pragma unroll
    for (int i = 0; i < 2; ++i) { int R, C; stage_rc(tid * 16 + i * 8192, R, C); const int Rb = Epi::PERM ? ((R & ~31) + perm32(R & 31)) : R;
        voffA[i] = (unsigned)(R * ld + C) * 2u; voffB[i] = (unsigned)(Rb * ld + C) * 2u; }
    const size_t kstep = (size_t)(BK * 2);
    const size_t hstep = (size_t)HALF * ld * 2;
    const size_t tstep = 2 * hstep;
    const unsigned ldsw = (unsigned)wid * 1024u;
    const int aoff = lds_byte(wr * 64 + fr, fq * 8), boff = lds_byte(wc * 32 + fr, fq * 8);
#define PG8_SA(b, h) (((b) * 2 + (h)) * HTB)
#define PG8_SB(b, h) ((4 + (b) * 2 + (h)) * HTB)
#define PG8_STAGE(bufoff, gbase, voff) do { _Pragma("unroll") for (int _i = 0; _i < 2; ++_i) \
        __builtin_amdgcn_global_load_lds((const unsigned*)((const char*)(gbase) + (voff)[_i]), (PG8_LAS unsigned*)(lds + (bufoff) + ldsw + _i * 8192), 16, 0, 0); } while (0)
#define PG8_LDA(dst, b, h) do { _Pragma("unroll") for (int m = 0; m < 4; ++m) _Pragma("unroll") for (int k = 0; k < 2; ++k) dst[m][k] = *(const PG8_LAS bf16x8*)(lds + PG8_SA(b, h) + aoff + m * 2048 + k * 1024); } while (0)
#define PG8_LDB(dst, b, h) do { _Pragma("unroll") for (int n = 0; n < 2; ++n) _Pragma("unroll") for (int k = 0; k < 2; ++k) dst[n][k] = *(const PG8_LAS bf16x8*)(lds + PG8_SB(b, h) + boff + n * 2048 + k * 1024); } while (0)
#define PG8_MMA(ai, bj, At, Bt) do { __builtin_amdgcn_s_setprio(1); _Pragma("unroll") for (int m = 0; m < 4; ++m) _Pragma("unroll") for (int n = 0; n < 2; ++n) _Pragma("unroll") for (int k = 0; k < 2; ++k) \
        acc[ai][bj][m][n] = __builtin_amdgcn_mfma_f32_16x16x32_bf16(Bt[n][k], At[m][k], acc[ai][bj][m][n], 0, 0, 0); __builtin_amdgcn_s_setprio(0); } while (0)
#define PG8_WAIT_V(n) asm volatile("s_waitcnt vmcnt(" #n ")" ::: "memory")
#define PG8_WAIT_L(n) asm volatile("s_waitcnt lgkmcnt(" #n ")" ::: "memory")
#define PG8_BAR __builtin_amdgcn_s_barrier()
#define PG8_SCHED __builtin_amdgcn_sched_barrier(0)
    Unit cur, nxt; int ui = 0;
    if (!S.next(0, cur)) return;
    f32x4 acc[2][2][4][2];
#pragma unroll
    for (int a = 0; a < 2; ++a)
#pragma unroll
        for (int b = 0; b < 2; ++b)
#pragma unroll
            for (int m = 0; m < 4; ++m)
#pragma unroll
                for (int n = 0; n < 2; ++n) acc[a][b][m][n] = (f32x4){0.f, 0.f, 0.f, 0.f};
    bf16x8 At[4][2], B0[2][2], B1[2][2];
    const char* cA = (const char*)g.A + (size_t)cur.pm * tstep + (size_t)cur.k0 * 2; const char* cB = (const char*)g.Bt + (size_t)cur.pn * tstep + (size_t)cur.k0 * 2;
    S.a_ready(cur);
    if constexpr (SP2) {
        PG8_STAGE(PG8_SB(0, 0), cB, voffB); PG8_STAGE(PG8_SB(0, 1), cB + hstep, voffB); PG8_STAGE(PG8_SA(0, 0), cA, voffA); PG8_STAGE(PG8_SA(0, 1), cA + hstep, voffA);
        if (wr == 1) PG8_BAR;
        PG8_WAIT_V(2); PG8_BAR;
        PG8_STAGE(PG8_SB(1, 0), cB + kstep, voffB); PG8_STAGE(PG8_SA(1, 0), cA + kstep, voffA); PG8_STAGE(PG8_SB(1, 1), cB + hstep + kstep, voffB);
        PG8_WAIT_V(6); PG8_BAR;
    } else {
        PG8_STAGE(PG8_SB(0, 0), cB, voffB); PG8_STAGE(PG8_SA(0, 0), cA, voffA); PG8_STAGE(PG8_SB(0, 1), cB + hstep, voffB); PG8_STAGE(PG8_SA(0, 1), cA + hstep, voffA);
        if (wr == 1) PG8_BAR;
        PG8_WAIT_V(4); PG8_BAR;
        PG8_STAGE(PG8_SB(1, 0), cB + kstep, voffB); PG8_STAGE(PG8_SA(1, 0), cA + kstep, voffA); PG8_STAGE(PG8_SB(1, 1), cB + hstep + kstep, voffB);
        PG8_WAIT_V(6); PG8_BAR;
    }
    for (;;) {
        const bool has_next = S.next(ui + 1, nxt);
        const char* nA = has_next ? (const char*)g.A + (size_t)nxt.pm * tstep + (size_t)nxt.k0 * 2 : cA; const char* nB = has_next ? (const char*)g.Bt + (size_t)nxt.pn * tstep + (size_t)nxt.k0 * 2 : cB;
        asm volatile(".p2align 8");
        for (int t = 0; t < nt; t += 2) {
            const bool last = (t == nt - 2);
            const char* a1 = cA + (size_t)(t + 1) * kstep;
            const char* a2 = last ? nA : cA + (size_t)(t + 2) * kstep; const char* b2 = last ? nB : cB + (size_t)(t + 2) * kstep;
            const char* a3 = a2 + kstep; const char* b3 = b2 + kstep;
            if (last && has_next) S.a_ready(nxt);
            if constexpr (SP2) {
            PG8_LDB(B0, 0, 0); PG8_LDB(B1, 0, 1); PG8_SCHED; PG8_LDA(At, 0, 0); PG8_STAGE(PG8_SA(1, 1), a1 + hstep, voffA);
            PG8_WAIT_V(8); PG8_WAIT_L(0); PG8_BAR; PG8_MMA(0, 0, At, B0); PG8_MMA(0, 1, At, B1); PG8_BAR; PG8_SCHED;
            PG8_LDA(At, 0, 1); PG8_STAGE(PG8_SB(0, 0), b2, voffB); PG8_STAGE(PG8_SB(0, 1), b2 + hstep, voffB); PG8_STAGE(PG8_SA(0, 0), a2, voffA);
            PG8_WAIT_V(8); PG8_WAIT_L(0); PG8_BAR; PG8_MMA(1, 0, At, B0); PG8_MMA(1, 1, At, B1); PG8_BAR; PG8_SCHED;
            PG8_LDB(B0, 1, 0); PG8_LDB(B1, 1, 1); PG8_SCHED; PG8_LDA(At, 1, 0); PG8_STAGE(PG8_SA(0, 1), a2 + hstep, voffA);
            PG8_WAIT_V(8); PG8_WAIT_L(0); PG8_BAR; PG8_MMA(0, 0, At, B0); PG8_MMA(0, 1, At, B1); PG8_BAR; PG8_SCHED;
            PG8_LDA(At, 1, 1); PG8_STAGE(PG8_SB(1, 0), b3, voffB); PG8_STAGE(PG8_SB(1, 1), b3 + hstep, voffB); PG8_STAGE(PG8_SA(1, 0), a3, voffA);
            PG8_WAIT_V(8); PG8_WAIT_L(0); PG8_BAR; PG8_MMA(1, 0, At, B0); PG8_MMA(1, 1, At, B1); PG8_BAR; PG8_SCHED;
            } else {
            PG8_LDB(B0, 0, 0); PG8_SCHED; PG8_LDA(At, 0, 0); PG8_STAGE(PG8_SA(1, 1), a1 + hstep, voffA);
            PG8_WAIT_L(8); PG8_BAR; PG8_WAIT_L(0); PG8_MMA(0, 0, At, B0); PG8_BAR; PG8_SCHED;
            PG8_LDB(B1, 0, 1); PG8_STAGE(PG8_SB(0, 0), b2, voffB);
            PG8_BAR; PG8_WAIT_L(0); PG8_MMA(0, 1, At, B1); PG8_BAR;
            PG8_LDA(At, 0, 1); PG8_STAGE(PG8_SA(0, 0), a2, voffA);
            PG8_BAR; PG8_WAIT_L(0); PG8_MMA(1, 0, At, B0); PG8_BAR; PG8_SCHED;
            PG8_STAGE(PG8_SB(0, 1), b2 + hstep, voffB);
            PG8_WAIT_V(6); PG8_BAR; PG8_MMA(1, 1, At, B1); PG8_BAR;
            PG8_LDB(B0, 1, 0); PG8_SCHED; PG8_LDA(At, 1, 0); PG8_STAGE(PG8_SA(0, 1), a2 + hstep, voffA);
            PG8_WAIT_L(8); PG8_BAR; PG8_WAIT_L(0); PG8_MMA(0, 0, At, B0); PG8_BAR; PG8_SCHED;
            PG8_LDB(B1, 1, 1); PG8_STAGE(PG8_SB(1, 0), b3, voffB);
            PG8_BAR; PG8_WAIT_L(0); PG8_MMA(0, 1, At, B1); PG8_BAR;
            PG8_LDA(At, 1, 1); PG8_STAGE(PG8_SA(1, 0), a3, voffA);
            PG8_BAR; PG8_WAIT_L(0); PG8_MMA(1, 0, At, B0); PG8_BAR; PG8_SCHED;
            PG8_STAGE(PG8_SB(1, 1), b3 + hstep, voffB);
            PG8_WAIT_V(6); PG8_BAR; PG8_MMA(1, 1, At, B1); PG8_BAR;
            }
        }
        if constexpr (ALIGN_EPI) { if (wr == 0) PG8_BAR; }
        if constexpr (!Epi::AFTER_DRAIN) { E(acc, cur, wr, wc, fr, fq); S.done(cur); }
        if (!has_next) break;
#pragma unroll
        for (int a = 0; a < 2; ++a)
#pragma unroll
            for (int b = 0; b < 2; ++b)
#pragma unroll
                for (int m = 0; m < 4; ++m)
#pragma unroll
                    for (int n = 0; n < 2; ++n) acc[a][b][m][n] = (f32x4){0.f, 0.f, 0.f, 0.f};
        cur = nxt; cA = nA; cB = nB; ++ui;
        if constexpr (ALIGN_EPI) { if (wr == 1) PG8_BAR; }
    }
    PG8_WAIT_V(0);
    if constexpr (!ALIGN_EPI) { if (wr == 0) PG8_BAR; }
    PG8_BAR;
    if constexpr (Epi::AFTER_DRAIN) { E.fused(acc, cur, wr, wc, fr, fq, lds, wid, lane); S.done(cur); }
#undef PG8_SA
#undef PG8_SB
#undef PG8_STAGE
#undef PG8_LDA
#undef PG8_LDB
#undef PG8_MMA
#undef PG8_WAIT_V
#undef PG8_WAIT_L
#undef PG8_BAR
#undef PG8_SCHED
}
}

namespace att {
using bf16 = __hip_bfloat16;
constexpr int   D = 128, NW = 8, QBLK = 32, KVBLK = 64;
constexpr float SCALE = 0.088388347648318440f;
constexpr float THR = 8.f;
constexpr int SDEPTH = 2;
constexpr int LDQ = 1536, LDK = 768, LDV = 5120, LDO = 1536;
constexpr size_t SHM_V = KVBLK * D * 2, SHM_K = KVBLK * D * 2, SHM_ATTN = 2 * SHM_V + 2 * SHM_K + NW * 64 * 4;
using bf16x8 = __attribute__((ext_vector_type(8))) short;
using s16x4  = __attribute__((ext_vector_type(4))) short;
using f32x16 = __attribute__((ext_vector_type(16))) float;
using f32x8  = __attribute__((ext_vector_type(8))) float;
using u32x4  = __attribute__((ext_vector_type(4))) unsigned;
#define KSWZ(row, colB) ((row) * 256 + ((colB) ^ (((row) & 7) << 4)))
#define SBAR() __builtin_amdgcn_sched_barrier(0)
__device__ __forceinline__ int crow(int r, int hi) { return (r & 3) + 8 * (r >> 2) + 4 * hi; }
__device__ __forceinline__ unsigned cvtpk(float lo, float hi) {
  unsigned r; asm volatile("v_cvt_pk_bf16_f32 %0, %1, %2" : "=v"(r) : "v"(lo), "v"(hi)); return r;
}
template <typename TIn> struct Stage;
template <> struct Stage<bf16>  { using T = bf16x8;
  __device__ static __forceinline__ T ld8(const bf16* p) { return *reinterpret_cast<const bf16x8*>(p); }
  __device__ static __forceinline__ bf16x8 tobf(T x) { return x; } };
template <> struct Stage<float> { using T = f32x8;
  __device__ static __forceinline__ T ld8(const float* p) { return *reinterpret_cast<const f32x8*>(p); }
  __device__ static __forceinline__ bf16x8 tobf(T x) {
    u32x4 w = {cvtpk(x[0], x[1]), cvtpk(x[2], x[3]), cvtpk(x[4], x[5]), cvtpk(x[6], x[7])}; return *reinterpret_cast<bf16x8*>(&w); } };

__device__ __forceinline__ void partialSM(f32x16& p0, f32x16& p1, float& m_reg, float& mn, float& alpha) {
  constexpr float C = SCALE * 1.4426950408889634f;
  float pmax = p0[0]; for (int r = 1; r < 16; ++r) pmax = fmaxf(pmax, p0[r]); for (int r = 0; r < 16; ++r) pmax = fmaxf(pmax, p1[r]);
  { auto rr = __builtin_amdgcn_permlane32_swap(__float_as_uint(pmax), __float_as_uint(pmax), false, false);
    pmax = fmaxf(__uint_as_float(rr[0]), __uint_as_float(rr[1])); }
  if (__builtin_expect(__all(pmax - m_reg <= THR / SCALE), 1)) { mn = m_reg; alpha = 1.f; }
  else { mn = fmaxf(m_reg, pmax); alpha = __builtin_amdgcn_exp2f((m_reg - mn) * C); m_reg = mn; }
  float mnC = -mn * C;
  for (int r = 0; r < 16; ++r) p0[r] = fmaf(p0[r], C, mnC); for (int r = 0; r < 16; ++r) p1[r] = fmaf(p1[r], C, mnC);
  for (int r = 0; r < 16; ++r) p0[r] = __builtin_amdgcn_exp2f(p0[r]);
}
__device__ __forceinline__ void finishSM(f32x16& p0, f32x16& p1, float alpha, float& l_reg, bf16x8& pa0, bf16x8& pa1, bf16x8& pa2, bf16x8& pa3) {
  for (int r = 0; r < 16; ++r) p1[r] = __builtin_amdgcn_exp2f(p1[r]);
  float ps = 0; for (int r = 0; r < 16; ++r) ps += p0[r]; for (int r = 0; r < 16; ++r) ps += p1[r];
  { auto rr = __builtin_amdgcn_permlane32_swap(__float_as_uint(ps), __float_as_uint(ps), false, false);
    ps = __uint_as_float(rr[0]) + __uint_as_float(rr[1]); }
  l_reg = l_reg * alpha + ps;
#define PK4(P, BASE, OUT) do { unsigned a0 = cvtpk(P[BASE + 0], P[BASE + 1]), a1 = cvtpk(P[BASE + 2], P[BASE + 3]);   \
    unsigned b0 = cvtpk(P[BASE + 4], P[BASE + 5]), b1 = cvtpk(P[BASE + 6], P[BASE + 7]);                              \
    auto r0 = __builtin_amdgcn_permlane32_swap(a0, b0, false, false); auto r1 = __builtin_amdgcn_permlane32_swap(a1, b1, false, false); \
    u32x4 w = {r0[0], r1[0], r0[1], r1[1]}; OUT = *reinterpret_cast<bf16x8*>(&w); } while (0)
  PK4(p0, 0, pa0); PK4(p0, 8, pa1); PK4(p1, 0, pa2); PK4(p1, 8, pa3);
#undef PK4
}
template <int ND0> __device__ __forceinline__ void qkt(f32x16& p0, f32x16& p1, const bf16* Ks, const bf16x8* qr, int r32, int hi, int kcb) {
  p0 = f32x16{}; p1 = f32x16{};
#pragma unroll
  for (int d0 = 0; d0 < ND0; ++d0) { int cb = (d0 * 16 + hi * 8) * 2 + kcb;
    bf16x8 b0 = *reinterpret_cast<const bf16x8*>((const char*)Ks + KSWZ(r32, cb));
    bf16x8 b1 = *reinterpret_cast<const bf16x8*>((const char*)Ks + KSWZ(32 + r32, cb));
    p0 = __builtin_amdgcn_mfma_f32_32x32x16_bf16(b0, qr[d0], p0, 0, 0, 0);
    p1 = __builtin_amdgcn_mfma_f32_32x32x16_bf16(b1, qr[d0], p1, 0, 0, 0); }
}
__device__ __forceinline__ int v_st(int k, int c) { const int kk = (k & ~0xC) | ((k & 4) << 1) | ((k & 8) >> 1); return ((kk >> 3) * 4 + (c >> 5)) * 512 + ((kk & 7) * 32 + (c & 31)) * 2; }
__device__ __forceinline__ int v_rd_base(int lane) { return ((lane & 3) << 3) | (((lane >> 2) & 3) << 6) | (((lane >> 4) & 1) << 5) | (((lane >> 5) & 1) << 8); }
constexpr int v_rd_off(int d0, int ks, int half) { return d0 * 512 + ks * 4096 + half * 2048; }
template <int OFF> __device__ __forceinline__ s16x4 tr_read(int vb) {
  s16x4 r; asm volatile("ds_read_b64_tr_b16 %0, %1 offset:%2" : "=&v"(r) : "v"(vb), "i"(OFF) : "memory"); return r;
}
template <int D0> __device__ __forceinline__ void pv_one(f32x16& od, int vb, bf16x8 pa0, bf16x8 pa1, bf16x8 pa2, bf16x8 pa3) {
  const s16x4 l0 = tr_read<v_rd_off(D0, 0, 0)>(vb), h0 = tr_read<v_rd_off(D0, 0, 1)>(vb), l1 = tr_read<v_rd_off(D0, 1, 0)>(vb), h1 = tr_read<v_rd_off(D0, 1, 1)>(vb);
  const s16x4 l2 = tr_read<v_rd_off(D0, 2, 0)>(vb), h2 = tr_read<v_rd_off(D0, 2, 1)>(vb), l3 = tr_read<v_rd_off(D0, 3, 0)>(vb), h3 = tr_read<v_rd_off(D0, 3, 1)>(vb);
  asm volatile("s_waitcnt lgkmcnt(0)" ::: "memory"); SBAR();
#define PK(L, H) (bf16x8){L[0], L[1], L[2], L[3], H[0], H[1], H[2], H[3]}
  od = __builtin_amdgcn_mfma_f32_32x32x16_bf16(pa0, PK(l0, h0), od, 0, 0, 0);
  od = __builtin_amdgcn_mfma_f32_32x32x16_bf16(pa1, PK(l1, h1), od, 0, 0, 0);
  od = __builtin_amdgcn_mfma_f32_32x32x16_bf16(pa2, PK(l2, h2), od, 0, 0, 0);
  od = __builtin_amdgcn_mfma_f32_32x32x16_bf16(pa3, PK(l3, h3), od, 0, 0, 0);
#undef PK
}
__device__ __forceinline__ void pv_d0(f32x16* o, int vb, bf16x8 pa0, bf16x8 pa1, bf16x8 pa2, bf16x8 pa3) {
  pv_one<0>(o[0], vb, pa0, pa1, pa2, pa3); pv_one<1>(o[1], vb, pa0, pa1, pa2, pa3); pv_one<2>(o[2], vb, pa0, pa1, pa2, pa3); pv_one<3>(o[3], vb, pa0, pa1, pa2, pa3);
}

template <typename TQ, int ND0, bool PARTIAL>
__device__ __forceinline__ void attn_dense_body(const TQ* __restrict__ Qb, const bf16* __restrict__ Kh, const bf16* __restrict__ Vh,
                                                float* __restrict__ Ob, int seq, char* lds, int kcb, float* __restrict__ ML) {
  using St = Stage<bf16>; using SQ = Stage<TQ>;
  const int tid = tid_opaque(), wid = tid >> 6, lane = tid & 63, r32 = lane & 31, hi = lane >> 5;
  bf16* V_lds = (bf16*)lds; bf16* K_lds = (bf16*)(lds + 2 * SHM_V);
  float* ws = (float*)(lds + 2 * SHM_V + 2 * SHM_K) + wid * 64; float* li_l = ws; float* al_l = ws + 32;
  float m_reg = -1e30f, l_reg = 0; f32x16 o[4] = {}; bf16x8 qr[8];
  const TQ* Qw = Qb + (long)(wid * QBLK + r32) * LDQ + hi * 8;
#pragma unroll
  for (int d0 = 0; d0 < ND0; ++d0) qr[d0] = SQ::tobf(SQ::ld8(Qw + d0 * 16));
  const int sr = tid >> 4, sc = (tid & 15) * 8, vst0 = v_st(sr, sc), vst1 = v_st(32 + sr, sc);
  const int vb0 = (int)(uintptr_t)V_lds + v_rd_base(lane);
  struct { typename St::T vs0, vs1, ks0, ks1; } sr_[SDEPTH];
#define SLOAD(i, k0) do { sr_[i].vs0 = St::ld8(&Vh[(long)((k0) + sr) * LDV + sc]); sr_[i].vs1 = St::ld8(&Vh[(long)((k0) + 32 + sr) * LDV + sc]); \
    sr_[i].ks0 = St::ld8(&Kh[(long)((k0) + sr) * LDK + sc]); sr_[i].ks1 = St::ld8(&Kh[(long)((k0) + 32 + sr) * LDK + sc]); } while (0)
#define SWRITE(b, i) do { *(bf16x8*)((char*)V_lds + (b) * SHM_V + vst0) = St::tobf(sr_[i].vs0);          \
    *(bf16x8*)((char*)V_lds + (b) * SHM_V + vst1) = St::tobf(sr_[i].vs1); int kc = sc * 2;               \
    *(bf16x8*)((char*)K_lds + (b) * SHM_K + KSWZ(sr, kc)) = St::tobf(sr_[i].ks0);                       \
    *(bf16x8*)((char*)K_lds + (b) * SHM_K + KSWZ(32 + sr, kc)) = St::tobf(sr_[i].ks1); } while (0)
#define SWAIT() do { if constexpr (SDEPTH == 2) asm volatile("s_waitcnt vmcnt(4)" ::: "memory"); else asm volatile("s_waitcnt vmcnt(0)" ::: "memory"); } while (0)
#define RESC(a) do { if (__any((a) < 1.f)) { if (hi == 0) al_l[r32] = (a); asm volatile("s_waitcnt lgkmcnt(0)" ::: "memory"); \
    for (int d = 0; d < 4; ++d) for (int r = 0; r < 16; ++r) o[d][r] *= al_l[crow(r, hi)]; } } while (0)
  f32x16 pA0, pA1, pB0, pB1; float mnA, mnB, alA, alB; bf16x8 pa0, pa1, pa2, pa3; const int NT = seq / KVBLK;
  constexpr int SE = 0, SO = SDEPTH - 1;
  SLOAD(SE, 0); asm volatile("s_waitcnt vmcnt(0)" ::: "memory"); SWRITE(0, SE); __syncthreads();
  qkt<ND0>(pA0, pA1, K_lds, qr, r32, hi, kcb); partialSM(pA0, pA1, m_reg, mnA, alA);
  SLOAD(SO, KVBLK); if constexpr (SDEPTH == 2) { if (2 < NT) SLOAD(SE, 2 * KVBLK); }
  SWAIT(); SWRITE(1, SO); __syncthreads();
  asm volatile(".p2align 8");
  for (int j = 1; j + 1 < NT; j += 2) {
    SBAR(); qkt<ND0>(pB0, pB1, (bf16*)((char*)K_lds + SHM_K), qr, r32, hi, kcb);
    finishSM(pA0, pA1, alA, l_reg, pa0, pa1, pa2, pa3); SBAR();
    SLOAD(SO, (j + SDEPTH) * KVBLK); SBAR();
    pv_d0(o, vb0, pa0, pa1, pa2, pa3); partialSM(pB0, pB1, m_reg, mnB, alB);
    __syncthreads(); SWAIT(); SWRITE(0, SE);
    RESC(alB); __syncthreads();
    SBAR(); qkt<ND0>(pA0, pA1, K_lds, qr, r32, hi, kcb);
    finishSM(pB0, pB1, alB, l_reg, pa0, pa1, pa2, pa3); SBAR();
    if (SDEPTH == 1 || j + 3 < NT) SLOAD(SE, (j + 1 + SDEPTH) * KVBLK); SBAR();
    pv_d0(o, vb0 + (int)SHM_V, pa0, pa1, pa2, pa3); partialSM(pA0, pA1, m_reg, mnA, alA);
    __syncthreads(); SWAIT(); SWRITE(1, SO);
    RESC(alA); __syncthreads();
  }
  SBAR(); qkt<ND0>(pB0, pB1, (bf16*)((char*)K_lds + SHM_K), qr, r32, hi, kcb);
  finishSM(pA0, pA1, alA, l_reg, pa0, pa1, pa2, pa3); SBAR();
  pv_d0(o, vb0, pa0, pa1, pa2, pa3); partialSM(pB0, pB1, m_reg, mnB, alB);
  __syncthreads(); RESC(alB);
  finishSM(pB0, pB1, alB, l_reg, pa0, pa1, pa2, pa3); SBAR();
  pv_d0(o, vb0 + (int)SHM_V, pa0, pa1, pa2, pa3);
  if (hi == 0) li_l[r32] = l_reg; asm volatile("s_waitcnt lgkmcnt(0)" ::: "memory");
  float rli[16];
#pragma unroll
  for (int r = 0; r < 16; ++r) rli[r] = PARTIAL ? 1.f : __builtin_amdgcn_rcpf(li_l[crow(r, hi)]);
  if (PARTIAL) { if (hi == 0) { float* mp = ML + (long)(wid * QBLK + r32) * 24; mp[0] = m_reg * (SCALE * 1.4426950408889634f); mp[1] = l_reg; } }
  float* Ow = Ob + (long)(wid * QBLK) * LDO;
#pragma unroll
  for (int r = 0; r < 16; ++r) { int orow = crow(r, hi);
    for (int d0 = 0; d0 < 4; ++d0) Ow[(long)orow * LDO + d0 * 32 + r32] = o[d0][r] * rli[r]; }
#undef SLOAD
#undef SWRITE
#undef SWAIT
#undef RESC
}
}

#define GAS __attribute__((address_space(1)))
typedef unsigned short bf16_t;
typedef unsigned v4u __attribute__((ext_vector_type(4)));
typedef unsigned v2u __attribute__((ext_vector_type(2)));
typedef float f32x4 __attribute__((ext_vector_type(4)));
typedef float f32x2 __attribute__((ext_vector_type(2)));
typedef short bf16x8 __attribute__((ext_vector_type(8)));

constexpr int DM = 2048, TL = 8192, TC = 256, TA = TL + TC, DEPTH = 4, DFF = 5632;
constexpr int NP = 5120, NIN = 5136, NPT = 5376;
constexpr int C_DAQ = 0, C_DAK = 512, C_DAV = 1024, C_GQ = 1536, C_GK = 2048, C_GV = 2304, C_LX = 2560, C_LG = 3072, C_SZ = 3584, C_SX = 4096, C_SB = 4608, C_SC = 4864, C_DT = 5120;
constexpr int QLD = 1536, KLD = 768;
constexpr float NEPS = 1e-6f;
constexpr int NWAVES = 8;
#ifndef FIN_INPLACE
#define FIN_INPLACE 1
#endif
#ifndef SUBM
#define SUBM 7
#endif

constexpr size_t MiB = 1u << 20;
constexpr size_t WS_CTL = 0, CTL_ZERO_BYTES = 1 * MiB;
constexpr size_t WS_WIN = 833 * MiB, WS_WOUT = 82 * MiB, WS_WUP = 114 * MiB, WS_WDN = 290 * MiB, WS_WG = 378 * MiB;
constexpr size_t WS_MODP = 380 * MiB, WS_MODF = 383 * MiB, WS_ROPE = 384 * MiB;
constexpr size_t WS_X = 385 * MiB, WS_XN = 451 * MiB, WS_P = 484 * MiB, WS_QB = 567 * MiB, WS_KB = 592 * MiB, WS_O = 605 * MiB;
constexpr size_t WS_DT = 655 * MiB, WS_ACUM = 656 * MiB, WS_HF = 657 * MiB, WS_PF = 674 * MiB, WS_HB = 691 * MiB, WS_PB = 708 * MiB, WS_LSUM = 725 * MiB;
constexpr size_t WS_YD = 727 * MiB, WS_XC = 744 * MiB, WS_ST = 749 * MiB, WS_SIN = 782 * MiB, WS_CHA = 799 * MiB;
constexpr size_t WS_YCAT = 800 * MiB, WS_GU = 833 * MiB, WS_H = 1015 * MiB, WS_OP1 = 1106 * MiB, WS_ML = 1156 * MiB, WS_YD2 = 1158 * MiB, WS_PART = 1175 * MiB, WS_GBND = 1197 * MiB, WS_UBND = 1200 * MiB, WS_END = 1202 * MiB;
static_assert(WS_WIN + 4ull * NPT * DM * 2 <= WS_H && WS_WOUT + 4ull * DM * DM * 2 <= WS_WUP && WS_WUP + 4ull * 2 * DFF * DM * 2 <= WS_WDN && WS_WDN + 4ull * DM * DFF * 2 <= WS_WG, "weights map");
static_assert(WS_X + (size_t)TA * DM * 4 <= WS_XN && WS_XN + (size_t)TA * DM * 2 <= WS_P && WS_P + (size_t)TA * NP * 2 <= WS_QB && WS_QB + (size_t)TA * QLD * 2 <= WS_KB && WS_KB + (size_t)TA * KLD * 2 <= WS_O && WS_O + (size_t)TA * QLD * 4 <= WS_DT, "act map 1");
static_assert(WS_HF + (size_t)TA * 512 * 4 <= WS_PF && WS_LSUM + 132ull * 2 * 2 * 512 * 4 <= WS_YD && WS_YD + (size_t)TA * 512 * 4 <= WS_XC && WS_XC + (size_t)TA * 256 * 2 <= WS_ST && WS_ST + 66ull * 2 * 65536 * 4 <= WS_SIN && WS_SIN + 66ull * 2 * 65536 * 2 <= WS_CHA, "act map 2");
static_assert(WS_YCAT + (size_t)TA * DM * 2 <= WS_GU && WS_GU + (size_t)TA * 2 * DFF * 2 <= WS_H && WS_H + (size_t)TA * DFF * 2 <= WS_END, "act map 3");
constexpr int CW_BAR = 4096;

constexpr int PH_LDS = 147456;
constexpr int MISC_OFF = PH_LDS;
constexpr int LDS_BYTES = PH_LDS + 1024;
static_assert(WMAP_OFF == MISC_OFF + 512 && WMAP_OFF + 256 <= LDS_BYTES, "wave map inside the LDS control area");

#define LAS __attribute__((address_space(3)))
#define LDS_WAIT() asm volatile("s_waitcnt lgkmcnt(0)" ::: "memory")
#define VM_WAIT() asm volatile("s_waitcnt vmcnt(0)" ::: "memory")
#define RLX_AGENT __ATOMIC_RELAXED, __HIP_MEMORY_SCOPE_AGENT

__device__ __forceinline__ unsigned f2bf(float f) { unsigned u = __builtin_bit_cast(unsigned, f); return (u + 0x7fffu + ((u >> 16) & 1u)) >> 16; }
__device__ __forceinline__ unsigned pk2(float lo, float hi) { unsigned r; asm volatile("v_cvt_pk_bf16_f32 %0, %1, %2" : "=v"(r) : "v"(lo), "v"(hi)); return r; }
__device__ __forceinline__ float bflo(unsigned w) { return __uint_as_float(w << 16); }
__device__ __forceinline__ float bfhi(unsigned w) { return __uint_as_float(w & 0xffff0000u); }
__device__ __forceinline__ float bf1(bf16_t b) { return __uint_as_float(((unsigned)b) << 16); }
__device__ __forceinline__ void unpack8(const v4u w, float (&x)[8]) { x[0] = bflo(w.x); x[1] = bfhi(w.x); x[2] = bflo(w.y); x[3] = bfhi(w.y); x[4] = bflo(w.z); x[5] = bfhi(w.z); x[6] = bflo(w.w); x[7] = bfhi(w.w); }
__device__ __forceinline__ v4u pack8(const float (&x)[8]) { v4u w; w.x = pk2(x[0], x[1]); w.y = pk2(x[2], x[3]); w.z = pk2(x[4], x[5]); w.w = pk2(x[6], x[7]); return w; }
__device__ __forceinline__ float wave_sum(float v) {
#pragma unroll
    for (int o = 1; o < 64; o <<= 1) v += shx(v, o);
    return v;
}
__device__ __forceinline__ float siluf(float x) { return x / (1.f + __expf(-x)); }
__device__ __forceinline__ float sigmf(float x) { return 1.f / (1.f + __expf(-x)); }
__device__ __forceinline__ float softplusf(float x) { return fmaxf(x, 0.f) + log1pf(__expf(-fabsf(x))); }
__device__ __forceinline__ float gelu_tanh(float x) { const float u = 0.7978845608028654f * (x + 0.044715f * x * x * x); return 0.5f * x * (1.f + tanhf(u)); }
#define MFMA16(a, b, c) __builtin_amdgcn_mfma_f32_16x16x32_bf16((a), (b), (c), 0, 0, 0)

struct Fr { LAS unsigned char* lds; char* ldsg; int tid, lane, wave, G, bid, vcu; };
__device__ __forceinline__ Fr fr_refresh(const Fr& F0) { Fr F = F0; F.tid = tid_opaque(); F.lane = F.tid & 63; F.wave = __builtin_amdgcn_readfirstlane(F.tid >> 6);
    asm volatile("" : "+s"(F.bid), "+s"(F.vcu), "+s"(F.G)); return F; }

struct Args { const float* in[30]; float* out; unsigned char* ws; int s_lo, s_hi; };
constexpr int TBL_OFF = PH_LDS + 256;
struct PArgs { LAS unsigned long long* tbl;
    __device__ __forceinline__ unsigned long long get(int k) const { const unsigned long long v = tbl[k];
        const unsigned lo = __builtin_amdgcn_readfirstlane((unsigned)v), hi = __builtin_amdgcn_readfirstlane((unsigned)(v >> 32)); return ((unsigned long long)hi << 32) | lo; }
    __device__ __forceinline__ const float* inp(int k) const { return (const float*)(const GAS float*)get(k); }
    __device__ __forceinline__ float* outp() const { return (float*)(GAS float*)get(30); }
    __device__ __forceinline__ unsigned char* wsp() const { return (unsigned char*)(GAS unsigned char*)get(31); }
};


#define XB_TMO      128
#define XB_XCNT(j)  (256  + 64 * (j))
#define XB_XSUB(j)  (1280 + 64 * (j))
#define XB_XGEN(j)  (2304 + 64 * (j))
#define XB_TOP      3328
#define XB_TOPGEN   3392
#define XCD_BAR_WORDS 3456
#define XB_SPIN_CAP (1u << 18)

__device__ __forceinline__ unsigned xb_ld(unsigned* p)              { return __hip_atomic_load(p, __ATOMIC_RELAXED, __HIP_MEMORY_SCOPE_AGENT); }
__device__ __forceinline__ unsigned xb_add(unsigned* p, unsigned v) { return __hip_atomic_fetch_add(p, v, __ATOMIC_RELAXED, __HIP_MEMORY_SCOPE_AGENT); }
__device__ __forceinline__ unsigned xb_xcc_id() { return (unsigned)__builtin_amdgcn_s_getreg((3 << 11) | 20) & 0xFu; }
#define XB_SPIN(cond, bar) do { unsigned _sp = 0; while (cond) { __builtin_amdgcn_s_sleep(1); \
    if ((++_sp & 255u) == 0u) { if (xb_ld(&(bar)[XB_TMO])) break; if (_sp > XB_SPIN_CAP) { atomicAdd(&(bar)[XB_TMO], 1u); break; } } } } while (0)

struct XcdBarrier {
    unsigned* bar; unsigned x;
    volatile LAS unsigned* st;
};

__device__ __forceinline__ XcdBarrier xcd_barrier_post(unsigned* bar, volatile LAS unsigned* st) {
    XcdBarrier b; b.bar = bar; b.x = xb_xcc_id(); b.st = st;
    if (tid_opaque() == 0) (void)xb_add(&bar[XB_XCNT(b.x)], 1u);
    return b;
}
__device__ __forceinline__ void xcd_barrier_complete(unsigned* bar, unsigned x, unsigned& nloc, unsigned& nx) {
    const unsigned G = gridDim.x * gridDim.y * gridDim.z;
    unsigned sum, cnt, mine, sp = 0u;
    for (;;) {
        sum = 0u; cnt = 0u; mine = 0u;
#pragma unroll
        for (unsigned j = 0; j < 16; ++j) { const unsigned c = xb_ld(&bar[XB_XCNT(j)]); sum += c; cnt += (c > 0u) ? 1u : 0u; mine = (j == x) ? c : mine; }
        if (sum == G) break;
        __builtin_amdgcn_s_sleep(1);
        if ((++sp & 255u) == 0u) { if (xb_ld(&bar[XB_TMO])) break; if (sp > XB_SPIN_CAP) { atomicAdd(&bar[XB_TMO], 1u); break; } }
    }
    nloc = mine > 0u ? mine : 1u; nx = cnt > 0u ? cnt : 1u;
}

__device__ __forceinline__ void xcd_barrier(const XcdBarrier& b) {
    asm volatile("s_waitcnt vmcnt(0)" ::: "memory");
    __syncthreads();
    if (tid_opaque() == 0) {
        unsigned* bar = b.bar;
        __builtin_amdgcn_s_waitcnt(0);
        unsigned nloc = b.st[0], nx = b.st[1];
        if (nloc == 0u) { xcd_barrier_complete(bar, b.x, nloc, nx); b.st[0] = nloc; b.st[1] = nx; }
        const unsigned old = xb_add(&bar[XB_XSUB(b.x)], 1u);
        const unsigned gen = old / nloc;
        if (old + 1u == (gen + 1u) * nloc) {
            __builtin_amdgcn_fence(__ATOMIC_RELEASE, "agent");
            asm volatile("s_waitcnt vmcnt(0)" ::: "memory");
            const unsigned og = xb_add(&bar[XB_TOP], 1u);
            const unsigned tg = og / nx;
            if (og + 1u == (tg + 1u) * nx) xb_add(&bar[XB_TOPGEN], 1u);
            else XB_SPIN(xb_ld(&bar[XB_TOPGEN]) == tg, bar);
            __builtin_amdgcn_fence(__ATOMIC_ACQUIRE, "agent");
            xb_add(&bar[XB_XGEN(b.x)], 1u);
            asm volatile("s_waitcnt vmcnt(0)" ::: "memory");
        } else {
            XB_SPIN(xb_ld(&bar[XB_XGEN(b.x)]) == gen, bar);
            __builtin_amdgcn_fence(__ATOMIC_ACQUIRE, "agent");
            asm volatile("s_waitcnt vmcnt(0)" ::: "memory");
        }
    }
    __syncthreads();
}

constexpr int TR_SCR = 64 * 65 * 4;
template <bool ILV = false>
__device__ __forceinline__ void tr_item(const float* W, int ldW, int Nuse, bf16_t* WT, int K, LAS float* scr, int item, int lane, int Nvalid = 1 << 30) {
    const int nblk = Nuse / 64, kb = item / nblk, nb = item % nblk, k0 = 64 * kb, n0 = 64 * nb;
    const int sn0 = ILV ? ((n0 & 128) ? Nuse / 2 : 0) + (n0 >> 8) * 128 + (n0 & 127) : n0;
    float tv[64];
    const float* wp = W + (size_t)k0 * ldW + sn0 + lane;
    const bool valid = sn0 + lane < Nvalid;
#pragma unroll
    for (int i = 0; i < 64; ++i) tv[i] = valid ? wp[(size_t)i * ldW] : 0.f;
#pragma unroll
    for (int i = 0; i < 64; ++i) scr[i * 65 + lane] = tv[i];
    LDS_WAIT(); asm volatile("" ::: "memory");
    const int c = lane & 7;
#pragma unroll
    for (int j = 0; j < 8; ++j) { const int n = (lane >> 3) + 8 * j; const LAS float* s = scr + (8 * c) * 65 + n;
        v4u o; o.x = pk2(s[0 * 65], s[1 * 65]); o.y = pk2(s[2 * 65], s[3 * 65]); o.z = pk2(s[4 * 65], s[5 * 65]); o.w = pk2(s[6 * 65], s[7 * 65]);
        *(v4u*)(WT + (size_t)(n0 + n) * K + k0 + 8 * c) = o; }
    LDS_WAIT(); asm volatile("" ::: "memory");
}
__device__ __forceinline__ void sincos_small(float x, float& s, float& c) {
    const float q = rintf(x * 0.6366197723675814f); const int n = (int)q;
    float r = fmaf(q, -1.5703125f, x); r = fmaf(q, -4.837512969970703125e-4f, r); r = fmaf(q, -7.54978995489188216e-8f, r);
    const float z = r * r;
    const float sp = r + r * z * (-1.6666654611e-1f + z * (8.3321608736e-3f + z * (-1.9515295891e-4f)));
    const float cp = 1.f - 0.5f * z + z * z * (4.166664568298827e-2f + z * (-1.388731625493765e-3f + z * 2.443315711809948e-5f));
    switch (n & 3) { case 0: s = sp; c = cp; break; case 1: s = cp; c = -sp; break; case 2: s = -sp; c = -cp; break; default: s = -cp; c = sp; break; }
}
constexpr int I_IN = 32 * 84, I_OUT = 32 * 32, I_UP = 32 * 176, I_DN = 88 * 32, I_WG = 16 * 4, I_L = I_IN + I_OUT + I_UP + I_DN + I_WG;
__device__ __forceinline__ void conv_item(const PArgs& A, unsigned char* ws, int L, int r, LAS float* scr, int lane) {
    if (r < I_IN) { tr_item(A.inp(8) + (size_t)L * DM * NIN, NIN, NPT, (bf16_t*)(ws + WS_WIN) + (size_t)L * NPT * DM, DM, scr, r, lane, NIN); return; } r -= I_IN;
    if (r < I_OUT) { tr_item(A.inp(9) + (size_t)L * DM * DM, DM, DM, (bf16_t*)(ws + WS_WOUT) + (size_t)L * DM * DM, DM, scr, r, lane); return; } r -= I_OUT;
    if (r < I_UP) { tr_item<true>(A.inp(25) + (size_t)L * DM * 2 * DFF, 2 * DFF, 2 * DFF, (bf16_t*)(ws + WS_WUP) + (size_t)L * 2 * DFF * DM, DM, scr, r, lane); return; } r -= I_UP;
    if (r < I_DN) { tr_item(A.inp(28) + (size_t)L * DFF * DM, DM, DM, (bf16_t*)(ws + WS_WDN) + (size_t)L * DM * DFF, DFF, scr, r, lane); return; } r -= I_DN;
    { const int mi = r / 4; tr_item(A.inp(16) + (size_t)(L * 16 + mi) * 16384, 128, 128, (bf16_t*)(ws + WS_WG) + (size_t)(L * 16 + mi) * 16384, 128, scr, r % 4, lane); }
}
constexpr int BG_Q1 = 7, BG_Q2 = 7;
__device__ __forceinline__ void bg_convert(const Fr& F0, const PArgs& A, int Ln, int lo, int hi, int rank, int per) {
    const Fr F = fr_refresh(F0); unsigned char* ws = A.wsp();
    LAS float* scr = (LAS float*)(F.lds + F.wave * TR_SCR);
    const int b = lo + rank * per, e = min(b + per, hi);
    for (int it = b; it < e; ++it) conv_item(A, ws, Ln, it, scr, F.lane);
    __syncthreads();
}
__device__ __forceinline__ void ph_prologue(const Fr& F0, const PArgs& A) {
    const Fr F = fr_refresh(F0);
    unsigned char* ws = A.wsp();
    const int gw = F.bid * NWAVES + F.wave, NGW = F.G * NWAVES;
    LAS float* scr = (LAS float*)(F.lds + F.wave * TR_SCR);
    for (int it = gw; it < I_L; it += NGW) conv_item(A, ws, 0, it, scr, F.lane);
    float* modp = (float*)(ws + WS_MODP);
    for (int it = gw; it < DEPTH * 48 * 8; it += NGW) {
        const int L = it / 384, r = it % 384, nb = r / 8, ks = r % 8, k0 = ks * 256;
        f32x4 c0 = *(const f32x4*)(A.inp(1) + k0 + 4 * F.lane), c1 = *(const f32x4*)(A.inp(3) + k0 + 4 * F.lane);
#pragma unroll
        for (int i = 0; i < 4; ++i) { c0[i] = siluf(c0[i]); c1[i] = siluf(c1[i]); }
        f32x4 a0 = {0.f, 0.f, 0.f, 0.f}, a1 = {0.f, 0.f, 0.f, 0.f};
        const float* wp = A.inp(4) + ((size_t)(L * DM + k0)) * (6 * DM) + nb * 256 + 4 * F.lane;
#pragma unroll 2
        for (int q = 0; q < 64; ++q) {
#pragma unroll
            for (int i = 0; i < 4; ++i) {
                const float s0 = __uint_as_float(__builtin_amdgcn_readlane(__float_as_uint(c0[i]), q)), s1 = __uint_as_float(__builtin_amdgcn_readlane(__float_as_uint(c1[i]), q));
                const f32x4 w = *(const f32x4*)(wp + (size_t)(4 * q + i) * (6 * DM));
                a0 += s0 * w; a1 += s1 * w; }
        }
        *(f32x4*)(modp + ((size_t)((L * 8 + ks) * 2 + 0)) * (6 * DM) + nb * 256 + 4 * F.lane) = a0;
        *(f32x4*)(modp + ((size_t)((L * 8 + ks) * 2 + 1)) * (6 * DM) + nb * 256 + 4 * F.lane) = a1;
    }
    { const int gt = F.bid * 512 + F.tid, NT = F.G * 512; f32x4* X4 = (f32x4*)(ws + WS_X);
      const f32x4* c4 = (const f32x4*)A.inp(2); const f32x4* x4 = (const f32x4*)A.inp(0);
      constexpr int NC4 = TC * DM / 4, NA4 = TA * DM / 4;
      for (int i = gt; i < NA4; i += NT) X4[i] = (i < NC4) ? c4[i] : x4[i - NC4]; }
    { const int gt = F.bid * 512 + F.tid; if (gt < 128 * 48) { const int pos = gt / 48, f = gt % 48;
        const float fr = (f < 16) ? powf(10000.f, -(float)f / 16.f) : powf(10000.f, -(float)(f - 16) / 32.f);
        float s, c; sincos_small((float)pos * fr, s, c); ((f32x2*)(ws + WS_ROPE))[gt] = (f32x2){c, s}; } }
}
__device__ __forceinline__ void ph_modf(const Fr& F0, const PArgs& A) {
    const Fr F = fr_refresh(F0);
    const float* modp = (const float*)(A.wsp() + WS_MODP); float* modf = (float*)(A.wsp() + WS_MODF);
    for (int i = F.bid * 512 + F.tid; i < DEPTH * 2 * 6 * DM; i += F.G * 512) {
        const int L = i / (2 * 6 * DM), r = i % (2 * 6 * DM), cd = r / (6 * DM), n = r % (6 * DM);
        float s = A.inp(5)[L * 6 * DM + n];
#pragma unroll
        for (int ks = 0; ks < 8; ++ks) s += modp[((size_t)((L * 8 + ks) * 2 + cd)) * (6 * DM) + n];
        modf[i] = s; }
}

template <bool DTP>
__device__ __forceinline__ void ph_norm(const Fr& F0, float* X, bf16_t* XN, const float* nw, const float* mod_lat, const float* mod_ctx, int sh_off, int sc_off,
                                        const float* win_layer, const float* dt_bias, float* DT, const float* part, int nsl, const float* gate_ctx) {
    const Fr F = fr_refresh(F0);
    LAS float* AL = (LAS float*)F.lds; LAS float* BL = AL + DM; LAS float* WDT = BL + DM;
    for (int k = F.tid; k < DM; k += 512) { AL[k] = nw[k] * (1.f + mod_lat[sc_off + k]); BL[k] = mod_lat[sh_off + k]; }
    if (DTP) {
        f32x4 wv[4][4];
#pragma unroll
        for (int kk = 0; kk < 4; ++kk)
#pragma unroll
            for (int q = 0; q < 4; ++q) wv[kk][q] = *(const f32x4*)(win_layer + (size_t)(F.tid + 512 * kk) * NIN + C_DT + 4 * q);
#pragma unroll
        for (int kk = 0; kk < 4; ++kk)
#pragma unroll
            for (int q = 0; q < 4; ++q)
#pragma unroll
                for (int e = 0; e < 4; ++e) WDT[(4 * q + e) * DM + F.tid + 512 * kk] = wv[kk][q][e]; }
    __syncthreads();
    const int gw = F.bid * NWAVES + F.wave, NGW = F.G * NWAVES, lane = F.lane;
    for (int row = gw; row < TA; row += NGW) {
        const f32x4* xr = (const f32x4*)(X + (size_t)row * DM) + lane;
        f32x4 v[8]; float ss = 0.f;
        const bool isctx = row < TC;
#pragma unroll
        for (int j = 0; j < 8; ++j) v[j] = xr[64 * j];
        if (isctx && nsl > 0) {
            f32x4* xw = (f32x4*)(X + (size_t)row * DM) + lane;
#pragma unroll
            for (int hf = 0; hf < 2; ++hf) { f32x4 acc4[4];
#pragma unroll
                for (int j = 0; j < 4; ++j) acc4[j] = (f32x4){0.f, 0.f, 0.f, 0.f};
                for (int s0 = 0; s0 < nsl; s0 += 4) { f32x4 t[4][4];
#pragma unroll
                    for (int u = 0; u < 4; ++u) { const int s = min(s0 + u, nsl - 1); const f32x4* pr = (const f32x4*)(part + ((size_t)s * TC + row) * DM) + lane + 256 * hf;
#pragma unroll
                        for (int j = 0; j < 4; ++j) t[u][j] = pr[64 * j]; }
#pragma unroll
                    for (int u = 0; u < 4; ++u) { const bool ok = s0 + u < nsl;
#pragma unroll
                        for (int j = 0; j < 4; ++j) acc4[j] = ok ? acc4[j] + t[u][j] : acc4[j]; } }
#pragma unroll
                for (int j = 0; j < 4; ++j) { v[4 * hf + j] += *(const f32x4*)(gate_ctx + 4 * lane + 256 * (4 * hf + j)) * acc4[j]; xw[64 * (4 * hf + j)] = v[4 * hf + j]; } } }
#pragma unroll
        for (int j = 0; j < 8; ++j) ss += (v[j].x * v[j].x + v[j].y * v[j].y) + (v[j].z * v[j].z + v[j].w * v[j].w);
        const float rs = 1.0f / sqrtf(wave_sum(ss) * (1.f / DM) + NEPS);
        v2u* o8 = (v2u*)(XN + (size_t)row * DM) + lane;
#pragma unroll
        for (int j = 0; j < 8; ++j) { const int k = 4 * lane + 256 * j; f32x4 a4, b4;
            if (isctx) { const f32x4 w4 = *(const f32x4*)(nw + k), s4 = *(const f32x4*)(mod_ctx + sc_off + k); a4 = w4 * (1.f + s4); b4 = *(const f32x4*)(mod_ctx + sh_off + k); }
            else { a4 = *(const LAS f32x4*)(AL + k); b4 = *(const LAS f32x4*)(BL + k); }
            v[j] = v[j] * rs * a4 + b4;
            v2u o; o.x = pk2(v[j].x, v[j].y); o.y = pk2(v[j].z, v[j].w); o8[64 * j] = o; }
        if (DTP) {
            float acc[16];
#pragma unroll
            for (int jj = 0; jj < 16; ++jj) acc[jj] = 0.f;
            const LAS float* W0 = WDT + 4 * lane; const LAS float* W1 = W0 + 8 * DM; asm volatile("" : "+v"(W1));
#pragma unroll
            for (int j = 0; j < 8; ++j)
#pragma unroll
                for (int jj = 0; jj < 16; ++jj) { const f32x4 w4 = *(const LAS f32x4*)((jj < 8 ? W0 : W1) + (jj & 7) * DM + 256 * j);
                    acc[jj] += (v[j].x * w4.x + v[j].y * w4.y) + (v[j].z * w4.z + v[j].w * w4.w); }
            float r8[8], r4[4], r2[2], r1;
#pragma unroll
            for (int i = 0; i < 8; ++i) { const bool up = (lane & 32) != 0; const float keep = up ? acc[i + 8] : acc[i], send = up ? acc[i] : acc[i + 8]; r8[i] = keep + shx(send, 32); }
#pragma unroll
            for (int i = 0; i < 4; ++i) { const bool up = (lane & 16) != 0; const float keep = up ? r8[i + 4] : r8[i], send = up ? r8[i] : r8[i + 4]; r4[i] = keep + shx(send, 16); }
#pragma unroll
            for (int i = 0; i < 2; ++i) { const bool up = (lane & 8) != 0; const float keep = up ? r4[i + 2] : r4[i], send = up ? r4[i] : r4[i + 2]; r2[i] = keep + shx(send, 8); }
            { const bool up = (lane & 4) != 0; const float keep = up ? r2[1] : r2[0], send = up ? r2[0] : r2[1]; r1 = keep + shx(send, 4); }
            r1 += shx(r1, 2); r1 += shx(r1, 1);
            const int col = ((lane >> 5) & 1) * 8 + ((lane >> 4) & 1) * 4 + ((lane >> 3) & 1) * 2 + ((lane >> 2) & 1);
            if ((lane & 3) == 0) DT[(size_t)row * 16 + col] = softplusf(r1 + dt_bias[col]);
        }
    }
    __syncthreads();
}

__device__ __forceinline__ void prep_rope_unit(const Fr& F, const PArgs& A, int L, int unit) {
    unsigned char* ws = A.wsp(); const int lane = F.lane;
    const bf16_t* P = (const bf16_t*)(ws + WS_P); bf16_t* QB = (bf16_t*)(ws + WS_QB); bf16_t* KB = (bf16_t*)(ws + WS_KB);
    const f32x2* RT = (const f32x2*)(ws + WS_ROPE);
    const float* qn = A.inp(12) + L * 128; const float* kn = A.inp(13) + L * 128;
    for (int i = 0; i < 8; ++i) {
        const int r = unit * 64 + F.wave * 8 + i; const bool lat = r >= TC; const int t = r - TC, prow = lat ? (t >> 6) : 0, pcol = lat ? (t & 63) : 0;
        const bf16_t* pr = P + (size_t)r * NP;
        {   const int hd = lane >> 3, o = (lane & 7) * 8, axis = o >> 5, p = o & 31, fi = p & 15; const bool first = p < 16; const int pos = axis ? pcol : prow;
            float xq[8], xk[8], yq[8], yk[8];
            unpack8(*(const v4u*)(pr + C_DAQ + 8 * lane), xq); unpack8(*(const v4u*)(pr + C_DAK + 8 * lane), xk);
#pragma unroll
            for (int e = 0; e < 8; ++e) { const float pq = shx(xq[e], 2), pk = shx(xk[e], 2);
                f32x2 cs = lat ? RT[pos * 48 + fi + e] : (f32x2){1.f, 0.f};
                const float sg = first ? -cs.y : cs.y;
                yq[e] = (xq[e] * cs.x + pq * sg) * 1.41421356237f; yk[e] = xk[e] * cs.x + pk * sg; }
            bf16_t* qd = QB + (size_t)r * QLD + hd * 128; const int m = hd & 1;
            *(v4u*)(qd + m * 64 + o) = pack8(yq); { unsigned zz = 0u; asm volatile("" : "+v"(zz)); *(v4u*)(qd + (1 - m) * 64 + o) = (v4u){zz, zz, zz, zz}; }
            *(v4u*)(KB + (size_t)r * KLD + 8 * lane) = pack8(yk);
        }
        {   const int o = (lane & 15) * 8, axis = o >> 6, p = o & 63, fi = p & 31; const bool first = p < 32; const int pos = axis ? pcol : prow;
            const int lk = lane & 31;
            float xq[8], xk[8], yq[8], yk[8];
            unpack8(*(const v4u*)(pr + C_GQ + 8 * lane), xq); unpack8(*(const v4u*)(pr + C_GK + 8 * lk), xk);
            float sq = 0.f, sk = 0.f;
#pragma unroll
            for (int e = 0; e < 8; ++e) { sq += xq[e] * xq[e]; sk += xk[e] * xk[e]; }
#pragma unroll
            for (int s = 1; s < 16; s <<= 1) { sq += shx(sq, s); sk += shx(sk, s); }
            const float rq = 1.0f / sqrtf(sq * (1.f / 128.f) + NEPS), rk = 1.0f / sqrtf(sk * (1.f / 128.f) + NEPS);
#pragma unroll
            for (int e = 0; e < 8; ++e) { xq[e] = xq[e] * rq * qn[o + e]; xk[e] = xk[e] * rk * kn[o + e]; }
#pragma unroll
            for (int e = 0; e < 8; ++e) { const float pq = shx(xq[e], 4), pk = shx(xk[e], 4);
                f32x2 cs = lat ? RT[pos * 48 + 16 + fi + e] : (f32x2){1.f, 0.f};
                const float sg = first ? -cs.y : cs.y;
                yq[e] = xq[e] * cs.x + pq * sg; yk[e] = xk[e] * cs.x + pk * sg; }
            *(v4u*)(QB + (size_t)r * QLD + 1024 + 8 * lane) = pack8(yq);
            if (lane < 32) *(v4u*)(KB + (size_t)r * KLD + 512 + 8 * lane) = pack8(yk);
        }
    }
}

__device__ __forceinline__ void prep_lru_unit(const Fr& F, const PArgs& A, int L, int unit) {
    unsigned char* ws = A.wsp(); const int lane = F.lane, tid = F.tid, c64 = unit >> 2, blk = unit & 3, r0 = c64 * 64;
    const int seg_lo = (r0 < TC) ? 0 : TC, seg_hi = (r0 < TC) ? TC : TA;
    const bf16_t* P = (const bf16_t*)(ws + WS_P);
    LAS float* XCv = (LAS float*)F.lds;
    LAS f32x2* AU = (LAS f32x2*)(F.lds + 64 * 132 * 4);
    const float* cw = A.inp(14) + (size_t)L * 4 * 512 + blk * 128; const float* cb = A.inp(15) + L * 512 + blk * 128;
    {
        const int tk = tid >> 3, c0 = (tid & 7) * 16, r = r0 + tk;
        float acc[16];
#pragma unroll
        for (int e = 0; e < 16; ++e) acc[e] = cb[c0 + e];
#pragma unroll
        for (int k = 0; k < 4; ++k) { const int rr = r + k - 2; if (rr >= seg_lo && rr < seg_hi) {
            const bf16_t* src = P + (size_t)rr * NP + C_LX + blk * 128 + c0; float x0[8], x1[8]; unpack8(*(const v4u*)src, x0); unpack8(*(const v4u*)(src + 8), x1);
#pragma unroll
            for (int e = 0; e < 8; ++e) { acc[e] += cw[k * 512 + c0 + e] * x0[e]; acc[8 + e] += cw[k * 512 + c0 + 8 + e] * x1[e]; } } }
#pragma unroll
        for (int e = 0; e < 16; e += 4) *(LAS f32x4*)(XCv + tk * 132 + c0 + e) = (f32x4){acc[e], acc[e + 1], acc[e + 2], acc[e + 3]};
    }
    __syncthreads();
    const int w = F.wave, fr = lane & 15, fq = lane >> 4;
    bf16x8 af[4][4];
#pragma unroll
    for (int m = 0; m < 4; ++m)
#pragma unroll
        for (int ks = 0; ks < 4; ++ks) { const LAS float* s = XCv + (16 * m + fr) * 132 + 32 * ks + 8 * fq; const f32x4 a = *(const LAS f32x4*)s, b = *(const LAS f32x4*)(s + 4);
            v4u wv; wv.x = pk2(a.x, a.y); wv.y = pk2(a.z, a.w); wv.z = pk2(b.x, b.y); wv.w = pk2(b.z, b.w); af[m][ks] = __builtin_bit_cast(bf16x8, wv); }
    const bf16_t* WG = (const bf16_t*)(ws + WS_WG) + (size_t)L * 16 * 16384;
    const int ch = 16 * w + fr, chg = blk * 128 + ch;
    for (int dir = 0; dir < 2; ++dir) {
        const bf16_t* Wr = WG + (size_t)((dir * 2 + 0) * 4 + blk) * 16384 + (size_t)ch * 128 + 8 * fq;
        const bf16_t* Wi = WG + (size_t)((dir * 2 + 1) * 4 + blk) * 16384 + (size_t)ch * 128 + 8 * fq;
        f32x4 ar[4], ai[4];
#pragma unroll
        for (int m = 0; m < 4; ++m) { ar[m] = (f32x4){0.f, 0.f, 0.f, 0.f}; ai[m] = (f32x4){0.f, 0.f, 0.f, 0.f}; }
#pragma unroll
        for (int ks = 0; ks < 4; ++ks) { const bf16x8 br = *(const bf16x8*)(Wr + 32 * ks), bi = *(const bf16x8*)(Wi + 32 * ks);
#pragma unroll
            for (int m = 0; m < 4; ++m) { ar[m] = MFMA16(af[m][ks], br, ar[m]); ai[m] = MFMA16(af[m][ks], bi, ai[m]); } }
        const float bgr = A.inp(17)[((size_t)(L * 2 + dir) * 2 + 0) * 512 + chg], bgi = A.inp(17)[((size_t)(L * 2 + dir) * 2 + 1) * 512 + chg];
        const float lam = A.inp(18)[(size_t)(L * 2 + dir) * 512 + chg];
        const float lsg = fminf(lam, 0.f) - log1pf(__expf(-fabsf(lam)));
#pragma unroll
        for (int m = 0; m < 4; ++m)
#pragma unroll
            for (int rg = 0; rg < 4; ++rg) { const int tok = 16 * m + 4 * fq + rg;
                const float rr = sigmf(ar[m][rg] + bgr), ii = sigmf(ai[m][rg] + bgi);
                const float log_a = 8.0f * rr * lsg, a = __expf(log_a), beta = sqrtf(fmaxf(-expm1f(2.f * log_a), 0.f));
                AU[tok * 128 + ch] = (f32x2){a, beta * (ii * XCv[tok * 132 + ch])}; }
        __syncthreads();
        if (tid < 128) {
            float* Hb = (float*)(ws + (dir ? WS_HB : WS_HF)); float* Pb = (float*)(ws + (dir ? WS_PB : WS_PF));
            float h = 0.f, pr = 1.f;
            for (int s = 0; s < 64; ++s) { const int tok = dir ? 63 - s : s; const f32x2 au = AU[tok * 128 + tid];
                h = au.x * h + au.y; pr *= au.x;
                const size_t o = (size_t)(r0 + tok) * 512 + blk * 128 + tid; Hb[o] = h; Pb[o] = pr; }
            float* LS = (float*)(ws + WS_LSUM) + ((size_t)(dir * 132 + c64) * 2) * 512 + blk * 128 + tid;
            LS[0] = pr; LS[512] = h;
        }
        __syncthreads();
    }
}

constexpr int SLD = 136, XLD = 72;
typedef short v4i16_t __attribute__((ext_vector_type(4)));
__device__ __forceinline__ bf16x8 lds_tr_frag(const LAS bf16_t* img, int ld, int r0, int c0, int fr, int fq) {
    const LAS bf16_t* p = img + (r0 + 8 * fq + (fr >> 2)) * ld + c0 + 4 * (fr & 3);
    const v4i16_t lo = __builtin_amdgcn_ds_read_tr16_b64_v4i16((LAS v4i16_t*)p), hi = __builtin_amdgcn_ds_read_tr16_b64_v4i16((LAS v4i16_t*)(p + 4 * ld));
    return (bf16x8){lo[0], lo[1], lo[2], lo[3], hi[0], hi[1], hi[2], hi[3]};
}
__device__ __forceinline__ void prep_ssd_unit(const Fr& F, const PArgs& A, int L, int unit) {
    unsigned char* ws = A.wsp(); const int lane = F.lane, tid = F.tid, c = unit >> 3, h = unit & 7, g = h >> 2, r0 = c * 128;
    const int seg_lo = (r0 < TC) ? 0 : TC, seg_hi = (r0 < TC) ? TC : TA;
    const bf16_t* P = (const bf16_t*)(ws + WS_P);
    LAS bf16_t* CG = (LAS bf16_t*)F.lds;
    LAS bf16_t* BG = CG + 128 * SLD;
    LAS bf16_t* XS = BG + 128 * SLD;
    LAS float* VEC = (LAS float*)(XS + 128 * XLD);
    LAS float* AFv = VEC, *ABv = VEC + 128, *DTF = VEC + 256, *DTB = VEC + 384, *WFv = VEC + 512, *WBv = VEC + 640;
    if (F.wave == 0) {
        const float* DT = (const float*)(ws + WS_DT);
        const float a_f = -__expf(A.inp(22)[(L * 2 + 0) * 8 + h]), a_b = -__expf(A.inp(22)[(L * 2 + 1) * 8 + h]);
        const int t0 = 2 * lane;
        const float bf_ = A.inp(21)[L * 16 + h], bb_ = A.inp(21)[L * 16 + 8 + h];
        const float df0 = softplusf(DT[(size_t)(r0 + t0) * 16 + h] + bf_), df1 = softplusf(DT[(size_t)(r0 + t0 + 1) * 16 + h] + bf_), db0 = softplusf(DT[(size_t)(r0 + t0) * 16 + 8 + h] + bb_), db1 = softplusf(DT[(size_t)(r0 + t0 + 1) * 16 + 8 + h] + bb_);
        const float xf0 = df0 * a_f, xf1 = df1 * a_f, xb0 = db0 * a_b, xb1 = db1 * a_b;
        float sf = xf0 + xf1, sb = xb0 + xb1;
#pragma unroll
        for (int o = 1; o < 64; o <<= 1) { const float uf = shup(sf, o), ub = shdn(sb, o); if (lane >= o) sf += uf; if (lane + o < 64) sb += ub; }
        const float af1 = sf, af0 = sf - xf1;
        const float ab0 = sb, ab1 = sb - xb0;
        const float aft = shidx(sf, 63), abt = shidx(sb, 0);
        AFv[t0] = af0; AFv[t0 + 1] = af1; ABv[t0] = ab0; ABv[t0 + 1] = ab1; DTF[t0] = df0; DTF[t0 + 1] = df1; DTB[t0] = db0; DTB[t0 + 1] = db1;
        WFv[t0] = __expf(aft - af0) * df0; WFv[t0 + 1] = __expf(aft - af1) * df1; WBv[t0] = __expf(abt - ab0) * db0; WBv[t0 + 1] = __expf(abt - ab1) * db1;
        float* AC = (float*)(ws + WS_ACUM);
        AC[(size_t)(r0 + t0) * 16 + h] = af0; AC[(size_t)(r0 + t0 + 1) * 16 + h] = af1; AC[(size_t)(r0 + t0) * 16 + 8 + h] = ab0; AC[(size_t)(r0 + t0 + 1) * 16 + 8 + h] = ab1;
        if (lane == 0) { float* CH = (float*)(ws + WS_CHA); CH[(c * 2 + 0) * 8 + h] = aft; CH[(c * 2 + 1) * 8 + h] = abt; }
    }
    const float* cw = A.inp(19) + (size_t)L * 4 * 1024; const float* cb = A.inp(20) + (size_t)L * 1024;
    bf16_t* XCg = (bf16_t*)(ws + WS_XC);
    for (int id = tid; id < 640; id += 512) {
        const int cgp = id % 40, t0 = (id / 40) * 8;
        int ccol, off, ld; LAS bf16_t* img;
        if (cgp < 8) { off = cgp * 8; ccol = 64 * h + off; img = XS; ld = XLD; } else if (cgp < 24) { off = (cgp - 8) * 8; ccol = 512 + 128 * g + off; img = BG; ld = SLD; } else { off = (cgp - 24) * 8; ccol = 768 + 128 * g + off; img = CG; ld = SLD; }
        const bool cglob = (cgp >= 24) && ((h & 3) == 0);
        float wk[4][8], bb[8];
#pragma unroll
        for (int e = 0; e < 8; ++e) { bb[e] = cb[ccol + e];
#pragma unroll
            for (int k = 0; k < 4; ++k) wk[k][e] = cw[k * 1024 + ccol + e]; }
        const bf16_t* src = P + (size_t)(r0 + t0) * NP + C_SX + ccol;
        float wn[4][8];
#pragma unroll
        for (int j = 0; j < 3; ++j) { const int rr = r0 + t0 + j - 2;
            if (rr >= seg_lo && rr < seg_hi) unpack8(*(const v4u*)(src + (ptrdiff_t)(j - 2) * NP), wn[j]);
            else {
#pragma unroll
                for (int e = 0; e < 8; ++e) wn[j][e] = 0.f; } }
#pragma unroll
        for (int t = 0; t < 8; ++t) { const int rr = r0 + t0 + t + 1;
            if (rr < seg_hi) unpack8(*(const v4u*)(src + (ptrdiff_t)(t + 1) * NP), wn[3]);
            else {
#pragma unroll
                for (int e = 0; e < 8; ++e) wn[3][e] = 0.f; }
            float o8[8];
#pragma unroll
            for (int e = 0; e < 8; ++e) { const float sv = bb[e] + wk[0][e] * wn[0][e] + wk[1][e] * wn[1][e] + wk[2][e] * wn[2][e] + wk[3][e] * wn[3][e];
                o8[e] = siluf(sv); wn[0][e] = wn[1][e]; wn[1][e] = wn[2][e]; wn[2][e] = wn[3][e]; }
            const v4u pv = pack8(o8);
            *(LAS v4u*)(img + (t0 + t) * ld + off) = pv;
            if (cglob) *(v4u*)(XCg + (size_t)(r0 + t0 + t) * 256 + 128 * g + off) = pv; }
    }
    __syncthreads();
    const int w = F.wave, fr = lane & 15, fq = lane >> 4;
    {
        bf16x8 ca[4];
#pragma unroll
        for (int ks = 0; ks < 4; ++ks) ca[ks] = *(const LAS bf16x8*)(CG + (16 * w + fr) * SLD + 32 * ks + 8 * fq);
        float afl[4], abl[4];
#pragma unroll
        for (int rg = 0; rg < 4; ++rg) { afl[rg] = AFv[16 * w + 4 * fq + rg]; abl[rg] = ABv[16 * w + 4 * fq + rg]; }
#pragma unroll 2
        for (int st = 0; st < 8; ++st) { f32x4 gacc = {0.f, 0.f, 0.f, 0.f};
#pragma unroll
            for (int ks = 0; ks < 4; ++ks) { const bf16x8 bfr = *(const LAS bf16x8*)(BG + (16 * st + fr) * SLD + 32 * ks + 8 * fq); gacc = MFMA16(ca[ks], bfr, gacc); }
            const int s = 16 * st + fr; const float afs = AFv[s], abs_ = ABv[s], dfs = DTF[s], dbs = DTB[s];
#pragma unroll
            for (int rg = 0; rg < 4; ++rg) { const int l = 16 * w + 4 * fq + rg; float f;
                if (s < l) f = __expf(afl[rg] - afs) * dfs; else if (s > l) f = __expf(abl[rg] - abs_) * dbs; else f = dfs + dbs;
                CG[l * SLD + s] = (bf16_t)f2bf(gacc[rg] * f); } }
    }
    __syncthreads();
    {
        bf16x8 ma[4];
#pragma unroll
        for (int ks = 0; ks < 4; ++ks) ma[ks] = *(const LAS bf16x8*)(CG + (16 * w + fr) * SLD + 32 * ks + 8 * fq);
        const float Dh = A.inp(23)[L * 8 + h]; float* YD = (float*)(ws + WS_YD);
#pragma unroll
        for (int pt = 0; pt < 4; ++pt) { f32x4 acc = {0.f, 0.f, 0.f, 0.f};
#pragma unroll
            for (int ks = 0; ks < 4; ++ks) { const bf16x8 xb = lds_tr_frag(XS, XLD, 32 * ks, 16 * pt, fr, fq); acc = MFMA16(ma[ks], xb, acc); }
#pragma unroll
            for (int rg = 0; rg < 4; ++rg) { const int l = 16 * w + 4 * fq + rg, p = 16 * pt + fr;
                YD[(size_t)(r0 + l) * 512 + 64 * h + p] = acc[rg] + Dh * bf1(XS[l * XLD + p]); } }
    }
    {
        const int d = w >> 2, ptile = w & 3; const LAS float* Wv = d ? WBv : WFv;
        bf16x8 xa[4];
#pragma unroll
        for (int ks = 0; ks < 4; ++ks) { float x8[8]; unpack8(__builtin_bit_cast(v4u, lds_tr_frag(XS, XLD, 32 * ks, 16 * ptile, fr, fq)), x8);
            const f32x4 w0 = *(const LAS f32x4*)(Wv + 32 * ks + 8 * fq), w1 = *(const LAS f32x4*)(Wv + 32 * ks + 8 * fq + 4);
            x8[0] *= w0.x; x8[1] *= w0.y; x8[2] *= w0.z; x8[3] *= w0.w; x8[4] *= w1.x; x8[5] *= w1.y; x8[6] *= w1.z; x8[7] *= w1.w;
            xa[ks] = __builtin_bit_cast(bf16x8, pack8(x8)); }
        float* ST = (float*)(ws + WS_ST) + ((size_t)((c * 2 + d) * 8 + h)) * 8192;
#pragma unroll 2
        for (int nt = 0; nt < 8; ++nt) { f32x4 acc = {0.f, 0.f, 0.f, 0.f};
#pragma unroll
            for (int ks = 0; ks < 4; ++ks) { const bf16x8 bb2 = lds_tr_frag(BG, SLD, 32 * ks, 16 * nt, fr, fq); acc = MFMA16(xa[ks], bb2, acc); }
#pragma unroll
            for (int rg = 0; rg < 4; ++rg) ST[(16 * ptile + 4 * fq + rg) * 128 + 16 * nt + fr] = acc[rg]; }
    }
    __syncthreads();
}

__device__ __forceinline__ void ph_prep(const Fr& F0, const PArgs& A, int L) {
    const Fr F = fr_refresh(F0);
    constexpr int N_SSD = 66 * 8, N_LRU = 132 * 4, N_ROPE = TA / 64;
    for (int u = F.vcu; u < N_SSD + N_LRU + N_ROPE; u += F.G) {
        if (u < N_SSD) { if (SUBM & 1) prep_ssd_unit(F, A, L, u); }
        else if (u < N_SSD + N_LRU) { if (SUBM & 2) prep_lru_unit(F, A, L, u - N_SSD); }
        else { if (SUBM & 4) prep_rope_unit(F, A, L, u - N_SSD - N_LRU); }
    }
}

__device__ __forceinline__ void ph_state_scan(const Fr& F0, const PArgs& A) {
    const Fr F = fr_refresh(F0);
    unsigned char* ws = A.wsp(); const float* ST = (const float*)(ws + WS_ST); bf16_t* SIN = (bf16_t*)(ws + WS_SIN); unsigned* CH = (unsigned*)(ws + WS_CHA);
    for (int e = F.bid * 512 + F.tid; e < 2 * 65536; e += F.G * 512) {
        const int d = e >> 16, rest = e & 65535, h = rest >> 13;
        float run = 0.f;
#pragma unroll 6
        for (int i = 0; i < 66; ++i) { const int c = d ? (i == 0 ? 1 : (i == 1 ? 0 : 67 - i)) : i; const size_t o = ((size_t)(c * 2 + d) << 16) + rest;
            SIN[o] = (bf16_t)f2bf(run);
            const float dec = __expf(__uint_as_float(__hip_atomic_load(CH + (c * 2 + d) * 8 + h, RLX_AGENT)));
            run = dec * run + ST[o]; }
    }
}
__device__ __forceinline__ void ph_attn(const Fr& F0, const PArgs& A, int L) {
    const Fr F = fr_refresh(F0);
    unsigned char* ws = A.wsp();
    const att::bf16* QB = (const att::bf16*)(ws + WS_QB); const att::bf16* KB = (const att::bf16*)(ws + WS_KB); const att::bf16* P = (const att::bf16*)(ws + WS_P);
    const int nunits = 768 + (L < DEPTH - 1 ? 12 : 0);
    for (int u = F.vcu; u < nunits; u += F.G) {
        int vh, row0, seq, kh, k0;
        if (u < 768) { const int v = (u < 512) ? u : u - 512; vh = ((u < 512) ? 0 : 8) + (v >> 6); row0 = TC + 256 * ((v & 63) >> 1); kh = v & 1; seq = TA / 2; k0 = kh * (TA / 2); }
        else { vh = u - 768; row0 = 0; seq = TC; kh = 0; k0 = 0; }
        const int kvh = vh >> 1;
        const att::bf16* Vh = P + (size_t)k0 * NP + (kvh < 4 ? C_DAV + 128 * kvh : C_GV + 128 * (kvh - 4));
        const att::bf16* Kh = KB + (size_t)k0 * KLD + kvh * 128;
        float* Ob = (float*)(ws + (kh ? WS_OP1 : WS_O)) + (size_t)row0 * QLD + vh * 128;
        float* ML = (float*)(ws + WS_ML) + ((size_t)(kh * TA + row0) * 12 + vh) * 2;
        if (vh < 8) { const int m = vh & 1; att::attn_dense_body<att::bf16, 4, true>(QB + (size_t)row0 * QLD + vh * 128 + 64 * m, Kh, Vh, Ob, seq, F.ldsg, 128 * m, ML); }
        else att::attn_dense_body<att::bf16, 8, true>(QB + (size_t)row0 * QLD + vh * 128, Kh, Vh, Ob, seq, F.ldsg, 0, ML);
        __syncthreads();
    }
}

__device__ __forceinline__ void attn_combine8(const float* O0, const float* O1, const float* ML0, const float* ML1, size_t r, int vh, int c0, bool split, float (&o8)[8]) {
    const f32x4 a0 = *(const f32x4*)(O0 + r * QLD + vh * 128 + c0), a1 = *(const f32x4*)(O0 + r * QLD + vh * 128 + c0 + 4);
    const f32x2 mla = *(const f32x2*)(ML0 + (r * 12 + vh) * 2);
    if (split) {
        const f32x4 b0 = *(const f32x4*)(O1 + r * QLD + vh * 128 + c0), b1 = *(const f32x4*)(O1 + r * QLD + vh * 128 + c0 + 4);
        const f32x2 mlb = *(const f32x2*)(ML1 + (r * 12 + vh) * 2);
        const float m = fmaxf(mla.x, mlb.x), wa = __builtin_amdgcn_exp2f(mla.x - m), wb = __builtin_amdgcn_exp2f(mlb.x - m), inv = 1.0f / (mla.y * wa + mlb.y * wb), ka = wa * inv, kb = wb * inv;
        o8[0] = a0.x * ka + b0.x * kb; o8[1] = a0.y * ka + b0.y * kb; o8[2] = a0.z * ka + b0.z * kb; o8[3] = a0.w * ka + b0.w * kb;
        o8[4] = a1.x * ka + b1.x * kb; o8[5] = a1.y * ka + b1.y * kb; o8[6] = a1.z * ka + b1.z * kb; o8[7] = a1.w * ka + b1.w * kb;
    } else { const float inv = 1.0f / mla.y;
        o8[0] = a0.x * inv; o8[1] = a0.y * inv; o8[2] = a0.z * inv; o8[3] = a0.w * inv; o8[4] = a1.x * inv; o8[5] = a1.y * inv; o8[6] = a1.z * inv; o8[7] = a1.w * inv; }
}
__device__ __forceinline__ void fin_attn_unit(const Fr& F, const PArgs& A, int L, int unit, float lam, float lam_init) {
    unsigned char* ws = A.wsp(); const int lane = F.lane; bf16_t* Y = (bf16_t*)(ws + WS_YCAT);
    const float* O0 = (const float*)(ws + WS_O); const float* O1 = (const float*)(ws + WS_OP1); const float* ML0 = (const float*)(ws + WS_ML); const float* ML1 = ML0 + (size_t)TA * 24;
    const float* sub = A.inp(11) + L * 128;
    const bool split = unit >= TC / 64;
#pragma unroll 2
    for (int i = 0; i < 8; ++i) {
        const size_t r = (size_t)unit * 64 + F.wave * 8 + i;
        {   const int hh = lane >> 4, d0 = (lane & 15) * 8;
            float x1[8], x2[8], o8[8];
            attn_combine8(O0, O1, ML0, ML1, r, 2 * hh, d0, split, x1); attn_combine8(O0, O1, ML0, ML1, r, 2 * hh + 1, d0, split, x2);
            float ss = 0.f;
#pragma unroll
            for (int e = 0; e < 8; ++e) { o8[e] = x1[e] - lam * x2[e]; ss += o8[e] * o8[e]; }
#pragma unroll
            for (int s = 1; s < 16; s <<= 1) ss += shx(ss, s);
            const float rs = (1.0f / sqrtf(ss * (1.f / 128.f) + NEPS)) * (1.f - lam_init);
#pragma unroll
            for (int e = 0; e < 8; ++e) o8[e] = o8[e] * rs * sub[d0 + e];
            *(v4u*)(Y + r * DM + 128 * hh + d0) = pack8(o8); }
        {   float o8[8]; attn_combine8(O0, O1, ML0, ML1, r, 8 + (lane >> 4), (lane & 15) * 8, split, o8);
            *(v4u*)(Y + r * DM + 512 + 8 * lane) = pack8(o8); }
    }
}
__device__ __forceinline__ void fin_lru_unit(const Fr& F, const PArgs& A, int c64) {
    unsigned char* ws = A.wsp(); const int ch = F.tid;
    const float* LS = (const float*)(ws + WS_LSUM);
    float cf = 0.f, cbk = 0.f;
    for (int j0 = 0; j0 < c64; j0 += 8) { float a[8], hh[8];
#pragma unroll
        for (int k = 0; k < 8; ++k) { const int j = min(j0 + k, c64 - 1); a[k] = LS[((size_t)(0 * 132 + j) * 2) * 512 + ch]; hh[k] = LS[((size_t)(0 * 132 + j) * 2 + 1) * 512 + ch]; }
#pragma unroll
        for (int k = 0; k < 8; ++k) { const bool ok = j0 + k < c64; cf = ok ? a[k] * cf + hh[k] : cf; } }
    const int pos = (c64 < 4) ? 3 - c64 : 135 - c64;
    for (int i0 = 0; i0 < pos; i0 += 8) { float a[8], hh[8];
#pragma unroll
        for (int k = 0; k < 8; ++k) { const int i = min(i0 + k, pos - 1), j = (i < 4) ? 3 - i : 135 - i; a[k] = LS[((size_t)(1 * 132 + j) * 2) * 512 + ch]; hh[k] = LS[((size_t)(1 * 132 + j) * 2 + 1) * 512 + ch]; }
#pragma unroll
        for (int k = 0; k < 8; ++k) { const bool ok = i0 + k < pos; cbk = ok ? a[k] * cbk + hh[k] : cbk; } }
    const float* HF = (const float*)(ws + WS_HF); const float* PF = (const float*)(ws + WS_PF); const float* HB = (const float*)(ws + WS_HB); const float* PB = (const float*)(ws + WS_PB);
    const bf16_t* P = (const bf16_t*)(ws + WS_P); bf16_t* Y = (bf16_t*)(ws + WS_YCAT);
#pragma unroll 8
    for (int t = 0; t < 64; ++t) { const size_t r = (size_t)c64 * 64 + t, o = r * 512 + ch;
        const float hf = HF[o] + PF[o] * cf, hb = HB[o] + PB[o] * cbk, gg = bf1(P[r * NP + C_LG + ch]);
        Y[r * DM + 1024 + ch] = (bf16_t)f2bf((hf + hb) * gelu_tanh(gg)); }
}
constexpr int CLD = 264;
__device__ __forceinline__ void fin_ssd_unit(const Fr& F, const PArgs& A, int L, int c) {
    unsigned char* ws = A.wsp(); const int lane = F.lane, tid = F.tid, w = F.wave, fr = lane & 15, fq = lane >> 4, r0 = c * 128;
    LAS bf16_t* CI = (LAS bf16_t*)F.lds;
    LAS float* EF = (LAS float*)(CI + 128 * CLD);
    LAS bf16_t* SB = (LAS bf16_t*)(EF + 16 * 128);
    const bf16_t* XCg = (const bf16_t*)(ws + WS_XC); const float* AC = (const float*)(ws + WS_ACUM);
    const bf16_t* SIN = (const bf16_t*)(ws + WS_SIN) + (size_t)c * 2 * 65536; const float* YD = (const float*)(ws + WS_YD); const bf16_t* P = (const bf16_t*)(ws + WS_P);
    v4u sreg[4];
#define FIN_SLOAD(h) do { _Pragma("unroll") for (int i = 0; i < 4; ++i) { const int q = tid + 512 * i; sreg[i] = *(const v4u*)(SIN + ((size_t)(q >> 10) * 8 + (h)) * 8192 + (q & 1023) * 8); } } while (0)
#define FIN_SWRITE(buf) do { _Pragma("unroll") for (int i = 0; i < 4; ++i) { const int q = tid + 512 * i; *(LAS v4u*)(SB + (((buf) * 2 + (q >> 10)) * 64 + ((q >> 4) & 63)) * SLD + (q & 15) * 8) = sreg[i]; } } while (0)
    FIN_SLOAD(0);
    for (int id = tid; id < 128 * 32; id += 512) { const int t = id >> 5, q = id & 31; *(LAS v4u*)(CI + t * CLD + 8 * q) = *(const v4u*)(XCg + (size_t)(r0 + t) * 256 + 8 * q); }
    for (int id = tid; id < 128 * 16; id += 512) { const int t = id >> 4, j = id & 15; EF[j * 128 + t] = __expf(AC[(size_t)(r0 + t) * 16 + j]); }
    float ss[4] = {0.f, 0.f, 0.f, 0.f};
    const size_t rbase = (size_t)(r0 + 16 * w + 4 * fq);
    float* YDw = (float*)(ws + (FIN_INPLACE ? WS_YD : WS_YD2));
    const float* ydp[4]; const bf16_t* zp[4]; bf16_t* yp[4]; float* ywp[4];
#pragma unroll
    for (int rg = 0; rg < 4; ++rg) { ydp[rg] = YD + (rbase + rg) * 512 + fr; ywp[rg] = YDw + (rbase + rg) * 512 + fr; zp[rg] = P + (rbase + rg) * NP + C_SZ + fr; yp[rg] = (bf16_t*)(ws + WS_YCAT) + (rbase + rg) * DM + 1536 + fr; }
#pragma unroll 1
    for (int h = 0; h < 8; ++h) { const int g = h >> 2, buf = h & 1;
        FIN_SWRITE(buf);
        __syncthreads();
        if (h < 7) FIN_SLOAD(h + 1);
        float ydv[4][4]; bf16_t zv[4][4];
#pragma unroll
        for (int pt = 0; pt < 4; ++pt)
#pragma unroll
            for (int rg = 0; rg < 4; ++rg) { ydv[pt][rg] = ydp[rg][64 * h + 16 * pt]; zv[pt][rg] = zp[rg][64 * h + 16 * pt]; }
        bf16x8 ca[4];
#pragma unroll
        for (int ks = 0; ks < 4; ++ks) ca[ks] = *(const LAS bf16x8*)(CI + (16 * w + fr) * CLD + 128 * g + 32 * ks + 8 * fq);
        float ef[4], eb[4];
#pragma unroll
        for (int rg = 0; rg < 4; ++rg) { ef[rg] = EF[h * 128 + 16 * w + 4 * fq + rg]; eb[rg] = EF[(8 + h) * 128 + 16 * w + 4 * fq + rg]; }
        const LAS bf16_t* S0 = SB + ((buf * 2 + 0) * 64) * SLD; const LAS bf16_t* S1 = SB + ((buf * 2 + 1) * 64) * SLD;
#pragma unroll
        for (int pt = 0; pt < 4; ++pt) { f32x4 a0 = {0.f, 0.f, 0.f, 0.f}, a1 = {0.f, 0.f, 0.f, 0.f};
#pragma unroll
            for (int ks = 0; ks < 4; ++ks) { const bf16x8 b0 = *(const LAS bf16x8*)(S0 + (16 * pt + fr) * SLD + 32 * ks + 8 * fq), b1 = *(const LAS bf16x8*)(S1 + (16 * pt + fr) * SLD + 32 * ks + 8 * fq);
                a0 = MFMA16(ca[ks], b0, a0); a1 = MFMA16(ca[ks], b1, a1); }
#pragma unroll
            for (int rg = 0; rg < 4; ++rg) { float y = ydv[pt][rg] + ef[rg] * a0[rg] + eb[rg] * a1[rg]; y *= siluf(bf1(zv[pt][rg])); ywp[rg][64 * h + 16 * pt] = y; ss[rg] += y * y; } }
    }
#undef FIN_SLOAD
#undef FIN_SWRITE
    const float* nwp = A.inp(24) + L * 512 + fr;
#pragma unroll
    for (int rg = 0; rg < 4; ++rg) {
#pragma unroll
        for (int s = 1; s < 16; s <<= 1) ss[rg] += shx(ss[rg], s);
        ss[rg] = 1.0f / sqrtf(ss[rg] * (1.f / 512.f) + NEPS); }
#pragma unroll 1
    for (int c8 = 0; c8 < 4; ++c8) { float t[8][4]; float wv[8];
#pragma unroll
        for (int k = 0; k < 8; ++k) { wv[k] = nwp[16 * (8 * c8 + k)];
#pragma unroll
            for (int rg = 0; rg < 4; ++rg) t[k][rg] = ywp[rg][16 * (8 * c8 + k)]; }
#pragma unroll
        for (int k = 0; k < 8; ++k)
#pragma unroll
            for (int rg = 0; rg < 4; ++rg) yp[rg][16 * (8 * c8 + k)] = (bf16_t)f2bf(t[k][rg] * ss[rg] * wv[k]); }
    __syncthreads();
}
__device__ __forceinline__ void ph_finish(const Fr& F0, const PArgs& A, int L) {
    const Fr F = fr_refresh(F0);
    const float lam_init = 0.8f - 0.6f * expf(-0.3f * (float)L);
    const float* lv = A.inp(10) + L * 256;
    const float s1 = wave_sum(lv[F.lane] * lv[64 + F.lane]), s2 = wave_sum(lv[128 + F.lane] * lv[192 + F.lane]);
    const float lam = expf(s1) - expf(s2) + lam_init;
    const bool need_ctx = L < DEPTH - 1;
    constexpr int N_SSD = 66, N_LRU = 132, N_ATT = TA / 64;
    for (int u = F.vcu; u < N_SSD + N_LRU + N_ATT; u += F.G) {
        if (u < N_SSD) { if ((SUBM & 1) && (need_ctx || u >= 2)) fin_ssd_unit(F, A, L, u); }
        else if (u < N_SSD + N_LRU) { const int c64 = u - N_SSD; if ((SUBM & 2) && (need_ctx || c64 >= 4)) fin_lru_unit(F, A, c64); }
        else { const int un = u - N_SSD - N_LRU; if ((SUBM & 4) && (need_ctx || un >= 4)) fin_attn_unit(F, A, L, un, lam, lam_init); }
    }
}

__device__ __forceinline__ void act_fix_panel(const Fr& F0, const PArgs& A, int L, int P) {
    const Fr F = fr_refresh(F0);
    unsigned char* ws = A.wsp(); bf16_t* H = (bf16_t*)(ws + WS_H); const float* GB = (const float*)(ws + WS_GBND); const float* UB = (const float*)(ws + WS_UBND);
    const float* cw = A.inp(26) + (size_t)L * 3 * DFF; const float* cb = A.inp(27) + (size_t)L * DFF;
    constexpr int NCG = DFF / 4;
    for (int it = F.tid; it < 2 * NCG; it += 512) {
        const int lower = it / NCG, c = (it % NCG) * 4;
        if (lower == 0 ? (P < 2) : (P < 1 || P > 31)) continue;
        const f32x4 w0 = *(const f32x4*)(cw + c), w1 = *(const f32x4*)(cw + DFF + c), w2 = *(const f32x4*)(cw + 2 * DFF + c), bb = *(const f32x4*)(cb + c);
        f32x4 gm, g0, gp, uu; size_t row;
        if (lower) { gm = *(const f32x4*)(GB + ((size_t)P * 4 + 2) * DFF + c); g0 = *(const f32x4*)(GB + ((size_t)P * 4 + 3) * DFF + c); gp = *(const f32x4*)(GB + ((size_t)(P + 1) * 4 + 0) * DFF + c);
            uu = *(const f32x4*)(UB + ((size_t)P * 2 + 1) * DFF + c); row = (size_t)P * 256 + 255; }
        else { gm = *(const f32x4*)(GB + ((size_t)(P - 1) * 4 + 3) * DFF + c); g0 = *(const f32x4*)(GB + ((size_t)P * 4 + 0) * DFF + c); gp = *(const f32x4*)(GB + ((size_t)P * 4 + 1) * DFF + c);
            uu = *(const f32x4*)(UB + ((size_t)P * 2 + 0) * DFF + c); row = (size_t)P * 256; }
        const f32x4 gs = bb + w0 * gm + w1 * g0 + w2 * gp;
        v2u o; o.x = pk2(siluf(gs[0]) * uu[0], siluf(gs[1]) * uu[1]); o.y = pk2(siluf(gs[2]) * uu[2], siluf(gs[3]) * uu[3]);
        *(v2u*)(H + row * DFF + c) = o; }
    VM_WAIT(); __syncthreads();
}

__device__ __forceinline__ void ph_final(const Fr& F0, const PArgs& A) {
    const Fr F = fr_refresh(F0);
    const float* X = (const float*)(A.wsp() + WS_X) + (size_t)TC * DM; const float* nw = A.inp(29);
    const int gw = F.bid * NWAVES + F.wave, NGW = F.G * NWAVES, lane = F.lane;
    for (int row = gw; row < TL; row += NGW) {
        const f32x4* xr = (const f32x4*)(X + (size_t)row * DM) + lane; f32x4* orow = (f32x4*)(A.outp() + (size_t)row * DM) + lane;
        f32x4 v[8]; float ss = 0.f;
#pragma unroll
        for (int j = 0; j < 8; ++j) { v[j] = xr[64 * j]; ss += (v[j].x * v[j].x + v[j].y * v[j].y) + (v[j].z * v[j].z + v[j].w * v[j].w); }
        const float rs = 1.0f / sqrtf(wave_sum(ss) * (1.f / DM) + NEPS);
#pragma unroll
        for (int j = 0; j < 8; ++j) { const f32x4 w4 = *(const f32x4*)(nw + 4 * lane + 256 * j); orow[64 * j] = v[j] * rs * w4; }
    }
#if defined(PROBE_K)
    if (PROBE_K >= 0) { __syncthreads(); if (F.bid == 0 && F.tid == 0) { const unsigned long long tt = __hip_atomic_load((unsigned long long*)((unsigned*)(A.wsp() + WS_CTL) + 1000) + PROBE_K, RLX_AGENT);
        const float us = (float)tt * (PROBE_K < 9 ? 0.0025f : 0.01f); A.outp()[0] += 8.f * floorf(us * 0.125f) + 4.f; } }
#endif
}

constexpr int N_STEPS = 2 + 9 * DEPTH + 1;
#ifndef PH_MASK
#define PH_MASK 0xFFFF
#endif
#define PHE(b) ((PH_MASK >> (b)) & 1)
#ifndef DBL_MASK
#define DBL_MASK 0
#endif
#define NREP(b) (((DBL_MASK >> (b)) & 1) ? 2 : 1)
#ifndef SPLIT_OUT
#define SPLIT_OUT 8
#define SPLIT_DN 11
#endif
#ifndef MK_ONE_LAUNCH
#define MK_ONE_LAUNCH 1
#endif
__global__ void __launch_bounds__(NWAVES * 64, 2) mk_fwd(Args args) {
    extern __shared__ __attribute__((aligned(16))) unsigned char lds[];
    Fr F;
    F.lds = (LAS unsigned char*)lds; F.ldsg = (char*)lds;
    F.tid = 0; F.lane = 0; F.wave = 0;
    F.G = gridDim.x; F.bid = blockIdx.x; F.vcu = (F.G % 8 == 0) ? (F.bid % 8) * (F.G / 8) + F.bid / 8 : F.bid;
    volatile LAS unsigned* MISC = (volatile LAS unsigned*)(F.lds + MISC_OFF);
    for (int u = threadIdx.x; u < (LDS_BYTES - MISC_OFF) / 4; u += NWAVES * 64) ((LAS unsigned*)(F.lds + MISC_OFF))[u] = 0u;
    __syncthreads();
    if (threadIdx.x == 0) { LAS unsigned long long* tb = (LAS unsigned long long*)(F.lds + TBL_OFF);
#pragma unroll
        for (int i = 0; i < 30; ++i) tb[i] = (unsigned long long)args.in[i];
        tb[30] = (unsigned long long)args.out; tb[31] = (unsigned long long)args.ws; }
    if ((threadIdx.x & 63) == 0) { const unsigned h = (unsigned)__builtin_amdgcn_s_getreg((5 << 11) | 4) & 63u; ((LAS int*)(F.lds + WMAP_OFF))[h] = (int)(threadIdx.x >> 6); }
    __syncthreads();
    PArgs PA; PA.tbl = (LAS unsigned long long*)(F.lds + TBL_OFF);
    unsigned char* ws = args.ws;
    const int lo = args.s_lo, hi = args.s_hi;
    if (hi - lo > 1) (void)xcd_barrier_post((unsigned*)(ws + WS_CTL) + CW_BAR, MISC + 8);
#define IN(k) (lo <= (k) && (k) < hi)
#ifndef PROBE_K
#define PROBE_K -1
#endif
#define STAMP(type) do { if (PROBE_K >= 0 && blockIdx.x == 0 && tid_opaque() == 0) { const unsigned long long t = __builtin_amdgcn_s_memrealtime(); volatile LAS unsigned* tp = MISC + 16; \
    const unsigned long long t0 = ((unsigned long long)tp[1] << 32) | tp[0]; tp[0] = (unsigned)t; tp[1] = (unsigned)(t >> 32); \
    if (t0) atomicAdd((unsigned long long*)((unsigned*)(PA.wsp() + WS_CTL) + 1000) + (type), t - t0); } } while (0)
#define SEAM(k) do { if (IN(k) && IN((k) + 1)) { XcdBarrier b2; b2.bar = (unsigned*)(PA.wsp() + WS_CTL) + CW_BAR; b2.x = xb_xcc_id(); b2.st = MISC + 8; xcd_barrier(b2); } } while (0)

    if (PHE(0) && IN(0)) for (int rep = 0; rep < NREP(0); ++rep) { STAMP(15); ph_prologue(F, PA); } SEAM(0); STAMP(10);
    if (PHE(1) && IN(1)) { ph_modf(F, PA); } SEAM(1); STAMP(11);

    for (int L = 0; L < DEPTH; ++L) {
        const int s0 = 2 + 9 * L;
        { int z = 0; asm volatile("" : "+s"(z)); F.lds = (LAS unsigned char*)lds + z; F.ldsg = (char*)lds + z; PA.tbl = (LAS unsigned long long*)(F.lds + TBL_OFF); MISC = (volatile LAS unsigned*)(F.lds + MISC_OFF); }
        ws = PA.wsp();
        const float* modf = (const float*)(ws + WS_MODF); float* X = (float*)(ws + WS_X); bf16_t* XN = (bf16_t*)(ws + WS_XN);
        const float* mod_lat = modf + (size_t)(L * 2 + 0) * 6 * DM; const float* mod_ctx = modf + (size_t)(L * 2 + 1) * 6 * DM;
        const bool need_ctx = L < DEPTH - 1;
        const int rlo = need_ctx ? 0 : TC;
        if (PHE(2) && IN(s0 + 0)) for (int rep = 0; rep < NREP(2); ++rep) { ph_norm<false>(F, X, XN, PA.inp(6) + L * DM, mod_lat, mod_ctx, 0, DM, nullptr, nullptr, nullptr, (const float*)(ws + WS_PART), L > 0 ? SPLIT_DN : 0, modf + (size_t)((L > 0 ? L - 1 : 0) * 2 + 1) * 6 * DM + 5 * DM); }
        SEAM(s0 + 0); STAMP(0);
        if (PHE(3) && IN(s0 + 1)) for (int rep = 0; rep < NREP(3); ++rep) {
            pg8::Gemm g{XN, (const bf16_t*)(ws + WS_WIN) + (size_t)L * NPT * DM, TA, NPT, DM, DM}; pg8::StaticOrder S; { const Fr Fg = fr_refresh(F); S.init(TA, NPT, Fg.G, Fg.bid); }
            pg8::EpiInProj E{(bf16_t*)(ws + WS_P), NP, (float*)(ws + WS_DT), NP / 256};
            pg8::gemm_phase<pg8::EpiInProj, pg8::StaticOrder, true, true>(F.lds, g, S, E);
            if (L < DEPTH - 1) { const Fr Fg = fr_refresh(F); const int rem = ((TA / 256) * (NPT / 256)) % Fg.G;
                if (rem > 0 && Fg.bid >= rem) bg_convert(F, PA, L + 1, 0, BG_Q1 * (Fg.G - rem) * NWAVES, (Fg.bid - rem) * NWAVES + wave_now(), BG_Q1); } }
        SEAM(s0 + 1); STAMP(1);
        if (PHE(4) && IN(s0 + 2)) for (int rep = 0; rep < NREP(4); ++rep) { ph_prep(F, PA, L); }
        SEAM(s0 + 2); STAMP(2);
        if (PHE(5) && IN(s0 + 3)) for (int rep = 0; rep < NREP(5); ++rep) { ph_state_scan(F, PA); ph_attn(F, PA, L); }
        SEAM(s0 + 3); STAMP(3);
        if (PHE(6) && IN(s0 + 4)) for (int rep = 0; rep < NREP(6); ++rep) { ph_finish(F, PA, L); }
        SEAM(s0 + 4); STAMP(4);
        if (PHE(7) && IN(s0 + 5)) {
            { pg8::Gemm g{(const bf16_t*)(ws + WS_YCAT) + (size_t)TC * DM, (const bf16_t*)(ws + WS_WOUT) + (size_t)L * DM * DM, TL, DM, DM, DM}; pg8::StaticOrder S; { const Fr Fg = fr_refresh(F); S.init(TL, DM, Fg.G, Fg.bid); }
              pg8::EpiResid E{X + (size_t)TC * DM, DM, mod_lat + 2 * DM, mod_lat + 2 * DM, 0};
              pg8::gemm_phase<pg8::EpiResid, pg8::StaticOrder, true, true>(F.lds, g, S, E); }
            if (need_ctx) { pg8::Gemm g{(const bf16_t*)(ws + WS_YCAT), (const bf16_t*)(ws + WS_WOUT) + (size_t)L * DM * DM, TC, DM, DM / SPLIT_OUT, DM}; const Fr Fg = fr_refresh(F); pg8::SplitKOrder S{DM / 256, SPLIT_OUT, DM / SPLIT_OUT, Fg.G, Fg.bid, 0};
              pg8::EpiPart E{(float*)(ws + WS_PART), DM, DM / SPLIT_OUT, TC};
              pg8::gemm_phase<pg8::EpiPart, pg8::SplitKOrder, true, true>(F.lds, g, S, E); } }
        SEAM(s0 + 5); STAMP(5);
        if (PHE(8) && IN(s0 + 6)) for (int rep = 0; rep < NREP(8); ++rep) { ph_norm<false>(F, X, XN, PA.inp(7) + L * DM, mod_lat, mod_ctx, 3 * DM, 4 * DM, nullptr, nullptr, nullptr, (const float*)(ws + WS_PART), need_ctx ? SPLIT_OUT : 0, mod_ctx + 2 * DM); }
        SEAM(s0 + 6); STAMP(6);
        if (PHE(9) && IN(s0 + 7)) for (int rep = 0; rep < NREP(9); ++rep) {
            pg8::Gemm g{XN + (size_t)rlo * DM, (const bf16_t*)(ws + WS_WUP) + (size_t)L * 2 * DFF * DM, TA - rlo, 2 * DFF, DM, DM}; pg8::StaticOrder S; { const Fr Fg = fr_refresh(F); S.init(TA - rlo, 2 * DFF, Fg.G, Fg.bid); }
            pg8::EpiAct E{(bf16_t*)(ws + WS_H) + (size_t)rlo * DFF, DFF, PA.inp(26) + (size_t)L * 3 * DFF, PA.inp(27) + (size_t)L * DFF, (float*)(ws + WS_GBND), (float*)(ws + WS_UBND), rlo / 256, (PG8_LAS float*)(F.lds + 131072)};
            pg8::gemm_phase<pg8::EpiAct, pg8::StaticOrder, true, true>(F.lds, g, S, E);
            if (L < DEPTH - 1) { const Fr Fg = fr_refresh(F); const int rem = ((TA / 256) * (2 * DFF / 256)) % Fg.G, rem1 = ((TA / 256) * (NPT / 256)) % Fg.G; const int lo = rem1 > 0 ? BG_Q1 * (Fg.G - rem1) * NWAVES : 0;
                if (rem > 0 && Fg.bid >= rem) bg_convert(F, PA, L + 1, lo, lo + BG_Q2 * (Fg.G - rem) * NWAVES, (Fg.bid - rem) * NWAVES + wave_now(), BG_Q2); } }
        SEAM(s0 + 7); STAMP(7);
        if (PHE(11) && IN(s0 + 8)) {
            { pg8::StaticOrder S0; { const Fr Fg = fr_refresh(F); S0.init(TL, DM, Fg.G, Fg.bid); } pg8::Unit u0; for (int i = 0; S0.next(i, u0); ++i) act_fix_panel(F, PA, L, u0.pm + 1); }
            { pg8::Gemm g{(const bf16_t*)(ws + WS_H) + (size_t)TC * DFF, (const bf16_t*)(ws + WS_WDN) + (size_t)L * DM * DFF, TL, DM, DFF, DFF}; pg8::StaticOrder S; { const Fr Fg = fr_refresh(F); S.init(TL, DM, Fg.G, Fg.bid); }
              pg8::EpiResid E{X + (size_t)TC * DM, DM, mod_lat + 5 * DM, mod_lat + 5 * DM, 0};
              pg8::gemm_phase<pg8::EpiResid, pg8::StaticOrder, true, true>(F.lds, g, S, E); }
            if (need_ctx) { pg8::Gemm g{(const bf16_t*)(ws + WS_H), (const bf16_t*)(ws + WS_WDN) + (size_t)L * DM * DFF, TC, DM, DFF / SPLIT_DN, DFF}; const Fr Fg = fr_refresh(F); pg8::SplitKOrder S{DM / 256, SPLIT_DN, DFF / SPLIT_DN, Fg.G, Fg.bid, 0};
              pg8::EpiPart E{(float*)(ws + WS_PART), DM, DFF / SPLIT_DN, TC};
              pg8::gemm_phase<pg8::EpiPart, pg8::SplitKOrder, true, true>(F.lds, g, S, E); }
            if (L < DEPTH - 1) { const Fr Fg = fr_refresh(F); const int rem = ((TA / 256) * (2 * DFF / 256)) % Fg.G, rem1 = ((TA / 256) * (NPT / 256)) % Fg.G;
                const int lo = (rem1 > 0 ? BG_Q1 * (Fg.G - rem1) * NWAVES : 0) + (rem > 0 ? BG_Q2 * (Fg.G - rem) * NWAVES : 0); const int per = (I_L - lo + Fg.G * NWAVES - 1) / (Fg.G * NWAVES);
                if (lo < I_L) bg_convert(F, PA, L + 1, lo, I_L, Fg.bid * NWAVES + wave_now(), per); }  }
        SEAM(s0 + 8); STAMP(8);
    }
    if (PHE(12) && IN(N_STEPS - 1)) { ph_final(F, PA); }
#undef IN
#undef SEAM
}

extern "C" void kernel_launch(void* const* d_in, const int* in_sizes, int n_in, void* d_out, int out_size, void* d_ws, size_t ws_size, hipStream_t stream) {
    static int grid = 0;
    if (grid == 0) {
        if (n_in != 30 || out_size != TL * DM || ws_size < WS_END) { fprintf(stderr, "kernel_launch: unexpected shapes: n_in %d out %d ws %zu (need %zu)\n", n_in, out_size, ws_size, (size_t)WS_END); grid = -1; return; }
        int dev = 0, cus = 0, per_cu = 0;
        if (hipGetDevice(&dev) != hipSuccess || hipDeviceGetAttribute(&cus, hipDeviceAttributeMultiprocessorCount, dev) != hipSuccess) { fprintf(stderr, "kernel_launch: device query failed\n"); grid = -1; return; }
        if (hipFuncSetAttribute((const void*)mk_fwd, hipFuncAttributeMaxDynamicSharedMemorySize, LDS_BYTES) != hipSuccess) { fprintf(stderr, "kernel_launch: hipFuncSetAttribute(%d) failed\n", LDS_BYTES); grid = -1; return; }
        if (hipOccupancyMaxActiveBlocksPerMultiprocessor(&per_cu, (const void*)mk_fwd, NWAVES * 64, LDS_BYTES) != hipSuccess || per_cu < 1) { fprintf(stderr, "kernel_launch: occupancy query says %d blocks per CU\n", per_cu); }
        (void)hipGetLastError();
        grid = cus;
    }
    if (grid < 0) return;
    if (hipMemsetAsync((char*)d_ws + WS_CTL, 0, CTL_ZERO_BYTES, stream) != hipSuccess) { fprintf(stderr, "kernel_launch: memset failed\n"); return; }
    Args a{};
    for (int i = 0; i < 30; ++i) a.in[i] = (const float*)d_in[i];
    a.out = (float*)d_out; a.ws = (unsigned char*)d_ws;
#if MK_ONE_LAUNCH
    a.s_lo = 0; a.s_hi = N_STEPS;
    hipLaunchKernelGGL(mk_fwd, dim3(grid), dim3(NWAVES * 64), LDS_BYTES, stream, a);
#else
    for (int s = 0; s < N_STEPS; ++s) { a.s_lo = s; a.s_hi = s + 1; hipLaunchKernelGGL(mk_fwd, dim3(grid), dim3(NWAVES * 64), LDS_BYTES, stream, a); }
#endif
    const hipError_t le = hipPeekAtLastError();
    if (le != hipSuccess) fprintf(stderr, "kernel_launch: launch failed: %s\n", hipGetErrorName(le));
}
```
